# Optimizing an MI355X kernel written in HIP

```python
import jax, jax.numpy as jnp
from jax import lax
import numpy as np

D_MODEL = 1024
BATCH = 8
SEQ = 2048
DEPTH = 2

GRID_W = 64
CTX_LEN = 256
D_FOURIER = 256
FOURIER_GROUPS = 4
D_CONV = 256
CONV_WIDTH = 31
N_NA_HEADS = 8
NA_HEAD_DIM = 64
D_NA = N_NA_HEADS * NA_HEAD_DIM
WIN_ROWS = 8
WIN_COLS = 16
QKV_START = D_FOURIER + 2 * D_CONV
KV_START = QKV_START + D_NA
D_IN = QKV_START + 3 * D_NA
D_MIX = D_FOURIER + D_CONV + D_NA
D_FF = 4 * D_MODEL
N_MOD = 6
RMS_EPS = 1e-6
LN_EPS = 1e-5

kernel_name = "hymba_style_fourier_conformer_natten_dit"


def rms_norm(x, g):
    xf = x.astype(jnp.float32)
    y = xf * lax.rsqrt(jnp.mean(xf * xf, axis=-1, keepdims=True) + RMS_EPS)
    return (y * g.astype(jnp.float32)).astype(x.dtype)


def layer_norm(x, g, b):
    xf = x.astype(jnp.float32)
    mu = jnp.mean(xf, axis=-1, keepdims=True)
    var = jnp.mean(jnp.square(xf - mu), axis=-1, keepdims=True)
    y = (xf - mu) * lax.rsqrt(var + LN_EPS)
    return (y * g.astype(jnp.float32) + b.astype(jnp.float32)).astype(x.dtype)


def modulate(x, shift, scale):
    return x * (1 + scale) + shift


def split_heads(u):
    b, l, _ = u.shape
    qkv = u[..., QKV_START:].reshape(b, l, 3, N_NA_HEADS, NA_HEAD_DIM)
    return u[..., :D_FOURIER], u[..., D_FOURIER:QKV_START], qkv[:, :, 0], qkv[:, :, 1], qkv[:, :, 2]


def fourier_mix(u, w):
    b, l, _ = u.shape
    ug = u.reshape(b, l, FOURIER_GROUPS, D_FOURIER // FOURIER_GROUPS).astype(jnp.float32)
    f = jnp.fft.fftn(ug, axes=(1, 3), norm="ortho").real
    return f.reshape(b, l, D_FOURIER).astype(u.dtype) @ w


def conv_module(u, dw_w, dw_b, ln_g, ln_b, pw_w, pw_b):
    a, gt = jnp.split(u, 2, axis=-1)
    v = a * jax.nn.sigmoid(gt)
    pad = CONV_WIDTH // 2
    v = lax.conv_general_dilated(v, dw_w[:, None, :].astype(v.dtype), window_strides=(1,), padding=[(pad, pad)],
                                 dimension_numbers=("NWC", "WIO", "NWC"), feature_group_count=D_CONV) + dw_b
    v = jax.nn.silu(layer_norm(v, ln_g, ln_b))
    return v @ pw_w + pw_b


def context_attention(q, k, v):
    s = jnp.einsum("bqhd,bkhd->bhqk", q, k).astype(jnp.float32) * (NA_HEAD_DIM ** -0.5)
    p = jax.nn.softmax(s, axis=-1).astype(v.dtype)
    o = jnp.einsum("bhqk,bkhd->bqhd", p, v)
    return o.reshape(q.shape[0], q.shape[1], D_NA)


def neighbourhood_attention(q, k, v, k_ctx, v_ctx, rpb):
    b, l, h, dh = q.shape
    rows = l // GRID_W
    kr = min(WIN_ROWS, rows)
    r = np.arange(rows)
    row_start = np.clip(r - kr // 2, 0, rows - kr)
    key_rows = row_start[:, None] + np.arange(kr)[None, :]
    col = np.arange(GRID_W)
    col_start = np.clip(col - WIN_COLS // 2, 0, GRID_W - WIN_COLS)
    col_valid = (col[None, :] >= col_start[:, None]) & (col[None, :] < col_start[:, None] + WIN_COLS)
    row_off = key_rows - r[:, None] + (WIN_ROWS - 1)
    col_off = np.clip(col[None, :] - col[:, None] + (WIN_COLS - 1), 0, 2 * WIN_COLS - 2)
    bias = rpb[:, row_off[:, :, None, None], col_off[None, None]].astype(jnp.float32)
    bias = jnp.where(jnp.asarray(col_valid)[None, None, None], bias, -jnp.inf)
    bias = bias.transpose(0, 1, 3, 2, 4).reshape(h, rows, GRID_W, kr * GRID_W)
    qg = q.reshape(b, rows, GRID_W, h, dh)
    kg = k.reshape(b, rows, GRID_W, h, dh)[:, key_rows].reshape(b, rows, kr * GRID_W, h, dh)
    vg = v.reshape(b, rows, GRID_W, h, dh)[:, key_rows].reshape(b, rows, kr * GRID_W, h, dh)
    scale = NA_HEAD_DIM ** -0.5
    s_loc = jnp.einsum("brqhd,brkhd->bhrqk", qg, kg).astype(jnp.float32) * scale + bias[None]
    s_ctx = jnp.einsum("brqhd,bchd->bhrqc", qg, k_ctx).astype(jnp.float32) * scale
    p = jax.nn.softmax(jnp.concatenate([s_loc, s_ctx], axis=-1), axis=-1).astype(v.dtype)
    n_loc = kr * GRID_W
    o = (jnp.einsum("bhrqk,brkhd->brqhd", p[..., :n_loc], vg)
         + jnp.einsum("bhrqc,bchd->brqhd", p[..., n_loc:], v_ctx))
    return o.reshape(b, l, D_NA)


def setup_inputs(seed: int = 0) -> dict:
    key = jax.random.key(seed)
    ks = jax.random.split(key, 24)

    def nrm(k, shape, scale):
        return jax.random.normal(k, shape, jnp.float32) * scale

    return {
        "x": nrm(ks[0], (BATCH, SEQ, D_MODEL), 1.0),
        "c": nrm(ks[1], (BATCH, D_MODEL), 1.0),
        "ctx": nrm(ks[2], (BATCH, CTX_LEN, D_MODEL), 1.0),
        "c_ctx": nrm(ks[3], (D_MODEL,), 1.0),
        "ada_w": nrm(ks[4], (DEPTH, D_MODEL, N_MOD * D_MODEL), D_MODEL ** -0.5),
        "ada_b": nrm(ks[5], (DEPTH, N_MOD * D_MODEL), 0.02),
        "norm1_g": 1.0 + nrm(ks[6], (DEPTH, D_MODEL), 0.05),
        "norm2_g": 1.0 + nrm(ks[7], (DEPTH, D_MODEL), 0.05),
        "w_in": nrm(ks[8], (DEPTH, D_MODEL, D_IN), D_MODEL ** -0.5),
        "w_fourier": nrm(ks[9], (DEPTH, D_FOURIER, D_FOURIER), D_FOURIER ** -0.5),
        "conv_dw_w": nrm(ks[10], (DEPTH, CONV_WIDTH, D_CONV), CONV_WIDTH ** -0.5),
        "conv_dw_b": nrm(ks[11], (DEPTH, D_CONV), 0.02),
        "conv_norm_g": 1.0 + nrm(ks[12], (DEPTH, D_CONV), 0.05),
        "conv_norm_b": nrm(ks[13], (DEPTH, D_CONV), 0.02),
        "conv_pw_w": nrm(ks[14], (DEPTH, D_CONV, D_CONV), D_CONV ** -0.5),
        "conv_pw_b": nrm(ks[15], (DEPTH, D_CONV), 0.02),
        "na_rpb": nrm(ks[16], (DEPTH, N_NA_HEADS, 2 * WIN_ROWS - 1, 2 * WIN_COLS - 1), 0.1),
        "w_out": nrm(ks[17], (DEPTH, D_MIX, D_MODEL), D_MIX ** -0.5),
        "mlp_w1": nrm(ks[18], (DEPTH, D_MODEL, D_FF), D_MODEL ** -0.5),
        "mlp_w2": nrm(ks[19], (DEPTH, D_FF, D_MODEL), D_FF ** -0.5),
        "final_norm_g": 1.0 + nrm(ks[20], (D_MODEL,), 0.05),
    }


def reference(x, c, ctx, c_ctx, ada_w, ada_b, norm1_g, norm2_g, w_in, w_fourier, conv_dw_w, conv_dw_b,
              conv_norm_g, conv_norm_b, conv_pw_w, conv_pw_b, na_rpb, w_out, mlp_w1, mlp_w2, final_norm_g):
    h_lat, h_ctx = x, ctx
    b = x.shape[0]
    n_ctx = ctx.shape[1]
    for i in range(DEPTH):
        last = i == DEPTH - 1
        conv_p = (conv_dw_w[i], conv_dw_b[i], conv_norm_g[i], conv_norm_b[i], conv_pw_w[i], conv_pw_b[i])
        mod = (jax.nn.silu(c) @ ada_w[i] + ada_b[i])[:, None, :]
        sh1, sc1, g1, sh2, sc2, g2 = jnp.split(mod, N_MOD, axis=-1)
        n_ctx_mod = (2 if last else N_MOD) * D_MODEL
        mod_c = (jax.nn.silu(c_ctx) @ ada_w[i][:, :n_ctx_mod] + ada_b[i][:n_ctx_mod])[None, None, :]
        mods_c = jnp.split(mod_c, n_ctx_mod // D_MODEL, axis=-1)

        hn_ctx = modulate(rms_norm(h_ctx, norm1_g[i]), mods_c[0], mods_c[1])
        if last:
            kv = (hn_ctx @ w_in[i][:, KV_START:]).reshape(b, n_ctx, 2, N_NA_HEADS, NA_HEAD_DIM)
            k_ctx, v_ctx = kv[:, :, 0], kv[:, :, 1]
        else:
            uf_c, uc_c, q_ctx, k_ctx, v_ctx = split_heads(hn_ctx @ w_in[i])
            mix_ctx = jnp.concatenate([fourier_mix(uf_c, w_fourier[i]), conv_module(uc_c, *conv_p),
                                       context_attention(q_ctx, k_ctx, v_ctx)], axis=-1)

        hn_lat = modulate(rms_norm(h_lat, norm1_g[i]), sh1, sc1)
        uf, uc, q, k, v = split_heads(hn_lat @ w_in[i])
        mix_lat = jnp.concatenate([fourier_mix(uf, w_fourier[i]), conv_module(uc, *conv_p),
                                   neighbourhood_attention(q, k, v, k_ctx, v_ctx, na_rpb[i])], axis=-1)
        h_lat = h_lat + g1 * (mix_lat @ w_out[i])

        hn = modulate(rms_norm(h_lat, norm2_g[i]), sh2, sc2)
        h_lat = h_lat + g2 * (jnp.square(jax.nn.relu(hn @ mlp_w1[i])) @ mlp_w2[i])

        if not last:
            h_ctx = h_ctx + mods_c[2] * (mix_ctx @ w_out[i])
            hn_c2 = modulate(rms_norm(h_ctx, norm2_g[i]), mods_c[3], mods_c[4])
            h_ctx = h_ctx + mods_c[5] * (jnp.square(jax.nn.relu(hn_c2 @ mlp_w1[i])) @ mlp_w2[i])
    return rms_norm(h_lat, final_norm_g)
```

```cpp
#include <hip/hip_runtime.h>
#include <hip/hip_cooperative_groups.h>
#include <cstdio>
#include <cstdint>
namespace cg = cooperative_groups;
namespace pg8 {
#define PG8_LAS __attribute__((address_space(3)))
typedef unsigned short bf16_t;
typedef short bf16x8 __attribute__((ext_vector_type(8)));
typedef float f32x4 __attribute__((ext_vector_type(4)));
typedef unsigned u32x4 __attribute__((ext_vector_type(4)));
constexpr int BM = 256, BK = 64, HALF = 128, HTB = HALF * BK * 2  , STAGE_BYTES = 8 * HTB, NXCD = 8, WGM = 8;

__host__ __device__ __forceinline__ int lds_byte(int r, int c) { const int st = (r >> 4) * 2 + (c >> 5), rr = r & 15, cc = c & 31, ob = rr * 64 + cc * 2; return st * 1024 + (ob ^ (((ob >> 9) & 1) << 5)); }
__host__ __device__ __forceinline__ void stage_rc(int b, int& R, int& C) { const int st = b / 1024, sb = b % 1024, swz = sb ^ (((sb >> 9) & 1) << 5); R = (st >> 1) * 16 + swz / 64; C = (st & 1) * 32 + (swz % 64) / 2; }
__host__ __device__ __forceinline__ int perm32(int rho) { const int n = rho >> 4, i = rho & 15; return 8 * (i >> 2) + 4 * n + (i & 3); }

struct Unit { int pm, pn; };
struct Gemm { const bf16_t* A; const bf16_t* Bt; int M, N, K; };

struct StaticOrder {
    int nM, nN, nwg, G, c;
    __host__ __device__ void init(int M, int N, int G_, int c_) { nM = M / BM; nN = N / BM; nwg = nM * nN; G = G_; c = c_; }
    __host__ __device__ bool next(int i, Unit& u) const {
        const long L = (long)i * G + c; if (L >= nwg) return false;
        int wgid = (int)L; { const int q = nwg / NXCD, r = nwg % NXCD, xcd = wgid % NXCD, off = wgid / NXCD; wgid = (xcd < r ? xcd * (q + 1) : r * (q + 1) + (xcd - r) * q) + off; }
        const int nig = WGM * nN, gid = wgid / nig, fm = gid * WGM, gsz = (nM - fm) < WGM ? (nM - fm) : WGM;
        u.pm = fm + ((wgid % nig) % gsz); u.pn = (wgid % nig) / gsz; return true;
    }
    __device__ __forceinline__ void a_ready(const Unit&) const {}
    __device__ __forceinline__ void done(const Unit&) const {}
};

template <class Epi, class Sched, bool ALIGN_EPI = false, bool SP2 = false>
__device__ __forceinline__ void gemm_phase(PG8_LAS unsigned char* lds, const Gemm g, const Sched& S, const Epi& E, const int tid_in) {
    const int tid = tid_in, wid = __builtin_amdgcn_readfirstlane(tid >> 6), lane = tid & 63, wr = wid >> 2, wc = wid & 3, fr = lane & 15, fq = lane >> 4;
    const int K = g.K, nt = K / BK;
    unsigned voffA[2], voffB[2];
#pragma unroll
    for (int i = 0; i < 2; ++i) { int R, C; stage_rc(tid * 16 + i * 8192, R, C); const int Rb = Epi::PERM ? ((R & ~31) + perm32(R & 31)) : R;
        voffA[i] = (unsigned)(R * K + C) * 2u; voffB[i] = (unsigned)(Rb * K + C) * 2u; }
    const size_t kstep = (size_t)(BK * 2);
    const size_t hstep = (size_t)HALF * K * 2;
    const size_t tstep = 2 * hstep;
    const unsigned ldsw = (unsigned)wid * 1024u;
    const int aoff = lds_byte(wr * 64 + fr, fq * 8), boff = lds_byte(wc * 32 + fr, fq * 8);
#define PG8_SA(b, h) (((b) * 2 + (h)) * HTB)
#define PG8_SB(b, h) ((4 + (b) * 2 + (h)) * HTB)
#define PG8_STAGE(bufoff, gbase, voff) do { _Pragma("unroll") for (int _i = 0; _i < 2; ++_i) \
        __builtin_amdgcn_global_load_lds((const unsigned*)((const char*)(gbase) + (voff)[_i]), (PG8_LAS unsigned*)(lds + (bufoff) + ldsw + _i * 8192), 16, 0, 0); } while (0)
#define PG8_LDA(dst, b, h) do { _Pragma("unroll") for (int m = 0; m < 4; ++m) _Pragma("unroll") for (int k = 0; k < 2; ++k) dst[m][k] = *(const PG8_LAS bf16x8*)(lds + PG8_SA(b, h) + aoff + m * 2048 + k * 1024); } while (0)
#define PG8_LDB(dst, b, h) do { _Pragma("unroll") for (int n = 0; n < 2; ++n) _Pragma("unroll") for (int k = 0; k < 2; ++k) dst[n][k] = *(const PG8_LAS bf16x8*)(lds + PG8_SB(b, h) + boff + n * 2048 + k * 1024); } while (0)
#define PG8_MMA(ai, bj, At, Bt) do { __builtin_amdgcn_s_setprio(1); _Pragma("unroll") for (int m = 0; m < 4; ++m) _Pragma("unroll") for (int n = 0; n < 2; ++n) _Pragma("unroll") for (int k = 0; k < 2; ++k) \
        acc[ai][bj][m][n] = __builtin_amdgcn_mfma_f32_16x16x32_bf16(Bt[n][k], At[m][k], acc[ai][bj][m][n], 0, 0, 0); __builtin_amdgcn_s_setprio(0); } while (0)
#define PG8_WAIT_V(n) asm volatile("s_waitcnt vmcnt(" #n ")" ::: "memory")
#define PG8_WAIT_L(n) asm volatile("s_waitcnt lgkmcnt(" #n ")" ::: "memory")
#define PG8_BAR __builtin_amdgcn_s_barrier()
#define PG8_SCHED __builtin_amdgcn_sched_barrier(0)
    Unit cur, nxt; int ui = 0;
    if (!S.next(0, cur)) return;
    f32x4 acc[2][2][4][2];
#pragma unroll
    for (int a = 0; a < 2; ++a)
#pragma unroll
        for (int b = 0; b < 2; ++b)
#pragma unroll
            for (int m = 0; m < 4; ++m)
#pragma unroll
                for (int n = 0; n < 2; ++n) acc[a][b][m][n] = (f32x4){0.f, 0.f, 0.f, 0.f};
    bf16x8 At[4][2], B0[2][2], B1[2][2];
    const char* cA = (const char*)g.A + (size_t)cur.pm * tstep; const char* cB = (const char*)g.Bt + (size_t)cur.pn * tstep;
    S.a_ready(cur);
    if constexpr (SP2) {
        PG8_STAGE(PG8_SB(0, 0), cB, voffB); PG8_STAGE(PG8_SB(0, 1), cB + hstep, voffB); PG8_STAGE(PG8_SA(0, 0), cA, voffA); PG8_STAGE(PG8_SA(0, 1), cA + hstep, voffA);
        if (wr == 1) PG8_BAR;
        PG8_WAIT_V(2); PG8_BAR;
        PG8_STAGE(PG8_SB(1, 0), cB + kstep, voffB); PG8_STAGE(PG8_SA(1, 0), cA + kstep, voffA); PG8_STAGE(PG8_SB(1, 1), cB + hstep + kstep, voffB);
        PG8_WAIT_V(6); PG8_BAR;
    } else {
        PG8_STAGE(PG8_SB(0, 0), cB, voffB); PG8_STAGE(PG8_SA(0, 0), cA, voffA); PG8_STAGE(PG8_SB(0, 1), cB + hstep, voffB); PG8_STAGE(PG8_SA(0, 1), cA + hstep, voffA);
        if (wr == 1) PG8_BAR;
        PG8_WAIT_V(4); PG8_BAR;
        PG8_STAGE(PG8_SB(1, 0), cB + kstep, voffB); PG8_STAGE(PG8_SA(1, 0), cA + kstep, voffA); PG8_STAGE(PG8_SB(1, 1), cB + hstep + kstep, voffB);
        PG8_WAIT_V(6); PG8_BAR;
    }
    for (;;) {
        const bool has_next = S.next(ui + 1, nxt);
        const char* nA = has_next ? (const char*)g.A + (size_t)nxt.pm * tstep : cA; const char* nB = has_next ? (const char*)g.Bt + (size_t)nxt.pn * tstep : cB;
        for (int t = 0; t < nt; t += 2) {
            const bool last = (t == nt - 2);
            const char* a1 = cA + (size_t)(t + 1) * kstep;
            const char* a2 = last ? nA : cA + (size_t)(t + 2) * kstep; const char* b2 = last ? nB : cB + (size_t)(t + 2) * kstep;
            const char* a3 = a2 + kstep; const char* b3 = b2 + kstep;
            if (last && has_next) S.a_ready(nxt);
            if constexpr (SP2) {
            PG8_LDB(B0, 0, 0); PG8_LDB(B1, 0, 1); PG8_SCHED; PG8_LDA(At, 0, 0); PG8_STAGE(PG8_SA(1, 1), a1 + hstep, voffA);
            PG8_WAIT_V(8); PG8_WAIT_L(0); PG8_BAR; PG8_MMA(0, 0, At, B0); PG8_MMA(0, 1, At, B1); PG8_BAR; PG8_SCHED;
            PG8_LDA(At, 0, 1); PG8_STAGE(PG8_SB(0, 0), b2, voffB); PG8_STAGE(PG8_SB(0, 1), b2 + hstep, voffB); PG8_STAGE(PG8_SA(0, 0), a2, voffA);
            PG8_WAIT_V(8); PG8_WAIT_L(0); PG8_BAR; PG8_MMA(1, 0, At, B0); PG8_MMA(1, 1, At, B1); PG8_BAR; PG8_SCHED;
            PG8_LDB(B0, 1, 0); PG8_LDB(B1, 1, 1); PG8_SCHED; PG8_LDA(At, 1, 0); PG8_STAGE(PG8_SA(0, 1), a2 + hstep, voffA);
            PG8_WAIT_V(8); PG8_WAIT_L(0); PG8_BAR; PG8_MMA(0, 0, At, B0); PG8_MMA(0, 1, At, B1); PG8_BAR; PG8_SCHED;
            PG8_LDA(At, 1, 1); PG8_STAGE(PG8_SB(1, 0), b3, voffB); PG8_STAGE(PG8_SB(1, 1), b3 + hstep, voffB); PG8_STAGE(PG8_SA(1, 0), a3, voffA);
            PG8_WAIT_V(8); PG8_WAIT_L(0); PG8_BAR; PG8_MMA(1, 0, At, B0); PG8_MMA(1, 1, At, B1); PG8_BAR; PG8_SCHED;
            } else {
            PG8_LDB(B0, 0, 0); PG8_SCHED; PG8_LDA(At, 0, 0); PG8_STAGE(PG8_SA(1, 1), a1 + hstep, voffA);
            PG8_WAIT_L(8); PG8_BAR; PG8_WAIT_L(0); PG8_MMA(0, 0, At, B0); PG8_BAR; PG8_SCHED;
            PG8_LDB(B1, 0, 1); PG8_STAGE(PG8_SB(0, 0), b2, voffB);
            PG8_BAR; PG8_WAIT_L(0); PG8_MMA(0, 1, At, B1); PG8_BAR;
            PG8_LDA(At, 0, 1); PG8_STAGE(PG8_SA(0, 0), a2, voffA);
            PG8_BAR; PG8_WAIT_L(0); PG8_MMA(1, 0, At, B0); PG8_BAR; PG8_SCHED;
            PG8_STAGE(PG8_SB(0, 1), b2 + hstep, voffB);
            PG8_WAIT_V(6); PG8_BAR; PG8_MMA(1, 1, At, B1); PG8_BAR;
            PG8_LDB(B0, 1, 0); PG8_SCHED; PG8_LDA(At, 1, 0); PG8_STAGE(PG8_SA(0, 1), a2 + hstep, voffA);
            PG8_WAIT_L(8); PG8_BAR; PG8_WAIT_L(0); PG8_MMA(0, 0, At, B0); PG8_BAR; PG8_SCHED;
            PG8_LDB(B1, 1, 1); PG8_STAGE(PG8_SB(1, 0), b3, voffB);
            PG8_BAR; PG8_WAIT_L(0); PG8_MMA(0, 1, At, B1); PG8_BAR;
            PG8_LDA(At, 1, 1); PG8_STAGE(PG8_SA(1, 0), a3, voffA);
            PG8_BAR; PG8_WAIT_L(0); PG8_MMA(1, 0, At, B0); PG8_BAR; PG8_SCHED;
            PG8_STAGE(PG8_SB(1, 1), b3 + hstep, voffB);
            PG8_WAIT_V(6); PG8_BAR; PG8_MMA(1, 1, At, B1); PG8_BAR;
            }
        }
        if constexpr (ALIGN_EPI) { if (wr == 0) PG8_BAR; }
        if constexpr (!Epi::AFTER_DRAIN) { E(acc, cur, wr, wc, fr, fq); S.done(cur); }
        if (!has_next) break;
#pragma unroll
        for (int a = 0; a < 2; ++a)
#pragma unroll
            for (int b = 0; b < 2; ++b)
#pragma unroll
                for (int m = 0; m < 4; ++m)
#pragma unroll
                    for (int n = 0; n < 2; ++n) acc[a][b][m][n] = (f32x4){0.f, 0.f, 0.f, 0.f};
        cur = nxt; cA = nA; cB = nB; ++ui;
        if constexpr (ALIGN_EPI) { if (wr == 1) PG8_BAR; }
    }
    PG8_WAIT_V(0);
    if constexpr (!ALIGN_EPI) { if (wr == 0) PG8_BAR; }
    PG8_BAR;
    if constexpr (Epi::AFTER_DRAIN) { E.fused(acc, cur, wr, wc, fr, fq, lds, wid, lane); S.done(cur); }
#undef PG8_SA
#undef PG8_SB
#undef PG8_STAGE
#undef PG8_LDA
#undef PG8_LDB
#undef PG8_MMA
#undef PG8_WAIT_V
#undef PG8_WAIT_L
#undef PG8_BAR
#undef PG8_SCHED
}
}

#define LAS __attribute__((address_space(3)))
#define DI __device__ __forceinline__
typedef unsigned short bf16;
typedef short bf16x8 __attribute__((ext_vector_type(8)));
typedef short s16x4 __attribute__((ext_vector_type(4)));
typedef float f32x4 __attribute__((ext_vector_type(4)));
typedef float f32x16 __attribute__((ext_vector_type(16)));
typedef unsigned u32x4 __attribute__((ext_vector_type(4)));
typedef unsigned u32x2 __attribute__((ext_vector_type(2)));
typedef __bf16 bf16x2_t __attribute__((ext_vector_type(2)));
typedef float f32x2_t __attribute__((ext_vector_type(2)));

#ifndef SINGLE_LAUNCH
#define SINGLE_LAUNCH 1
#endif

constexpr int D = 1024, NB = 8, SEQ = 2048, CTX = 256, TL = NB * SEQ, TC = NB * CTX, TA = TL + TC;
constexpr int DIN = 2304, DFF = 4096, URM = 1536;
constexpr int NPH = 18;
constexpr int LDS_BYTES = 147456;
constexpr size_t MiB = 1u << 20;
constexpr size_t WS_CTL = 0, WS_MODS = 1 * MiB;
constexpr size_t WS_WIN = 2 * MiB, WS_WOUT = WS_WIN + (size_t)DIN * D * 2, WS_W1 = WS_WOUT + 2 * MiB, WS_W2 = WS_W1 + 8 * MiB, WS_WPW = WS_W2 + 8 * MiB, WS_WF2 = WS_WPW + 128 * 1024;
constexpr size_t WS_DFTL = 25 * MiB, WS_DFTC = 41 * MiB, WS_HCTX = 42 * MiB, WS_HN = 50 * MiB, WS_OV = 86 * MiB;
constexpr size_t WS_URM = WS_OV, WS_UTL = WS_OV + 54 * MiB, WS_UTC = WS_UTL + 8 * MiB, WS_VTL = WS_UTC + 1 * MiB, WS_VTC = WS_VTL + 16 * MiB,
                 WS_G12 = WS_VTC + 2 * MiB, WS_CVA = WS_G12 + 18 * MiB, WS_MIX = WS_CVA + 9 * MiB, WS_HID = WS_OV, WS_END = WS_OV + 144 * MiB;
static_assert(WS_WF2 + 256 * 1024 <= WS_DFTL && WS_MIX + 36 * MiB == WS_END && WS_END <= 256 * MiB, "ws map");

struct Params { const float* in[21]; float* out; unsigned char* ws; int ph_lo, ph_hi; };
constexpr int LDSP_OFF = 131072;
struct PP {
    const __attribute__((address_space(3))) unsigned long long* P;
    __device__ __forceinline__ unsigned long long ld(int i) const { const unsigned long long v = P[i]; const unsigned lo = __builtin_amdgcn_readfirstlane((unsigned)v), hi = __builtin_amdgcn_readfirstlane((unsigned)(v >> 32)); return ((unsigned long long)hi << 32) | lo; }
    __device__ __forceinline__ const float* in(int i) const { return (const float*)ld(i); }
    __device__ __forceinline__ float* out() const { return (float*)ld(21); }
    __device__ __forceinline__ unsigned char* ws() const { return (unsigned char*)ld(22); }
};

DI unsigned pk2(float lo, float hi) { f32x2_t v = {lo, hi}; bf16x2_t b = __builtin_convertvector(v, bf16x2_t); return __builtin_bit_cast(unsigned, b); }
DI float bf2f(short x) { return __builtin_bit_cast(float, ((unsigned)(unsigned short)x) << 16); }
DI float wave_sum(float v) {
#pragma unroll
    for (int o = 1; o < 64; o <<= 1) v += __shfl_xor(v, o);
    return v;
}
#define LDS_WAIT() asm volatile("s_waitcnt lgkmcnt(0)" ::: "memory")

struct Sched {
    int nM, nN, nwg, G, c, pmadd;
    DI void init(int nM_, int nN_, int G_, int c_) { nM = nM_; nN = nN_; nwg = nM_ * nN_; G = G_; c = c_; pmadd = 0; }
    DI bool next(int i, pg8::Unit& u) const {
        const long L = (long)i * G + c; if (L >= nwg) return false;
        int wgid = (int)L; { const int q = nwg / 8, r = nwg % 8, xcd = wgid % 8, off = wgid / 8; wgid = (xcd < r ? xcd * (q + 1) : r * (q + 1) + (xcd - r) * q) + off; }
        const int nig = 8 * nN, gid = wgid / nig, fm = gid * 8, gsz = (nM - fm) < 8 ? (nM - fm) : 8;
        u.pm = fm + ((wgid % nig) % gsz); u.pn = (wgid % nig) / gsz;
        if (u.pm > 0) u.pm += pmadd;
        return true;
    }
    DI void a_ready(const pg8::Unit&) const {}
    DI void done(const pg8::Unit&) const {}
};

template <int ACT> DI void store_tile_bf16(const pg8::f32x4 (&acc)[2][2][4][2], bf16* base, int ld, const float* bias, int wr, int wc, int fr, int fq) {
    const unsigned loff = (unsigned)((wr * 64 + fr) * ld + wc * 32 + 8 * fq) * 2u;
    f32x4 bv[2][2];
#pragma unroll
    for (int bj = 0; bj < 2; ++bj)
#pragma unroll
        for (int n = 0; n < 2; ++n) bv[bj][n] = bias ? *(const f32x4*)(bias + wc * 32 + 8 * fq + bj * 128 + 4 * n) : (f32x4){0.f, 0.f, 0.f, 0.f};
#pragma unroll
    for (int ai = 0; ai < 2; ++ai)
#pragma unroll
        for (int m = 0; m < 4; ++m) { char* rowp = (char*)base + (size_t)((ai * 128 + m * 16) * ld) * 2u;
#pragma unroll
            for (int bj = 0; bj < 2; ++bj) { f32x4 a = acc[ai][bj][m][0] + bv[bj][0], b = acc[ai][bj][m][1] + bv[bj][1];
                if (ACT == 1) {
#pragma unroll
                    for (int e = 0; e < 4; ++e) { const float x = fmaxf(a[e], 0.f); a[e] = x * x; const float y = fmaxf(b[e], 0.f); b[e] = y * y; } }
                u32x4 w; w.x = pk2(a.x, a.y); w.y = pk2(a.z, a.w); w.z = pk2(b.x, b.y); w.w = pk2(b.z, b.w);
                *(u32x4*)(rowp + bj * 256 + loff) = w; } }
}
enum { M_URM = 0, M_SWAP, M_DFTL, M_DFTC, M_MIXF, M_MIXC, M_RES1, M_RES2, M_HID };
struct UEpi {
    static constexpr bool PERM = true, AFTER_DRAIN = false;
    int mode, layer; PP p;
    DI void operator()(const pg8::f32x4 (&acc)[2][2][4][2], const pg8::Unit& u, int wr, int wc, int fr, int fq) const {
        unsigned char* ws = p.ws();
        if (mode == M_RES1 || mode == M_RES2) {
            const bool first = (mode == M_RES1 && layer == 0);
            const int row0 = u.pm * 256; const bool lat = row0 < TL; const int r2 = lat ? row0 : row0 - TL, midx = lat ? (row0 >> 11) : 8;
            const float* srcb = lat ? (first ? p.in(0) : (const float*)p.out()) : (first ? p.in(2) : (const float*)(ws + WS_HCTX));
            float* dstb = lat ? p.out() : (float*)(ws + WS_HCTX);
            const char* s = (const char*)(srcb + (size_t)r2 * D + u.pn * 256);
            char* d = (char*)(dstb + (size_t)r2 * D + u.pn * 256);
            const float* gp = (const float*)(ws + WS_MODS) + (size_t)layer * 9 * 6144 + (mode == M_RES1 ? 2 : 5) * D + midx * 6144 + u.pn * 256 + wc * 32 + 8 * fq;
            const unsigned loff = (unsigned)((wr * 64 + fr) * D + wc * 32 + 8 * fq) * 4u;
            f32x4 gv[2][2];
#pragma unroll
            for (int bj = 0; bj < 2; ++bj)
#pragma unroll
                for (int n = 0; n < 2; ++n) gv[bj][n] = *(const f32x4*)(gp + bj * 128 + 4 * n);
#pragma unroll
            for (int ai = 0; ai < 2; ++ai)
#pragma unroll
                for (int m = 0; m < 4; ++m) { const size_t ro = (size_t)((ai * 128 + m * 16) * D) * 4u;
#pragma unroll
                    for (int bj = 0; bj < 2; ++bj) {
                        const f32x4 x0 = *(const f32x4*)(s + ro + bj * 512 + loff), x1 = *(const f32x4*)(s + ro + bj * 512 + 16 + loff);
                        *(f32x4*)(d + ro + bj * 512 + loff) = x0 + gv[bj][0] * acc[ai][bj][m][0];
                        *(f32x4*)(d + ro + bj * 512 + 16 + loff) = x1 + gv[bj][1] * acc[ai][bj][m][1]; } }
            return;
        }
        bf16* base; int ld; const float* bias = nullptr;
        if (mode == M_URM) { ld = URM; base = (bf16*)(ws + WS_URM) + (size_t)(u.pm * 256) * URM + u.pn * 256; }
        else if (mode == M_HID) { ld = DFF; base = (bf16*)(ws + WS_HID) + (size_t)(u.pm * 256) * DFF + u.pn * 256; }
        else if (mode == M_SWAP) {
            const int tok0 = u.pn * 256; const bool lat = tok0 < TL;
            const int bb = lat ? (tok0 >> 11) : ((tok0 - TL) >> 8), l0 = lat ? (tok0 & (SEQ - 1)) : 0; ld = lat ? SEQ : CTX;
            if (u.pm == 0) base = (bf16*)(ws + (lat ? WS_UTL : WS_UTC)) + (size_t)(bb * 256) * ld + l0;
            else base = (bf16*)(ws + (lat ? WS_VTL : WS_VTC)) + (size_t)(bb * 512 + (u.pm - 7) * 256) * ld + l0;
        } else if (mode == M_DFTL || mode == M_DFTC) {
            const int L = mode == M_DFTL ? SEQ : CTX, lshift = mode == M_DFTL ? 11 : 8, rowbase = mode == M_DFTL ? 0 : TL;
            const int row0 = u.pm * 256, cs = row0 >> lshift, lp0 = row0 & (L - 1);
            ld = 512; base = (bf16*)(ws + WS_G12) + (size_t)(rowbase + u.pn * L + lp0) * 512 + cs * 256;
        } else {
            ld = D; base = (bf16*)(ws + WS_MIX) + (size_t)(u.pm * 256) * D + (mode == M_MIXC ? 256 : 0);
            if (mode == M_MIXC) bias = p.in(15) + layer * 256;
        }
        if (mode == M_HID) store_tile_bf16<1>(acc, base, ld, nullptr, wr, wc, fr, fq);
        else store_tile_bf16<0>(acc, base, ld, bias, wr, wc, fr, fq);
    }
};
DI void run_gemm(LAS unsigned char* lds, const bf16* A, const bf16* Bt, int K, const Sched& S, int mode, int layer, PP p, const int tid) {
    pg8::Gemm g{A, Bt, 0, 0, K}; UEpi e{mode, layer, p};
    pg8::gemm_phase<UEpi, Sched, true, true>(lds, g, S, e, tid);
}

DI void phase_mods(const PP p, LAS unsigned char* lds, const int tid_, const int bid_) {
    const int tid = tid_, lane = tid & 63, wave = tid >> 6;
    LAS float* s = (LAS float*)lds;
    LAS float* red = (LAS float*)(lds + 36864);
    float* mods = (float*)(p.ws() + WS_MODS);
    for (int i = tid; i < 9 * 1024; i += 512) { const int j = i >> 10, k = i & 1023; const float v = j < 8 ? p.in(1)[j * 1024 + k] : p.in(3)[k]; s[i] = v / (1.f + expf(-v)); }
    __syncthreads();
    for (int item = bid_; item < 192; item += gridDim.x) {
        const int layer = item / 96, cgp = item % 96, col = cgp * 64 + lane;
        const float* W = p.in(4) + (size_t)layer * 1024 * 6144 + col;
        float acc[9];
#pragma unroll
        for (int j = 0; j < 9; ++j) acc[j] = 0.f;
        const int k0 = wave * 128;
#pragma unroll 8
        for (int k = k0; k < k0 + 128; ++k) { const float w = W[(size_t)k * 6144];
#pragma unroll
            for (int j = 0; j < 9; ++j) acc[j] += s[j * 1024 + k] * w; }
#pragma unroll
        for (int j = 0; j < 9; ++j) red[(wave * 9 + j) * 64 + lane] = acc[j];
        __syncthreads();
        for (int t = tid; t < 576; t += 512) { const int j = t >> 6, l = t & 63; float v = p.in(5)[layer * 6144 + cgp * 64 + l];
#pragma unroll
            for (int w = 0; w < 8; ++w) v += red[(w * 9 + j) * 64 + l];
            mods[(size_t)(layer * 9 + j) * 6144 + cgp * 64 + l] = v; }
        __syncthreads();
    }
}
DI void make_tables(const PP p, const int tid_, const int bid_) {
    bf16* DL = (bf16*)(p.ws() + WS_DFTL); bf16* DC = (bf16*)(p.ws() + WS_DFTC);
    const int gt = bid_ * 512 + tid_, NT = gridDim.x * 512;
    for (int i = gt; i < 4096 * 256; i += NT) { const int row = i >> 8, l0 = (i & 255) * 8, cs = row >> 11, lp = row & 2047;
        float v[8];
#pragma unroll
        for (int e = 0; e < 8; ++e) { const int ph = (lp * (l0 + e)) & 2047; const float x = (float)ph * (1.f / 1024.f); v[e] = (cs ? sinpif(x) : cospif(x)) * 0.022097086912079608f; }
        u32x4 w; w.x = pk2(v[0], v[1]); w.y = pk2(v[2], v[3]); w.z = pk2(v[4], v[5]); w.w = pk2(v[6], v[7]);
        *(u32x4*)(DL + (size_t)row * 2048 + l0) = w; }
    for (int i = gt; i < 512 * 32; i += NT) { const int row = i >> 5, l0 = (i & 31) * 8, cs = row >> 8, lp = row & 255;
        float v[8];
#pragma unroll
        for (int e = 0; e < 8; ++e) { const int ph = (lp * (l0 + e)) & 255; const float x = (float)ph * (1.f / 128.f); v[e] = (cs ? sinpif(x) : cospif(x)) * 0.0625f; }
        u32x4 w; w.x = pk2(v[0], v[1]); w.y = pk2(v[2], v[3]); w.z = pk2(v[4], v[5]); w.w = pk2(v[6], v[7]);
        *(u32x4*)(DC + (size_t)row * 256 + l0) = w; }
}
DI void transpose_item(const float* W, int K, int N, bf16* WT, LAS float* scr, int item, int lane) {
    const int nblk = N / 32, kb = item / nblk, nb = item % nblk, k0 = 64 * kb, n0 = 32 * nb;
#pragma unroll 8
    for (int i = 0; i < 32; ++i) { const int kk = 2 * i + (lane >> 5); scr[kk * 33 + (lane & 31)] = W[(size_t)(k0 + kk) * N + n0 + (lane & 31)]; }
    LDS_WAIT(); asm volatile("" ::: "memory");
    const int c = lane & 7;
#pragma unroll
    for (int j = 0; j < 4; ++j) { const int n = (lane >> 3) + 8 * j; const LAS float* sp = scr + (8 * c) * 33 + n;
        u32x4 o; o.x = pk2(sp[0 * 33], sp[1 * 33]); o.y = pk2(sp[2 * 33], sp[3 * 33]); o.z = pk2(sp[4 * 33], sp[5 * 33]); o.w = pk2(sp[6 * 33], sp[7 * 33]);
        *(u32x4*)(WT + (size_t)(n0 + n) * K + k0 + 8 * c) = o; }
    LDS_WAIT(); asm volatile("" ::: "memory");
}
DI void conv_weights(const PP p, int layer, LAS unsigned char* lds, const int tid_, const int bid_) {
    const int lane = tid_ & 63, wave = tid_ >> 6;
    LAS float* scr = (LAS float*)(lds + 57344 + wave * 8448);
    const int gw = bid_ * 8 + wave, NGW = gridDim.x * 8;
    const float* Win = p.in(8) + (size_t)layer * D * DIN; const float* Wout = p.in(17) + (size_t)layer * D * D;
    const float* W1 = p.in(18) + (size_t)layer * D * DFF; const float* W2 = p.in(19) + (size_t)layer * DFF * D; const float* Wpw = p.in(14) + (size_t)layer * 256 * 256;
    bf16* WinT = (bf16*)(p.ws() + WS_WIN); bf16* WoutT = (bf16*)(p.ws() + WS_WOUT); bf16* W1T = (bf16*)(p.ws() + WS_W1); bf16* W2T = (bf16*)(p.ws() + WS_W2); bf16* WpwT = (bf16*)(p.ws() + WS_WPW);
    constexpr int I_IN = 16 * 72, I_OUT = 16 * 32, I_1 = 16 * 128, I_2 = 64 * 32, I_PW = 4 * 8, NIT = I_IN + I_OUT + I_1 + I_2 + I_PW;
    for (int it = gw; it < NIT; it += NGW) {
        int r = it;
        if (r < I_IN) { transpose_item(Win, D, DIN, WinT, scr, r, lane); continue; } r -= I_IN;
        if (r < I_OUT) { transpose_item(Wout, D, D, WoutT, scr, r, lane); continue; } r -= I_OUT;
        if (r < I_1) { transpose_item(W1, D, DFF, W1T, scr, r, lane); continue; } r -= I_1;
        if (r < I_2) { transpose_item(W2, DFF, D, W2T, scr, r, lane); continue; } r -= I_2;
        transpose_item(Wpw, 256, 256, WpwT, scr, r, lane);
    }
    const float* Wf = p.in(9) + (size_t)layer * 256 * 256; bf16* Wf2t = (bf16*)(p.ws() + WS_WF2);
    for (int o = bid_ * 512 + tid_; o < 256 * 512; o += gridDim.x * 512) {
        const int n = o >> 9, k = o & 511, cs = k >> 8, g = (k >> 6) & 3, j = k & 63;
        float acc = 0.f;
        for (int jp = 0; jp < 64; ++jp) { const float x = (float)((j * jp) & 63) * (1.f / 32.f); const float t = cs ? sinpif(x) : cospif(x); acc += t * Wf[(size_t)(g * 64 + jp) * 256 + n]; }
        acc *= cs ? -0.125f : 0.125f;
        Wf2t[(size_t)n * 512 + k] = (bf16)(pk2(acc, 0.f) & 0xffffu);
    }
}
DI void phase_norm(const PP p, int layer, int which, int nrows, const int tid_, const int bid_) {
    const int lane = tid_ & 63, wave = tid_ >> 6;
    const int gw = bid_ * 8 + wave, NGW = gridDim.x * 8;
    const bool first = (layer == 0 && which == 0);
    const float* hl = first ? p.in(0) : p.out(); const float* hc = first ? p.in(2) : (const float*)(p.ws() + WS_HCTX);
    const float* g = p.in(which ? 7 : 6) + layer * D;
    const float* mods = (const float*)(p.ws() + WS_MODS) + (size_t)layer * 9 * 6144 + (which ? 3 : 0) * D;
    bf16* hn = (bf16*)(p.ws() + WS_HN);
    for (int row = gw; row < nrows; row += NGW) {
        const float* src = row < TL ? hl + (size_t)row * D : hc + (size_t)(row - TL) * D;
        const int midx = row < TL ? (row >> 11) : 8;
        f32x4 v[4]; float ss = 0.f;
#pragma unroll
        for (int jj = 0; jj < 4; ++jj) { v[jj] = *(const f32x4*)(src + 4 * (lane + 64 * jj)); ss += (v[jj].x * v[jj].x + v[jj].y * v[jj].y) + (v[jj].z * v[jj].z + v[jj].w * v[jj].w); }
        const float rinv = 1.f / sqrtf(wave_sum(ss) * (1.f / D) + 1e-6f);
#pragma unroll
        for (int jj = 0; jj < 4; ++jj) { const int k = 4 * (lane + 64 * jj);
            const f32x4 gg = *(const f32x4*)(g + k), sh = *(const f32x4*)(mods + midx * 6144 + k), sc = *(const f32x4*)(mods + midx * 6144 + D + k);
            const f32x4 y = (v[jj] * rinv * gg) * (sc + 1.f) + sh;
            u32x2 w; w.x = pk2(y.x, y.y); w.y = pk2(y.z, y.w);
            *(u32x2*)(hn + (size_t)row * D + k) = w; }
    }
}
DI void phase_final(const PP p, const int tid_, const int bid_) {
    const int lane = tid_ & 63, wave = tid_ >> 6;
    const int gw = bid_ * 8 + wave, NGW = gridDim.x * 8;
    const float* g = p.in(20);
    for (int row = gw; row < TL; row += NGW) {
        float* src = p.out() + (size_t)row * D;
        f32x4 v[4]; float ss = 0.f;
#pragma unroll
        for (int jj = 0; jj < 4; ++jj) { v[jj] = *(const f32x4*)(src + 4 * (lane + 64 * jj)); ss += (v[jj].x * v[jj].x + v[jj].y * v[jj].y) + (v[jj].z * v[jj].z + v[jj].w * v[jj].w); }
        const float rinv = 1.f / sqrtf(wave_sum(ss) * (1.f / D) + 1e-6f);
#pragma unroll
        for (int jj = 0; jj < 4; ++jj) { const int k = 4 * (lane + 64 * jj); const f32x4 gg = *(const f32x4*)(g + k); *(f32x4*)(src + k) = v[jj] * rinv * gg; }
    }
}
DI void conv_tile(const PP p, int layer, int seqbase, int L, int t0, LAS unsigned char* lds, const int tid_, const int bid_) {
    const int tid = tid_, lane = tid & 63;
    LAS float* vt = (LAS float*)lds;
    LAS float* red1 = (LAS float*)(lds + 98304);
    LAS float* red2 = (LAS float*)(lds + 98304 + 1024);
    const bf16* Urm = (const bf16*)(p.ws() + WS_URM);
    bf16* cva = (bf16*)(p.ws() + WS_CVA);
    __syncthreads();
    for (int idx = tid; idx < 94 * 32; idx += 512) { const int tt = idx >> 5, c8 = (idx & 31) * 8, pos = t0 - 15 + tt;
        float v[8];
        if (pos >= 0 && pos < L) { const bf16* rp = Urm + (size_t)(seqbase + pos) * URM + c8; const bf16x8 a8 = *(const bf16x8*)rp, g8 = *(const bf16x8*)(rp + 256);
#pragma unroll
            for (int e = 0; e < 8; ++e) { const float a = bf2f(a8[e]), gt = bf2f(g8[e]); v[e] = a / (1.f + __expf(-gt)); } }
        else {
#pragma unroll
            for (int e = 0; e < 8; ++e) v[e] = 0.f; }
        *(LAS f32x4*)(vt + tt * 256 + c8) = (f32x4){v[0], v[1], v[2], v[3]}; *(LAS f32x4*)(vt + tt * 256 + c8 + 4) = (f32x4){v[4], v[5], v[6], v[7]}; }
    __syncthreads();
    const int c = tid & 255, th = tid >> 8, wq = (tid >> 6) & 3;
    const float* dw = p.in(10) + (size_t)layer * 31 * 256 + c;
    float w[31];
#pragma unroll
    for (int tap = 0; tap < 31; ++tap) w[tap] = dw[tap * 256];
    const float bias = p.in(11)[layer * 256 + c], lg = p.in(12)[layer * 256 + c], lb = p.in(13)[layer * 256 + c];
    for (int ch = 0; ch < 4; ++ch) {
        const int tb = th * 32 + ch * 8;
        float o[8];
#pragma unroll
        for (int e = 0; e < 8; ++e) { float acc = bias;
#pragma unroll
            for (int tap = 0; tap < 31; ++tap) acc += w[tap] * vt[(tb + e + tap) * 256 + c];
            o[e] = acc; }
#pragma unroll
        for (int e = 0; e < 8; ++e) { const float s1 = wave_sum(o[e]); if (lane == 0) red1[(tb + e) * 4 + wq] = s1; }
        __syncthreads();
#pragma unroll
        for (int e = 0; e < 8; ++e) { const LAS float* r = red1 + (tb + e) * 4; const float mean = ((r[0] + r[1]) + (r[2] + r[3])) * (1.f / 256.f); o[e] -= mean;
            const float s2 = wave_sum(o[e] * o[e]); if (lane == 0) red2[(tb + e) * 4 + wq] = s2; }
        __syncthreads();
#pragma unroll
        for (int e = 0; e < 8; ++e) { const LAS float* r = red2 + (tb + e) * 4; const float var = ((r[0] + r[1]) + (r[2] + r[3])) * (1.f / 256.f);
            const float y = o[e] / sqrtf(var + 1e-5f) * lg + lb; const float z = y / (1.f + __expf(-y));
            cva[(size_t)(seqbase + t0 + tb + e) * 256 + c] = (bf16)(pk2(z, 0.f) & 0xffffu); }
    }
}
#define MFMA32(a, b, c) __builtin_amdgcn_mfma_f32_32x32x16_bf16((a), (b), (c), 0, 0, 0)
template <bool LOCAL> DI void attn_tile(const char* kb, unsigned koff, const char* vb, unsigned voff, unsigned dstr, const bf16x8 (&qf)[2][4], f32x16 (&o)[2][2], float (&m)[2], float (&ls)[2],
                                        const LAS float* bl, int lt, int ql, int half) {
    const float SCL = 0.125f * 1.4426950408889634f, NINF = -__builtin_inff();
    bf16x8 kf[4];
#pragma unroll
    for (int ks = 0; ks < 4; ++ks) kf[ks] = *(const bf16x8*)(kb + koff + 16 * ks);
    bf16x8 vf[2][2];
#pragma unroll
    for (int dt = 0; dt < 2; ++dt)
#pragma unroll
        for (int t = 0; t < 2; ++t) { const s16x4 lo = *(const s16x4*)(vb + voff + dt * dstr + 32 * t), hi = *(const s16x4*)(vb + voff + dt * dstr + 32 * t + 16);
            vf[dt][t] = (bf16x8){lo.x, lo.y, lo.z, lo.w, hi.x, hi.y, hi.z, hi.w}; }
#pragma unroll
    for (int qt = 0; qt < 2; ++qt) {
        f32x16 sv;
#pragma unroll
        for (int v = 0; v < 16; ++v) sv[v] = 0.f;
#pragma unroll
        for (int ks = 0; ks < 4; ++ks) sv = MFMA32(kf[ks], qf[qt][ks], sv);
        float mx = NINF;
        if (LOCAL) {
            const int qc = qt * 32 + ql, cs = min(max(qc - 8, 0), 48);
            const int kc0 = (lt & 1) * 32 + 4 * half;
            const int d0 = kc0 - cs, b0 = (lt >> 1) * 31 + kc0 - qc + 15;
#pragma unroll
            for (int v = 0; v < 16; ++v) { const int dv = (v & 3) + 8 * (v >> 2); const bool valid = (unsigned)(d0 + dv) < 16u;
                const int bi = min(max(b0 + dv, 0), 247); const float bias = bl[bi];
                const float x = valid ? sv[v] * SCL + bias : NINF; sv[v] = x; mx = fmaxf(mx, x); }
        } else {
#pragma unroll
            for (int v = 0; v < 16; ++v) { const float x = sv[v] * SCL; sv[v] = x; mx = fmaxf(mx, x); }
        }
        mx = fmaxf(mx, __shfl_xor(mx, 32));
        const float mn = fmaxf(m[qt], mx), alpha = __builtin_amdgcn_exp2f(m[qt] - mn); m[qt] = mn;
        float sum = 0.f;
#pragma unroll
        for (int v = 0; v < 16; ++v) { const float pv = __builtin_amdgcn_exp2f(sv[v] - mn); sv[v] = pv; sum += pv; }
        ls[qt] = ls[qt] * alpha + sum;
#pragma unroll
        for (int dt = 0; dt < 2; ++dt)
#pragma unroll
            for (int v = 0; v < 16; ++v) o[dt][qt][v] *= alpha;
#pragma unroll
        for (int t = 0; t < 2; ++t) { u32x4 pw; pw.x = pk2(sv[8 * t + 0], sv[8 * t + 1]); pw.y = pk2(sv[8 * t + 2], sv[8 * t + 3]); pw.z = pk2(sv[8 * t + 4], sv[8 * t + 5]); pw.w = pk2(sv[8 * t + 6], sv[8 * t + 7]);
            const bf16x8 pf = __builtin_bit_cast(bf16x8, pw);
#pragma unroll
            for (int dt = 0; dt < 2; ++dt) o[dt][qt] = MFMA32(vf[dt][t], pf, o[dt][qt]); }
    }
}
DI void attn_item(const PP p, int layer, int b, int qbase, int nloc, int r, LAS unsigned char* lds, const int tid_, const int bid_) {
    const int tid = tid_, lane = tid & 63, h = tid >> 6, ql = lane & 31, half = lane >> 5;
    const char* UrmB = (const char*)(p.ws() + WS_URM); const char* VtL = (const char*)(p.ws() + WS_VTL); const char* VtC = (const char*)(p.ws() + WS_VTC);
    bf16* mix = (bf16*)(p.ws() + WS_MIX);
    LAS float* bl = (LAS float*)(lds + h * 1024);
    const int rs = min(max(r - 4, 0), 24);
    const float LOG2E = 1.4426950408889634f, NINF = -__builtin_inff();
    __syncthreads();
    if (nloc) { const float* rp = p.in(16) + (size_t)(layer * 8 + h) * 465;
        for (int i = lane; i < 248; i += 64) { const int kr = i / 31, co = i - kr * 31; bl[i] = rp[(rs - r + 7 + kr) * 31 + co] * LOG2E; } }
    __syncthreads();
    bf16x8 qf[2][4];
#pragma unroll
    for (int qt = 0; qt < 2; ++qt) { const unsigned qoff = (unsigned)((qbase + qt * 32 + ql) * URM + 512 + h * 64 + 32 * half) * 2u;
#pragma unroll
        for (int ks = 0; ks < 4; ++ks) qf[qt][ks] = *(const bf16x8*)(UrmB + qoff + 16 * ks); }
    f32x16 o[2][2];
#pragma unroll
    for (int a = 0; a < 2; ++a)
#pragma unroll
        for (int c = 0; c < 2; ++c)
#pragma unroll
            for (int v = 0; v < 16; ++v) o[a][c][v] = 0.f;
    float m[2] = {NINF, NINF}, ls[2] = {0.f, 0.f};
    {
        unsigned koff = (unsigned)((TL + b * CTX + ql) * URM + 1024 + h * 64 + 32 * half) * 2u;
        unsigned voff = (unsigned)((b * 512 + h * 64 + ql) * CTX + 4 * half) * 2u;
        for (int tile = 0; tile < 8; ++tile) { attn_tile<false>(UrmB, koff, VtC, voff, 32u * CTX * 2u, qf, o, m, ls, bl, 0, ql, half); koff += 32u * URM * 2u; voff += 64u; }
    }
    if (nloc) {
        unsigned koff = (unsigned)((b * SEQ + rs * 64 + ql) * URM + 1024 + h * 64 + 32 * half) * 2u;
        unsigned voff = (unsigned)((b * 512 + h * 64 + ql) * SEQ + rs * 64 + 4 * half) * 2u;
        for (int lt = 0; lt < nloc; ++lt) { attn_tile<true>(UrmB, koff, VtL, voff, 32u * SEQ * 2u, qf, o, m, ls, bl, lt, ql, half); koff += 32u * URM * 2u; voff += 64u; }
    }
#pragma unroll
    for (int qt = 0; qt < 2; ++qt) { const float lt_ = ls[qt] + __shfl_xor(ls[qt], 32); const float inv = 1.f / lt_; const int token = qbase + qt * 32 + ql;
#pragma unroll
        for (int dt = 0; dt < 2; ++dt)
#pragma unroll
            for (int i = 0; i < 4; ++i) { const int d = dt * 32 + 8 * i + 4 * half; u32x2 w; w.x = pk2(o[dt][qt][4 * i] * inv, o[dt][qt][4 * i + 1] * inv); w.y = pk2(o[dt][qt][4 * i + 2] * inv, o[dt][qt][4 * i + 3] * inv);
                *(u32x2*)(mix + (size_t)token * D + 512 + h * 64 + d) = w; } }
}
DI void run_phase(const PP p, int ph, LAS unsigned char* lds, const int tid, const int c) {
    const int G = gridDim.x;
    if (ph == 0) { phase_mods(p, lds, tid, c); make_tables(p, tid, c); conv_weights(p, 0, lds, tid, c); return; }
    if (ph == NPH - 1) { phase_final(p, tid, c); return; }
    const int layer = (ph - 1) >> 3, sub = (ph - 1) & 7;
    const int M = layer == 0 ? TA : TL;
    if (sub == 0) { if (layer == 1) conv_weights(p, 1, lds, tid, c); phase_norm(p, layer, 0, TA, tid, c); return; }
    if (sub == 5) { phase_norm(p, layer, 1, M, tid, c); return; }
    const int H = G / 2 > 0 ? G / 2 : 1;
#pragma unroll 1
    for (int j = 0; j < 2; ++j) {
        unsigned char* ws = p.ws();
        const bf16* A = nullptr; const bf16* Bt = nullptr; int K = 0, nM = 0, nN = 0, cc = c, pmadd = 0, mode = 0; bool valid = true;
        if (sub == 1) {
            if (j == 0) { A = (const bf16*)(ws + WS_HN); Bt = (const bf16*)(ws + WS_WIN) + (size_t)256 * D; K = D; nM = TA / 256; nN = 6; mode = M_URM; }
            else { A = (const bf16*)(ws + WS_WIN); Bt = (const bf16*)(ws + WS_HN); K = D; nM = 3; nN = TA / 256; cc = (c + (G - (432 % G))) % G; pmadd = 6; mode = M_SWAP; }
        } else if (sub == 2) {
            if (j == 0) { A = (const bf16*)(ws + WS_DFTL); Bt = (const bf16*)(ws + WS_UTL); K = SEQ; nM = 16; nN = 8; mode = M_DFTL; }
            else { A = (const bf16*)(ws + WS_DFTC); Bt = (const bf16*)(ws + WS_UTC); K = CTX; nM = 2; nN = 8; cc = (c + H) % G; mode = M_DFTC; valid = (layer == 0); }
        } else if (sub == 3) {
            if (j == 0) { A = (const bf16*)(ws + WS_G12); Bt = (const bf16*)(ws + WS_WF2); K = 512; nM = M / 256; nN = 1; mode = M_MIXF; }
            else { A = (const bf16*)(ws + WS_CVA); Bt = (const bf16*)(ws + WS_WPW); K = 256; nM = M / 256; nN = 1; cc = (c + G - ((M / 256) % G)) % G; mode = M_MIXC; }
        } else if (sub == 4) { A = (const bf16*)(ws + WS_MIX); Bt = (const bf16*)(ws + WS_WOUT); K = D; nM = M / 256; nN = 4; mode = M_RES1; valid = (j == 0); }
        else if (sub == 6) { A = (const bf16*)(ws + WS_HN); Bt = (const bf16*)(ws + WS_W1); K = D; nM = M / 256; nN = 16; mode = M_HID; valid = (j == 0); }
        else { A = (const bf16*)(ws + WS_HID); Bt = (const bf16*)(ws + WS_W2); K = DFF; nM = M / 256; nN = 4; mode = M_RES2; valid = (j == 0); }
        if (valid) { Sched S; S.init(nM, nN, G, cc); S.pmadd = pmadd; run_gemm(lds, A, Bt, K, S, mode, layer, p, tid); }
    }
    if (sub == 2) {
        if (c < H) {
            const int nconv = layer == 0 ? 288 : 256;
            for (int it = c; it < nconv; it += H) {
                const bool lat = it < 256; const int i2 = it - 256;
                conv_tile(p, layer, lat ? (it >> 5) * SEQ : TL + (i2 >> 2) * CTX, lat ? SEQ : CTX, lat ? (it & 31) * 64 : (i2 & 3) * 64, lds, tid, c);
            }
        }
        const int natt = (c >= H) ? 256 : (layer == 0 ? 32 : 0);
        const int a0 = (c >= H) ? c - H : c, astep = (c >= H) ? G - H : H;
#pragma unroll 1
        for (int it = a0; it < natt; it += astep) {
            if (c >= H) attn_item(p, layer, it >> 5, (it >> 5) * SEQ + (it & 31) * 64, 16, it & 31, lds, tid, c);
            else attn_item(p, layer, it >> 2, TL + (it >> 2) * CTX + (it & 3) * 64, 0, 0, lds, tid, c);
        }
    }
}

__global__ void __launch_bounds__(512, 2) fwd_kernel(Params prm) {
    extern __shared__ __attribute__((aligned(16))) unsigned char lds_raw[];
    LAS unsigned char* lds = (LAS unsigned char*)lds_raw;
    {
        const unsigned long long* ka = (const unsigned long long*)__builtin_amdgcn_kernarg_segment_ptr();
        if (threadIdx.x < 23) ((LAS unsigned long long*)(lds + LDSP_OFF))[threadIdx.x] = ka[threadIdx.x];
    }
    __syncthreads();
    PP p; p.P = (const LAS unsigned long long*)(lds + LDSP_OFF);
    const int lo = prm.ph_lo, hi = prm.ph_hi;
#pragma unroll 1
    for (int ph = lo; ph < hi; ++ph) {
        if (ph > lo) cg::this_grid().sync();
        int tid = threadIdx.x, bid = blockIdx.x;
        asm volatile("" : "+v"(tid));
        asm volatile("" : "+s"(bid));
        run_phase(p, ph, lds, tid, bid);
        __syncthreads();
    }
}

extern "C" void kernel_launch(void* const* d_in, const int* in_sizes, int n_in, void* d_out, int out_size, void* d_ws, size_t ws_size, hipStream_t stream) {
    static int grid = 0;
    if (grid == 0) {
        if (n_in != 21 || ws_size < WS_END) { fprintf(stderr, "kernel_launch: unexpected n_in %d / ws_size %zu\n", n_in, ws_size); grid = -1; return; }
        int dev = 0, cus = 0, per_cu = 0;
        (void)hipGetDevice(&dev); (void)hipDeviceGetAttribute(&cus, hipDeviceAttributeMultiprocessorCount, dev);
        (void)hipFuncSetAttribute((const void*)fwd_kernel, hipFuncAttributeMaxDynamicSharedMemorySize, LDS_BYTES);
        (void)hipOccupancyMaxActiveBlocksPerMultiprocessor(&per_cu, (const void*)fwd_kernel, 512, LDS_BYTES);
        if (per_cu < 1) { fprintf(stderr, "kernel_launch: occupancy query says %d blocks/CU\n", per_cu); per_cu = 1; }
        (void)hipGetLastError();
        grid = cus > 0 ? cus : 256;
    }
    if (grid < 0) return;
    Params p{};
    for (int i = 0; i < 21; ++i) p.in[i] = (const float*)d_in[i];
    p.out = (float*)d_out; p.ws = (unsigned char*)d_ws;
#if SINGLE_LAUNCH
    p.ph_lo = 0; p.ph_hi = NPH;
    void* args[] = {&p};
    hipError_t e = hipLaunchCooperativeKernel((const void*)fwd_kernel, dim3(grid), dim3(512), args, LDS_BYTES, stream);
    if (e != hipSuccess) fprintf(stderr, "cooperative launch failed: %s (grid %d)\n", hipGetErrorString(e), grid);
#else
    for (int ph = 0; ph < NPH; ++ph) { p.ph_lo = ph; p.ph_hi = ph + 1; hipLaunchKernelGGL(fwd_kernel, dim3(grid), dim3(512), LDS_BYTES, stream, p); }
#endif
}
```

```cpp
#include <hip/hip_runtime.h>
#include <hip/hip_cooperative_groups.h>
#include <cstdio>
#include <cstdint>
namespace cg = cooperative_groups;
namespace pg8 {
#define PG8_LAS __attribute__((address_space(3)))
typedef unsigned short bf16_t;
typedef short bf16x8 __attribute__((ext_vector_type(8)));
typedef float f32x4 __attribute__((ext_vector_type(4)));
typedef unsigned u32x4 __attribute__((ext_vector_type(4)));
constexpr int BM = 256, BK = 64, HALF = 128, HTB = HALF * BK * 2  , STAGE_BYTES = 8 * HTB, NXCD = 8, WGM = 8;

__host__ __device__ __forceinline__ int lds_byte(int r, int c) { const int st = (r >> 4) * 2 + (c >> 5), rr = r & 15, cc = c & 31, ob = rr * 64 + cc * 2; return st * 1024 + (ob ^ (((ob >> 9) & 1) << 5)); }
__host__ __device__ __forceinline__ void stage_rc(int b, int& R, int& C) { const int st = b / 1024, sb = b % 1024, swz = sb ^ (((sb >> 9) & 1) << 5); R = (st >> 1) * 16 + swz / 64; C = (st & 1) * 32 + (swz % 64) / 2; }
__host__ __device__ __forceinline__ int perm32(int rho) { const int n = rho >> 4, i = rho & 15; return 8 * (i >> 2) + 4 * n + (i & 3); }

struct Unit { int pm, pn; };
struct Gemm { const bf16_t* A; const bf16_t* Bt; int M, N, K; };

struct StaticOrder {
    int nM, nN, nwg, G, c;
    __host__ __device__ void init(int M, int N, int G_, int c_) { nM = M / BM; nN = N / BM; nwg = nM * nN; G = G_; c = c_; }
    __host__ __device__ bool next(int i, Unit& u) const {
        const long L = (long)i * G + c; if (L >= nwg) return false;
        int wgid = (int)L; { const int q = nwg / NXCD, r = nwg % NXCD, xcd = wgid % NXCD, off = wgid / NXCD; wgid = (xcd < r ? xcd * (q + 1) : r * (q + 1) + (xcd - r) * q) + off; }
        const int nig = WGM * nN, gid = wgid / nig, fm = gid * WGM, gsz = (nM - fm) < WGM ? (nM - fm) : WGM;
        u.pm = fm + ((wgid % nig) % gsz); u.pn = (wgid % nig) / gsz; return true;
    }
    __device__ __forceinline__ void a_ready(const Unit&) const {}
    __device__ __forceinline__ void done(const Unit&) const {}
};

template <class Epi, class Sched, bool ALIGN_EPI = false, bool SP2 = false>
__device__ __forceinline__ void gemm_phase(PG8_LAS unsigned char* lds, const Gemm g, const Sched& S, const Epi& E, const int tid_in) {
    const int tid = tid_in, wid = __builtin_amdgcn_readfirstlane(tid >> 6), lane = tid & 63, wr = wid >> 2, wc = wid & 3, fr = lane & 15, fq = lane >> 4;
    const int K = g.K, nt = K / BK;
    unsigned voffA[2], voffB[2];
#pragma unroll
    for (int i = 0; i < 2; ++i) { int R, C; stage_rc(tid * 16 + i * 8192, R, C); const int Rb = Epi::PERM ? ((R & ~31) + perm32(R & 31)) : R;
        voffA[i] = (unsigned)(R * K + C) * 2u; voffB[i] = (unsigned)(Rb * K + C) * 2u; }
    const size_t kstep = (size_t)(BK * 2);
    const size_t hstep = (size_t)HALF * K * 2;
    const size_t tstep = 2 * hstep;
    const unsigned ldsw = (unsigned)wid * 1024u;
    const int aoff = lds_byte(wr * 64 + fr, fq * 8), boff = lds_byte(wc * 32 + fr, fq * 8);
#define PG8_SA(b, h) (((b) * 2 + (h)) * HTB)
#define PG8_SB(b, h) ((4 + (b) * 2 + (h)) * HTB)
#define PG8_STAGE(bufoff, gbase, voff) do { _Pragma("unroll") for (int _i = 0; _i < 2; ++_i) \
        __builtin_amdgcn_global_load_lds((const unsigned*)((const char*)(gbase) + (voff)[_i]), (PG8_LAS unsigned*)(lds + (bufoff) + ldsw + _i * 8192), 16, 0, 0); } while (0)
#define PG8_LDA(dst, b, h) do { _Pragma("unroll") for (int m = 0; m < 4; ++m) _Pragma("unroll") for (int k = 0; k < 2; ++k) dst[m][k] = *(const PG8_LAS bf16x8*)(lds + PG8_SA(b, h) + aoff + m * 2048 + k * 1024); } while (0)
#define PG8_LDB(dst, b, h) do { _Pragma("unroll") for (int n = 0; n < 2; ++n) _Pragma("unroll") for (int k = 0; k < 2; ++k) dst[n][k] = *(const PG8_LAS bf16x8*)(lds + PG8_SB(b, h) + boff + n * 2048 + k * 1024); } while (0)
#define PG8_MMA(ai, bj, At, Bt) do { __builtin_amdgcn_s_setprio(1); _Pragma("unroll") for (int m = 0; m < 4; ++m) _Pragma("unroll") for (int n = 0; n < 2; ++n) _Pragma("unroll") for (int k = 0; k < 2; ++k) \
        acc[ai][bj][m][n] = __builtin_amdgcn_mfma_f32_16x16x32_bf16(Bt[n][k], At[m][k], acc[ai][bj][m][n], 0, 0, 0); __builtin_amdgcn_s_setprio(0); } while (0)
#define PG8_WAIT_V(n) asm volatile("s_waitcnt vmcnt(" #n ")" ::: "memory")
#define PG8_WAIT_L(n) asm volatile("s_waitcnt lgkmcnt(" #n ")" ::: "memory")
#define PG8_BAR __builtin_amdgcn_s_barrier()
#define PG8_SCHED __builtin_amdgcn_sched_barrier(0)
    Unit cur, nxt; int ui = 0;
    if (!S.next(0, cur)) return;
    f32x4 acc[2][2][4][2];
#pragma unroll
    for (int a = 0; a < 2; ++a)
#pragma unroll
        for (int b = 0; b < 2; ++b)
#pragma unroll
            for (int m = 0; m < 4; ++m)
#pragma unroll
                for (int n = 0; n < 2; ++n) acc[a][b][m][n] = (f32x4){0.f, 0.f, 0.f, 0.f};
    bf16x8 At[4][2], B0[2][2], B1[2][2];
    const char* cA = (const char*)g.A + (size_t)cur.pm * tstep; const char* cB = (const char*)g.Bt + (size_t)cur.pn * tstep;
    S.a_ready(cur);
    if constexpr (SP2) {
        PG8_STAGE(PG8_SB(0, 0), cB, voffB); PG8_STAGE(PG8_SB(0, 1), cB + hstep, voffB); PG8_STAGE(PG8_SA(0, 0), cA, voffA); PG8_STAGE(PG8_SA(0, 1), cA + hstep, voffA);
        if (wr == 1) PG8_BAR;
        PG8_WAIT_V(2); PG8_BAR;
        PG8_STAGE(PG8_SB(1, 0), cB + kstep, voffB); PG8_STAGE(PG8_SA(1, 0), cA + kstep, voffA); PG8_STAGE(PG8_SB(1, 1), cB + hstep + kstep, voffB);
        PG8_WAIT_V(6); PG8_BAR;
    } else {
        PG8_STAGE(PG8_SB(0, 0), cB, voffB); PG8_STAGE(PG8_SA(0, 0), cA, voffA); PG8_STAGE(PG8_SB(0, 1), cB + hstep, voffB); PG8_STAGE(PG8_SA(0, 1), cA + hstep, voffA);
        if (wr == 1) PG8_BAR;
        PG8_WAIT_V(4); PG8_BAR;
        PG8_STAGE(PG8_SB(1, 0), cB + kstep, voffB); PG8_STAGE(PG8_SA(1, 0), cA + kstep, voffA); PG8_STAGE(PG8_SB(1, 1), cB + hstep + kstep, voffB);
        PG8_WAIT_V(6); PG8_BAR;
    }
    for (;;) {
        const bool has_next = S.next(ui + 1, nxt);
        const char* nA = has_next ? (const char*)g.A + (size_t)nxt.pm * tstep : cA; const char* nB = has_next ? (const char*)g.Bt + (size_t)nxt.pn * tstep : cB;
        for (int t = 0; t < nt; t += 2) {
            const bool last = (t == nt - 2);
            const char* a1 = cA + (size_t)(t + 1) * kstep;
            const char* a2 = last ? nA : cA + (size_t)(t + 2) * kstep; const char* b2 = last ? nB : cB + (size_t)(t + 2) * kstep;
            const char* a3 = a2 + kstep; const char* b3 = b2 + kstep;
            if (last && has_next) S.a_ready(nxt);
            if constexpr (SP2) {
            PG8_LDB(B0, 0, 0); PG8_LDB(B1, 0, 1); PG8_SCHED; PG8_LDA(At, 0, 0); PG8_STAGE(PG8_SA(1, 1), a1 + hstep, voffA);
            PG8_WAIT_V(8); PG8_WAIT_L(0); PG8_BAR; PG8_MMA(0, 0, At, B0); PG8_MMA(0, 1, At, B1); PG8_BAR; PG8_SCHED;
            PG8_LDA(At, 0, 1); PG8_STAGE(PG8_SB(0, 0), b2, voffB); PG8_STAGE(PG8_SB(0, 1), b2 + hstep, voffB); PG8_STAGE(PG8_SA(0, 0), a2, voffA);
            PG8_WAIT_V(8); PG8_WAIT_L(0); PG8_BAR; PG8_MMA(1, 0, At, B0); PG8_MMA(1, 1, At, B1); PG8_BAR; PG8_SCHED;
            PG8_LDB(B0, 1, 0); PG8_LDB(B1, 1, 1); PG8_SCHED; PG8_LDA(At, 1, 0); PG8_STAGE(PG8_SA(0, 1), a2 + hstep, voffA);
            PG8_WAIT_V(8); PG8_WAIT_L(0); PG8_BAR; PG8_MMA(0, 0, At, B0); PG8_MMA(0, 1, At, B1); PG8_BAR; PG8_SCHED;
            PG8_LDA(At, 1, 1); PG8_STAGE(PG8_SB(1, 0), b3, voffB); PG8_STAGE(PG8_SB(1, 1), b3 + hstep, voffB); PG8_STAGE(PG8_SA(1, 0), a3, voffA);
            PG8_WAIT_V(8); PG8_WAIT_L(0); PG8_BAR; PG8_MMA(1, 0, At, B0); PG8_MMA(1, 1, At, B1); PG8_BAR; PG8_SCHED;
            } else {
            PG8_LDB(B0, 0, 0); PG8_SCHED; PG8_LDA(At, 0, 0); PG8_STAGE(PG8_SA(1, 1), a1 + hstep, voffA);
            PG8_WAIT_L(8); PG8_BAR; PG8_WAIT_L(0); PG8_MMA(0, 0, At, B0); PG8_BAR; PG8_SCHED;
            PG8_LDB(B1, 0, 1); PG8_STAGE(PG8_SB(0, 0), b2, voffB);
            PG8_BAR; PG8_WAIT_L(0); PG8_MMA(0, 1, At, B1); PG8_BAR;
            PG8_LDA(At, 0, 1); PG8_STAGE(PG8_SA(0, 0), a2, voffA);
            PG8_BAR; PG8_WAIT_L(0); PG8_MMA(1, 0, At, B0); PG8_BAR; PG8_SCHED;
            PG8_STAGE(PG8_SB(0, 1), b2 + hstep, voffB);
            PG8_WAIT_V(6); PG8_BAR; PG8_MMA(1, 1, At, B1); PG8_BAR;
            PG8_LDB(B0, 1, 0); PG8_SCHED; PG8_LDA(At, 1, 0); PG8_STAGE(PG8_SA(0, 1), a2 + hstep, voffA);
            PG8_WAIT_L(8); PG8_BAR; PG8_WAIT_L(0); PG8_MMA(0, 0, At, B0); PG8_BAR; PG8_SCHED;
            PG8_LDB(B1, 1, 1); PG8_STAGE(PG8_SB(1, 0), b3, voffB);
            PG8_BAR; PG8_WAIT_L(0); PG8_MMA(0, 1, At, B1); PG8_BAR;
            PG8_LDA(At, 1, 1); PG8_STAGE(PG8_SA(1, 0), a3, voffA);
            PG8_BAR; PG8_WAIT_L(0); PG8_MMA(1, 0, At, B0); PG8_BAR; PG8_SCHED;
            PG8_STAGE(PG8_SB(1, 1), b3 + hstep, voffB);
            PG8_WAIT_V(6); PG8_BAR; PG8_MMA(1, 1, At, B1); PG8_BAR;
            }
        }
        if constexpr (ALIGN_EPI) { if (wr == 0) PG8_BAR; }
        if constexpr (!Epi::AFTER_DRAIN) { E(acc, cur, wr, wc, fr, fq); S.done(cur); }
        if (!has_next) break;
#pragma unroll
        for (int a = 0; a < 2; ++a)
#pragma unroll
            for (int b = 0; b < 2; ++b)
#pragma unroll
                for (int m = 0; m < 4; ++m)
#pragma unroll
                    for (int n = 0; n < 2; ++n) acc[a][b][m][n] = (f32x4){0.f, 0.f, 0.f, 0.f};
        cur = nxt; cA = nA; cB = nB; ++ui;
        if constexpr (ALIGN_EPI) { if (wr == 1) PG8_BAR; }
    }
    PG8_WAIT_V(0);
    if constexpr (!ALIGN_EPI) { if (wr == 0) PG8_BAR; }
    PG8_BAR;
    if constexpr (Epi::AFTER_DRAIN) { E.fused(acc, cur, wr, wc, fr, fq, lds, wid, lane); S.done(cur); }
#undef PG8_SA
#undef PG8_SB
#undef PG8_STAGE
#undef PG8_LDA
#undef PG8_LDB
#undef PG8_MMA
#undef PG8_WAIT_V
#undef PG8_WAIT_L
#undef PG8_BAR
#undef PG8_SCHED
}
}

#define LAS __attribute__((address_space(3)))
#define DI __device__ __forceinline__
typedef unsigned short bf16;
typedef short bf16x8 __attribute__((ext_vector_type(8)));
typedef short s16x4 __attribute__((ext_vector_type(4)));
typedef float f32x4 __attribute__((ext_vector_type(4)));
typedef float f32x16 __attribute__((ext_vector_type(16)));
typedef unsigned u32x4 __attribute__((ext_vector_type(4)));
typedef unsigned u32x2 __attribute__((ext_vector_type(2)));
typedef __bf16 bf16x2_t __attribute__((ext_vector_type(2)));
typedef float f32x2_t __attribute__((ext_vector_type(2)));
#define GAS __attribute__((address_space(1)))
typedef GAS float gfloat; typedef GAS unsigned short gbf16; typedef GAS char gchar; typedef GAS unsigned char guchar;

#ifndef SINGLE_LAUNCH
#define SINGLE_LAUNCH 1
#endif

constexpr int D = 1024, NB = 8, SEQ = 2048, CTX = 256, TL = NB * SEQ, TC = NB * CTX, TA = TL + TC;
constexpr int DIN = 2304, DFF = 4096, URM = 1024;
constexpr int NPH = 18;
constexpr int LDS_BYTES = 147456;
constexpr size_t MiB = 1u << 20;
constexpr size_t WS_CTL = 0, WS_MODS = 1 * MiB;
constexpr size_t WS_WIN = 2 * MiB, WS_WOUT = WS_WIN + (size_t)DIN * D * 2, WS_W1 = WS_WOUT + 2 * MiB, WS_W2 = WS_W1 + 8 * MiB, WS_WPW = WS_W2 + 8 * MiB, WS_WF2 = WS_WPW + 128 * 1024;
constexpr size_t WS_DFTL = 25 * MiB, WS_DFTC = 41 * MiB, WS_HCTX = 42 * MiB, WS_HN = 50 * MiB, WS_OV = 86 * MiB;
constexpr size_t WS_URM = WS_OV, WS_UTL = WS_OV + 36 * MiB, WS_UTC = WS_UTL + 8 * MiB, WS_KT = WS_UTC + 1 * MiB, WS_VT = WS_KT + 18 * MiB,
                 WS_G12 = WS_VT + 18 * MiB, WS_CVA = WS_G12 + 18 * MiB, WS_MIX = WS_CVA + 9 * MiB, WS_HID = WS_OV, WS_END = WS_OV + 144 * MiB;
static_assert(WS_WF2 + 256 * 1024 <= WS_DFTL && WS_MIX + 36 * MiB == WS_END && WS_END <= 256 * MiB, "ws map");

struct Params { const float* in[21]; float* out; unsigned char* ws; int ph_lo, ph_hi; };
constexpr int LDSP_OFF = 131072;
struct PP {
    const __attribute__((address_space(3))) unsigned long long* P;
    __device__ __forceinline__ unsigned long long ld(int i) const { const unsigned long long v = P[i]; const unsigned lo = __builtin_amdgcn_readfirstlane((unsigned)v), hi = __builtin_amdgcn_readfirstlane((unsigned)(v >> 32)); return ((unsigned long long)hi << 32) | lo; }
    __device__ __forceinline__ const gfloat* in(int i) const { return (const gfloat*)ld(i); }
    __device__ __forceinline__ gfloat* out() const { return (gfloat*)ld(21); }
    __device__ __forceinline__ unsigned char* ws() const { return (unsigned char*)ld(22); }
};

DI unsigned pk2(float lo, float hi) { f32x2_t v = {lo, hi}; bf16x2_t b = __builtin_convertvector(v, bf16x2_t); return __builtin_bit_cast(unsigned, b); }
DI float bf2f(short x) { return __builtin_bit_cast(float, ((unsigned)(unsigned short)x) << 16); }
DI float wave_sum(float v) {
#pragma unroll
    for (int o = 1; o < 64; o <<= 1) v += __shfl_xor(v, o);
    return v;
}
#define LDS_WAIT() asm volatile("s_waitcnt lgkmcnt(0)" ::: "memory")

struct Sched {
    int nM, nN, nwg, G, c, pmadd;
    DI void init(int nM_, int nN_, int G_, int c_) { nM = nM_; nN = nN_; nwg = nM_ * nN_; G = G_; c = c_; pmadd = 0; }
    DI bool next(int i, pg8::Unit& u) const {
        const long L = (long)i * G + c; if (L >= nwg) return false;
        int wgid = (int)L; { const int q = nwg / 8, r = nwg % 8, xcd = wgid % 8, off = wgid / 8; wgid = (xcd < r ? xcd * (q + 1) : r * (q + 1) + (xcd - r) * q) + off; }
        const int nig = 8 * nN, gid = wgid / nig, fm = gid * 8, gsz = (nM - fm) < 8 ? (nM - fm) : 8;
        u.pm = fm + ((wgid % nig) % gsz); u.pn = (wgid % nig) / gsz;
        if (u.pm > 0) u.pm += pmadd;
        return true;
    }
    DI void a_ready(const pg8::Unit&) const {}
    DI void done(const pg8::Unit&) const {}
};

template <int ACT> DI void store_tile_bf16(const pg8::f32x4 (&acc)[2][2][4][2], gbf16* base, int ld, const gfloat* bias, int wr, int wc, int fr, int fq) {
    const unsigned loff = (unsigned)((wr * 64 + fr) * ld + wc * 32 + 8 * fq) * 2u;
    f32x4 bv[2][2];
#pragma unroll
    for (int bj = 0; bj < 2; ++bj)
#pragma unroll
        for (int n = 0; n < 2; ++n) bv[bj][n] = bias ? *(const GAS f32x4*)(bias + wc * 32 + 8 * fq + bj * 128 + 4 * n) : (f32x4){0.f, 0.f, 0.f, 0.f};
#pragma unroll
    for (int ai = 0; ai < 2; ++ai)
#pragma unroll
        for (int m = 0; m < 4; ++m) { gchar* rowp = (gchar*)base + (size_t)((ai * 128 + m * 16) * ld) * 2u;
#pragma unroll
            for (int bj = 0; bj < 2; ++bj) { f32x4 a = acc[ai][bj][m][0] + bv[bj][0], b = acc[ai][bj][m][1] + bv[bj][1];
                if (ACT == 1) {
#pragma unroll
                    for (int e = 0; e < 4; ++e) { const float x = fmaxf(a[e], 0.f); a[e] = x * x; const float y = fmaxf(b[e], 0.f); b[e] = y * y; } }
                u32x4 w; w.x = pk2(a.x, a.y); w.y = pk2(a.z, a.w); w.z = pk2(b.x, b.y); w.w = pk2(b.z, b.w);
                *(GAS u32x4*)(rowp + bj * 256 + loff) = w; } }
}
DI void store_kfrag(const pg8::f32x4 (&acc)[2][2][4][2], gbf16* base, int wr, int wc, int fr, int fq) {
    const unsigned loff = (unsigned)(wr * 2 * 16384 + (wc >> 1) * 2048 + fq * 512 + (wc & 1) * 256 + fr * 8) * 2u;
#pragma unroll
    for (int ai = 0; ai < 2; ++ai)
#pragma unroll
        for (int m = 0; m < 4; ++m)
#pragma unroll
            for (int bj = 0; bj < 2; ++bj) { const f32x4 a = acc[ai][bj][m][0], b = acc[ai][bj][m][1];
                u32x4 w; w.x = pk2(a.x, a.y); w.y = pk2(a.z, a.w); w.z = pk2(b.x, b.y); w.w = pk2(b.z, b.w);
                *(GAS u32x4*)((gchar*)base + (size_t)((ai * 4 + (m >> 1)) * 16384 + bj * 2 * 2048 + (m & 1) * 128) * 2u + loff) = w; }
}
DI void store_vfrag(const pg8::f32x4 (&acc)[2][2][4][2], gbf16* base, int wr, int wc, int fr, int fq) {
    const unsigned loff = (unsigned)(wc * 8 * 2048 + wr * 2048 + (fq >> 1) * 512 + fr * 8 + (fq & 1) * 4) * 2u;
#pragma unroll
    for (int ai = 0; ai < 2; ++ai)
#pragma unroll
        for (int m = 0; m < 4; ++m)
#pragma unroll
            for (int bj = 0; bj < 2; ++bj) { const f32x4 a = acc[ai][bj][m][0], b = acc[ai][bj][m][1];
                gchar* q = (gchar*)base + (size_t)(bj * 32 * 2048 + ai * 2 * 2048 + (m >> 1) * 1024 + (m & 1) * 128) * 2u + loff;
                u32x2 w0; w0.x = pk2(a.x, a.y); w0.y = pk2(a.z, a.w); u32x2 w1; w1.x = pk2(b.x, b.y); w1.y = pk2(b.z, b.w);
                *(GAS u32x2*)q = w0; *(GAS u32x2*)(q + 512) = w1; }
}
enum { M_URM = 0, M_SWAP, M_DFTL, M_DFTC, M_MIXF, M_MIXC, M_RES1, M_RES2, M_HID };
struct UEpi {
    static constexpr bool PERM = true, AFTER_DRAIN = false;
    int mode, layer; PP p;
    DI void operator()(const pg8::f32x4 (&acc)[2][2][4][2], const pg8::Unit& u, int wr, int wc, int fr, int fq) const {
        unsigned char* ws = p.ws();
        if (mode == M_RES1 || mode == M_RES2) {
            const bool first = (mode == M_RES1 && layer == 0);
            const int row0 = u.pm * 256; const bool lat = row0 < TL; const int r2 = lat ? row0 : row0 - TL, midx = lat ? (row0 >> 11) : 8;
            const gfloat* srcb = lat ? (first ? p.in(0) : (const gfloat*)p.out()) : (first ? p.in(2) : (const gfloat*)(ws + WS_HCTX));
            gfloat* dstb = lat ? p.out() : (gfloat*)(ws + WS_HCTX);
            const gchar* s = (const gchar*)(srcb + (size_t)r2 * D + u.pn * 256);
            gchar* d = (gchar*)(dstb + (size_t)r2 * D + u.pn * 256);
            const gfloat* gp = (const gfloat*)(ws + WS_MODS) + (size_t)layer * 9 * 6144 + (mode == M_RES1 ? 2 : 5) * D + midx * 6144 + u.pn * 256 + wc * 32 + 8 * fq;
            const unsigned loff = (unsigned)((wr * 64 + fr) * D + wc * 32 + 8 * fq) * 4u;
            f32x4 gv[2][2];
#pragma unroll
            for (int bj = 0; bj < 2; ++bj)
#pragma unroll
                for (int n = 0; n < 2; ++n) gv[bj][n] = *(const GAS f32x4*)(gp + bj * 128 + 4 * n);
#pragma unroll
            for (int ai = 0; ai < 2; ++ai)
#pragma unroll
                for (int m = 0; m < 4; ++m) { const size_t ro = (size_t)((ai * 128 + m * 16) * D) * 4u;
#pragma unroll
                    for (int bj = 0; bj < 2; ++bj) {
                        const f32x4 x0 = *(const GAS f32x4*)(s + ro + bj * 512 + loff), x1 = *(const GAS f32x4*)(s + ro + bj * 512 + 16 + loff);
                        *(GAS f32x4*)(d + ro + bj * 512 + loff) = x0 + gv[bj][0] * acc[ai][bj][m][0];
                        *(GAS f32x4*)(d + ro + bj * 512 + 16 + loff) = x1 + gv[bj][1] * acc[ai][bj][m][1]; } }
            return;
        }
        gbf16* base; int ld; const gfloat* bias = nullptr;
        if (mode == M_URM) {
            if (u.pn >= 4) { store_kfrag(acc, (gbf16*)(ws + WS_KT) + (size_t)(u.pm * 64 + (u.pn - 4) * 4) * 2048, wr, wc, fr, fq); return; }
            ld = URM; base = (gbf16*)(ws + WS_URM) + (size_t)(u.pm * 256) * URM + u.pn * 256; }
        else if (mode == M_HID) { ld = DFF; base = (gbf16*)(ws + WS_HID) + (size_t)(u.pm * 256) * DFF + u.pn * 256; }
        else if (mode == M_SWAP) {
            if (u.pm != 0) { store_vfrag(acc, (gbf16*)(ws + WS_VT) + (size_t)(u.pn * 64 + (u.pm - 7) * 4) * 2048, wr, wc, fr, fq); return; }
            const int tok0 = u.pn * 256; const bool lat = tok0 < TL;
            const int bb = lat ? (tok0 >> 11) : ((tok0 - TL) >> 8), l0 = lat ? (tok0 & (SEQ - 1)) : 0; ld = lat ? SEQ : CTX;
            base = (gbf16*)(ws + (lat ? WS_UTL : WS_UTC)) + (size_t)(bb * 256) * ld + l0;
        } else if (mode == M_DFTL || mode == M_DFTC) {
            const int L = mode == M_DFTL ? SEQ : CTX, lshift = mode == M_DFTL ? 11 : 8, rowbase = mode == M_DFTL ? 0 : TL;
            const int row0 = u.pm * 256, cs = row0 >> lshift, lp0 = row0 & (L - 1);
            ld = 512; base = (gbf16*)(ws + WS_G12) + (size_t)(rowbase + u.pn * L + lp0) * 512 + cs * 256;
        } else {
            ld = D; base = (gbf16*)(ws + WS_MIX) + (size_t)(u.pm * 256) * D + (mode == M_MIXC ? 256 : 0);
            if (mode == M_MIXC) bias = p.in(15) + layer * 256;
        }
        if (mode == M_HID) store_tile_bf16<1>(acc, base, ld, nullptr, wr, wc, fr, fq);
        else store_tile_bf16<0>(acc, base, ld, bias, wr, wc, fr, fq);
    }
};
DI void run_gemm(LAS unsigned char* lds, const gbf16* A, const gbf16* Bt, int K, const Sched& S, int mode, int layer, PP p, const int tid) {
    pg8::Gemm g{(const bf16*)A, (const bf16*)Bt, 0, 0, K}; UEpi e{mode, layer, p};
    pg8::gemm_phase<UEpi, Sched, true, true>(lds, g, S, e, tid);
}

DI void phase_mods(const PP p, LAS unsigned char* lds, const int tid_, const int bid_) {
    const int tid = tid_, lane = tid & 63, wave = tid >> 6;
    LAS float* s = (LAS float*)lds;
    LAS float* red = (LAS float*)(lds + 36864);
    gfloat* mods = (gfloat*)(p.ws() + WS_MODS);
    for (int i = tid; i < 9 * 1024; i += 512) { const int j = i >> 10, k = i & 1023; const float v = j < 8 ? p.in(1)[j * 1024 + k] : p.in(3)[k]; s[i] = v / (1.f + expf(-v)); }
    __syncthreads();
    for (int item = bid_; item < 192; item += gridDim.x) {
        const int layer = item / 96, cgp = item % 96, col = cgp * 64 + lane;
        const gfloat* W = p.in(4) + (size_t)layer * 1024 * 6144 + col;
        float acc[9];
#pragma unroll
        for (int j = 0; j < 9; ++j) acc[j] = 0.f;
        const int k0 = wave * 128;
#pragma unroll 8
        for (int k = k0; k < k0 + 128; ++k) { const float w = W[(size_t)k * 6144];
#pragma unroll
            for (int j = 0; j < 9; ++j) acc[j] += s[j * 1024 + k] * w; }
#pragma unroll
        for (int j = 0; j < 9; ++j) red[(wave * 9 + j) * 64 + lane] = acc[j];
        __syncthreads();
        for (int t = tid; t < 576; t += 512) { const int j = t >> 6, l = t & 63; float v = p.in(5)[layer * 6144 + cgp * 64 + l];
#pragma unroll
            for (int w = 0; w < 8; ++w) v += red[(w * 9 + j) * 64 + l];
            mods[(size_t)(layer * 9 + j) * 6144 + cgp * 64 + l] = v; }
        __syncthreads();
    }
}
DI void make_tables(const PP p, const int tid_, const int bid_) {
    gbf16* DL = (gbf16*)(p.ws() + WS_DFTL); gbf16* DC = (gbf16*)(p.ws() + WS_DFTC);
    const int gt = bid_ * 512 + tid_, NT = gridDim.x * 512;
    for (int i = gt; i < 4096 * 256; i += NT) { const int row = i >> 8, l0 = (i & 255) * 8, cs = row >> 11, lp = row & 2047;
        float v[8];
#pragma unroll
        for (int e = 0; e < 8; ++e) { const int ph = (lp * (l0 + e)) & 2047; const float x = (float)ph * (1.f / 1024.f); v[e] = (cs ? sinpif(x) : cospif(x)) * 0.022097086912079608f; }
        u32x4 w; w.x = pk2(v[0], v[1]); w.y = pk2(v[2], v[3]); w.z = pk2(v[4], v[5]); w.w = pk2(v[6], v[7]);
        *(GAS u32x4*)(DL + (size_t)row * 2048 + l0) = w; }
    for (int i = gt; i < 512 * 32; i += NT) { const int row = i >> 5, l0 = (i & 31) * 8, cs = row >> 8, lp = row & 255;
        float v[8];
#pragma unroll
        for (int e = 0; e < 8; ++e) { const int ph = (lp * (l0 + e)) & 255; const float x = (float)ph * (1.f / 128.f); v[e] = (cs ? sinpif(x) : cospif(x)) * 0.0625f; }
        u32x4 w; w.x = pk2(v[0], v[1]); w.y = pk2(v[2], v[3]); w.z = pk2(v[4], v[5]); w.w = pk2(v[6], v[7]);
        *(GAS u32x4*)(DC + (size_t)row * 256 + l0) = w; }
}
DI void transpose_item(const gfloat* W, int K, int N, gbf16* WT, LAS float* scr, int item, int lane) {
    const int nblk = N / 32, kb = item / nblk, nb = item % nblk, k0 = 64 * kb, n0 = 32 * nb;
#pragma unroll 8
    for (int i = 0; i < 32; ++i) { const int kk = 2 * i + (lane >> 5); scr[kk * 33 + (lane & 31)] = W[(size_t)(k0 + kk) * N + n0 + (lane & 31)]; }
    LDS_WAIT(); asm volatile("" ::: "memory");
    const int c = lane & 7;
#pragma unroll
    for (int j = 0; j < 4; ++j) { const int n = (lane >> 3) + 8 * j; const LAS float* sp = scr + (8 * c) * 33 + n;
        u32x4 o; o.x = pk2(sp[0 * 33], sp[1 * 33]); o.y = pk2(sp[2 * 33], sp[3 * 33]); o.z = pk2(sp[4 * 33], sp[5 * 33]); o.w = pk2(sp[6 * 33], sp[7 * 33]);
        *(GAS u32x4*)(WT + (size_t)(n0 + n) * K + k0 + 8 * c) = o; }
    LDS_WAIT(); asm volatile("" ::: "memory");
}
DI void conv_weights(const PP p, int layer, LAS unsigned char* lds, const int tid_, const int bid_) {
    const int lane = tid_ & 63, wave = tid_ >> 6;
    LAS float* scr = (LAS float*)(lds + 57344 + wave * 8448);
    const int gw = bid_ * 8 + wave, NGW = gridDim.x * 8;
    const gfloat* Win = p.in(8) + (size_t)layer * D * DIN; const gfloat* Wout = p.in(17) + (size_t)layer * D * D;
    const gfloat* W1 = p.in(18) + (size_t)layer * D * DFF; const gfloat* W2 = p.in(19) + (size_t)layer * DFF * D; const gfloat* Wpw = p.in(14) + (size_t)layer * 256 * 256;
    gbf16* WinT = (gbf16*)(p.ws() + WS_WIN); gbf16* WoutT = (gbf16*)(p.ws() + WS_WOUT); gbf16* W1T = (gbf16*)(p.ws() + WS_W1); gbf16* W2T = (gbf16*)(p.ws() + WS_W2); gbf16* WpwT = (gbf16*)(p.ws() + WS_WPW);
    constexpr int I_IN = 16 * 72, I_OUT = 16 * 32, I_1 = 16 * 128, I_2 = 64 * 32, I_PW = 4 * 8, NIT = I_IN + I_OUT + I_1 + I_2 + I_PW;
    for (int it = gw; it < NIT; it += NGW) {
        int r = it;
        if (r < I_IN) { transpose_item(Win, D, DIN, WinT, scr, r, lane); continue; } r -= I_IN;
        if (r < I_OUT) { transpose_item(Wout, D, D, WoutT, scr, r, lane); continue; } r -= I_OUT;
        if (r < I_1) { transpose_item(W1, D, DFF, W1T, scr, r, lane); continue; } r -= I_1;
        if (r < I_2) { transpose_item(W2, DFF, D, W2T, scr, r, lane); continue; } r -= I_2;
        transpose_item(Wpw, 256, 256, WpwT, scr, r, lane);
    }
    const gfloat* Wf = p.in(9) + (size_t)layer * 256 * 256; gbf16* Wf2t = (gbf16*)(p.ws() + WS_WF2);
    for (int o = bid_ * 512 + tid_; o < 256 * 512; o += gridDim.x * 512) {
        const int n = o >> 9, k = o & 511, cs = k >> 8, g = (k >> 6) & 3, j = k & 63;
        float acc = 0.f;
        for (int jp = 0; jp < 64; ++jp) { const float x = (float)((j * jp) & 63) * (1.f / 32.f); const float t = cs ? sinpif(x) : cospif(x); acc += t * Wf[(size_t)(g * 64 + jp) * 256 + n]; }
        acc *= cs ? -0.125f : 0.125f;
        Wf2t[(size_t)n * 512 + k] = (bf16)(pk2(acc, 0.f) & 0xffffu);
    }
}
DI void phase_norm(const PP p, int layer, int which, int nrows, const int tid_, const int bid_) {
    const int lane = tid_ & 63, wave = tid_ >> 6;
    const int gw = bid_ * 8 + wave, NGW = gridDim.x * 8;
    const bool first = (layer == 0 && which == 0);
    const gfloat* hl = first ? p.in(0) : p.out(); const gfloat* hc = first ? p.in(2) : (const gfloat*)(p.ws() + WS_HCTX);
    const gfloat* g = p.in(which ? 7 : 6) + layer * D;
    const gfloat* mods = (const gfloat*)(p.ws() + WS_MODS) + (size_t)layer * 9 * 6144 + (which ? 3 : 0) * D;
    gbf16* hn = (gbf16*)(p.ws() + WS_HN);
    for (int row = gw; row < nrows; row += NGW) {
        const gfloat* src = row < TL ? hl + (size_t)row * D : hc + (size_t)(row - TL) * D;
        const int midx = row < TL ? (row >> 11) : 8;
        f32x4 v[4]; float ss = 0.f;
#pragma unroll
        for (int jj = 0; jj < 4; ++jj) { v[jj] = *(const GAS f32x4*)(src + 4 * (lane + 64 * jj)); ss += (v[jj].x * v[jj].x + v[jj].y * v[jj].y) + (v[jj].z * v[jj].z + v[jj].w * v[jj].w); }
        const float rinv = 1.f / sqrtf(wave_sum(ss) * (1.f / D) + 1e-6f);
#pragma unroll
        for (int jj = 0; jj < 4; ++jj) { const int k = 4 * (lane + 64 * jj);
            const f32x4 gg = *(const GAS f32x4*)(g + k), sh = *(const GAS f32x4*)(mods + midx * 6144 + k), sc = *(const GAS f32x4*)(mods + midx * 6144 + D + k);
            const f32x4 y = (v[jj] * rinv * gg) * (sc + 1.f) + sh;
            u32x2 w; w.x = pk2(y.x, y.y); w.y = pk2(y.z, y.w);
            *(GAS u32x2*)(hn + (size_t)row * D + k) = w; }
    }
}
DI void phase_final(const PP p, const int tid_, const int bid_) {
    const int lane = tid_ & 63, wave = tid_ >> 6;
    const int gw = bid_ * 8 + wave, NGW = gridDim.x * 8;
    const gfloat* g = p.in(20);
    for (int row = gw; row < TL; row += NGW) {
        gfloat* src = p.out() + (size_t)row * D;
        f32x4 v[4]; float ss = 0.f;
#pragma unroll
        for (int jj = 0; jj < 4; ++jj) { v[jj] = *(const GAS f32x4*)(src + 4 * (lane + 64 * jj)); ss += (v[jj].x * v[jj].x + v[jj].y * v[jj].y) + (v[jj].z * v[jj].z + v[jj].w * v[jj].w); }
        const float rinv = 1.f / sqrtf(wave_sum(ss) * (1.f / D) + 1e-6f);
#pragma unroll
        for (int jj = 0; jj < 4; ++jj) { const int k = 4 * (lane + 64 * jj); const f32x4 gg = *(const GAS f32x4*)(g + k); *(GAS f32x4*)(src + k) = v[jj] * rinv * gg; }
    }
}
DI void conv_tile(const PP p, int layer, int seqbase, int L, int t0, LAS unsigned char* lds, const int tid_, const int bid_) {
    int tid = tid_; asm volatile("" : "+v"(tid));
    const int lane = tid & 63;
    LAS float* vt = (LAS float*)lds;
    LAS float* red1 = (LAS float*)(lds + 98304);
    LAS float* red2 = (LAS float*)(lds + 98304 + 1024);
    const gbf16* Urm = (const gbf16*)(p.ws() + WS_URM);
    gbf16* cva = (gbf16*)(p.ws() + WS_CVA);
    __syncthreads();
    for (int idx = tid; idx < 94 * 32; idx += 512) { const int tt = idx >> 5, c8 = (idx & 31) * 8, pos = t0 - 15 + tt;
        float v[8];
        if (pos >= 0 && pos < L) { const gbf16* rp = Urm + (size_t)(seqbase + pos) * URM + c8; const bf16x8 a8 = *(const GAS bf16x8*)rp, g8 = *(const GAS bf16x8*)(rp + 256);
#pragma unroll
            for (int e = 0; e < 8; ++e) { const float a = bf2f(a8[e]), gt = bf2f(g8[e]); v[e] = a / (1.f + __expf(-gt)); } }
        else {
#pragma unroll
            for (int e = 0; e < 8; ++e) v[e] = 0.f; }
        *(LAS f32x4*)(vt + tt * 256 + c8) = (f32x4){v[0], v[1], v[2], v[3]}; *(LAS f32x4*)(vt + tt * 256 + c8 + 4) = (f32x4){v[4], v[5], v[6], v[7]}; }
    __syncthreads();
    const int c = tid & 255, th = tid >> 8, wq = (tid >> 6) & 3;
    const gfloat* dw = p.in(10) + (size_t)layer * 31 * 256 + c;
    float w[31];
#pragma unroll
    for (int tap = 0; tap < 31; ++tap) w[tap] = dw[tap * 256];
    const float bias = p.in(11)[layer * 256 + c], lg = p.in(12)[layer * 256 + c], lb = p.in(13)[layer * 256 + c];
    for (int ch = 0; ch < 4; ++ch) {
        const int tb = th * 32 + ch * 8;
        float o[8];
#pragma unroll
        for (int e = 0; e < 8; ++e) { float acc = bias;
#pragma unroll
            for (int tap = 0; tap < 31; ++tap) acc += w[tap] * vt[(tb + e + tap) * 256 + c];
            o[e] = acc; }
#pragma unroll
        for (int e = 0; e < 8; ++e) { const float s1 = wave_sum(o[e]); if (lane == 0) red1[(tb + e) * 4 + wq] = s1; }
        __syncthreads();
#pragma unroll
        for (int e = 0; e < 8; ++e) { const LAS float* r = red1 + (tb + e) * 4; const float mean = ((r[0] + r[1]) + (r[2] + r[3])) * (1.f / 256.f); o[e] -= mean;
            const float s2 = wave_sum(o[e] * o[e]); if (lane == 0) red2[(tb + e) * 4 + wq] = s2; }
        __syncthreads();
#pragma unroll
        for (int e = 0; e < 8; ++e) { const LAS float* r = red2 + (tb + e) * 4; const float var = ((r[0] + r[1]) + (r[2] + r[3])) * (1.f / 256.f);
            const float y = o[e] / sqrtf(var + 1e-5f) * lg + lb; const float z = y / (1.f + __expf(-y));
            cva[(size_t)(seqbase + t0 + tb + e) * 256 + c] = (bf16)(pk2(z, 0.f) & 0xffffu); }
    }
}
#define MFMA32(a, b, c) __builtin_amdgcn_mfma_f32_32x32x16_bf16((a), (b), (c), 0, 0, 0)
DI void attn_load(const gchar* KtB, const gchar* VtB, int tile, int b, int h, int rs, int lane, bf16x8 (&kf)[4], bf16x8 (&vf)[2][2]) {
    const int tileg = tile >= 8 ? (b * 64 + rs * 2 + (tile - 8)) : (TL / 32 + b * 8 + tile);
    const unsigned off = (unsigned)((tileg * 8 + h) * 2048 + lane * 8) * 2u;
#pragma unroll
    for (int ks = 0; ks < 4; ++ks) kf[ks] = *(const GAS bf16x8*)(KtB + off + ks * 1024);
#pragma unroll
    for (int dt = 0; dt < 2; ++dt)
#pragma unroll
        for (int t = 0; t < 2; ++t) vf[dt][t] = *(const GAS bf16x8*)(VtB + off + (dt * 2 + t) * 1024);
}
template <bool LOCAL> DI void attn_compute(const bf16x8 (&kf)[4], const bf16x8 (&vf)[2][2], const LAS bf16x8* ql_, f32x16 (&o)[2][2], float (&m)[2], float (&ls)[2],
                                           const LAS float* bl, int lt, int ql, int half) {
    const float SCL = 0.125f * 1.4426950408889634f, NINF = -__builtin_inff();
#pragma unroll
    for (int qt = 0; qt < 2; ++qt) {
        f32x16 sv;
#pragma unroll
        for (int v = 0; v < 16; ++v) sv[v] = 0.f;
#pragma unroll
        for (int ks = 0; ks < 4; ++ks) sv = MFMA32(kf[ks], ql_[(qt * 4 + ks) * 64], sv);
        float mx = NINF;
        if (LOCAL) {
            const int qc = qt * 32 + ql, cs = min(max(qc - 8, 0), 48);
            const int kc0 = (lt & 1) * 32 + 4 * half;
            const int d0 = kc0 - cs, b0 = (lt >> 1) * 31 + kc0 - qc + 15;
            float bias[16];
#pragma unroll
            for (int v = 0; v < 16; ++v) { const int dv = (v & 3) + 8 * (v >> 2); const int bi = min(max(b0 + dv, 0), 247); bias[v] = ((const volatile LAS float*)bl)[bi]; }
#pragma unroll
            for (int v = 0; v < 16; ++v) { const int dv = (v & 3) + 8 * (v >> 2); const bool valid = (unsigned)(d0 + dv) < 16u;
                const float x = valid ? sv[v] * SCL + bias[v] : NINF; sv[v] = x; mx = fmaxf(mx, x); }
        } else {
#pragma unroll
            for (int v = 0; v < 16; ++v) { const float x = sv[v] * SCL; sv[v] = x; mx = fmaxf(mx, x); }
        }
        mx = fmaxf(mx, __shfl_xor(mx, 32));
        const float mn = fmaxf(m[qt], mx), alpha = __builtin_amdgcn_exp2f(m[qt] - mn); m[qt] = mn;
        float sum = 0.f;
#pragma unroll
        for (int v = 0; v < 16; ++v) { const float pv = __builtin_amdgcn_exp2f(sv[v] - mn); sv[v] = pv; sum += pv; }
        ls[qt] = ls[qt] * alpha + sum;
#pragma unroll
        for (int dt = 0; dt < 2; ++dt)
#pragma unroll
            for (int v = 0; v < 16; ++v) o[dt][qt][v] *= alpha;
#pragma unroll
        for (int t = 0; t < 2; ++t) { u32x4 pw; pw.x = pk2(sv[8 * t + 0], sv[8 * t + 1]); pw.y = pk2(sv[8 * t + 2], sv[8 * t + 3]); pw.z = pk2(sv[8 * t + 4], sv[8 * t + 5]); pw.w = pk2(sv[8 * t + 6], sv[8 * t + 7]);
            const bf16x8 pf = __builtin_bit_cast(bf16x8, pw);
#pragma unroll
            for (int dt = 0; dt < 2; ++dt) o[dt][qt] = MFMA32(vf[dt][t], pf, o[dt][qt]); }
    }
}
DI void attn_item(const PP p, int layer, int b, int qbase, int nloc, int r, LAS unsigned char* lds, const int tid_, const int bid_) {
    int tid = tid_; asm volatile("" : "+v"(tid));
    const int lane = tid & 63, h = __builtin_amdgcn_readfirstlane(tid >> 6), ql = lane & 31, half = lane >> 5;
    const gchar* UrmB = (const gchar*)(p.ws() + WS_URM); const gchar* KtB = (const gchar*)(p.ws() + WS_KT); const gchar* VtB = (const gchar*)(p.ws() + WS_VT);
    LAS float* bl = (LAS float*)(lds + h * 9216);
    LAS bf16x8* qlds = (LAS bf16x8*)(lds + h * 9216 + 1024) + lane;
    const int rs = min(max(r - 4, 0), 24);
    const float LOG2E = 1.4426950408889634f, NINF = -__builtin_inff();
    __syncthreads();
    if (nloc) { const gfloat* rp = p.in(16) + (size_t)(layer * 8 + h) * 465;
        for (int i = lane; i < 248; i += 64) { const int kr = i / 31, co = i - kr * 31; bl[i] = rp[(rs - r + 7 + kr) * 31 + co] * LOG2E; } }
    __syncthreads();
#pragma unroll
    for (int qt = 0; qt < 2; ++qt) { const unsigned qoff = (unsigned)((qbase + qt * 32 + ql) * URM + 512 + h * 64 + 32 * half) * 2u;
#pragma unroll
        for (int ks = 0; ks < 4; ++ks) qlds[(qt * 4 + ks) * 64] = *(const GAS bf16x8*)(UrmB + qoff + 16 * ks); }
    f32x16 o[2][2];
#pragma unroll
    for (int a = 0; a < 2; ++a)
#pragma unroll
        for (int c = 0; c < 2; ++c)
#pragma unroll
            for (int v = 0; v < 16; ++v) o[a][c][v] = 0.f;
    float m[2] = {NINF, NINF}, ls[2] = {0.f, 0.f};
    const int ntiles = 8 + nloc;
    bf16x8 kf[4], vf[2][2], kn[4], vn[2][2];
    attn_load(KtB, VtB, 0, b, h, rs, lane, kf, vf);
#pragma unroll 1
    for (int tile = 0; tile < ntiles; ++tile) {
        asm volatile("" ::: "memory");
        const int tn = tile + 1 < ntiles ? tile + 1 : tile;
        attn_load(KtB, VtB, tn, b, h, rs, lane, kn, vn);
        if (tile < 8) attn_compute<false>(kf, vf, qlds, o, m, ls, bl, 0, ql, half);
        else attn_compute<true>(kf, vf, qlds, o, m, ls, bl, tile - 8, ql, half);
#pragma unroll
        for (int ks = 0; ks < 4; ++ks) kf[ks] = kn[ks];
#pragma unroll
        for (int dt = 0; dt < 2; ++dt)
#pragma unroll
            for (int t = 0; t < 2; ++t) vf[dt][t] = vn[dt][t];
    }
    int tid2 = tid_; asm volatile("" : "+v"(tid2));
    const int ql2 = tid2 & 31, half2 = (tid2 >> 5) & 1; gbf16* mixo = (gbf16*)(p.ws() + WS_MIX);
#pragma unroll
    for (int qt = 0; qt < 2; ++qt) { const float lt_ = ls[qt] + __shfl_xor(ls[qt], 32); const float inv = 1.f / lt_; const int token = qbase + qt * 32 + ql2;
#pragma unroll
        for (int dt = 0; dt < 2; ++dt)
#pragma unroll
            for (int i = 0; i < 4; ++i) { const int d = dt * 32 + 8 * i + 4 * half2; u32x2 w; w.x = pk2(o[dt][qt][4 * i] * inv, o[dt][qt][4 * i + 1] * inv); w.y = pk2(o[dt][qt][4 * i + 2] * inv, o[dt][qt][4 * i + 3] * inv);
                *(GAS u32x2*)((gchar*)mixo + (unsigned)(token * D + 512 + h * 64 + d) * 2u) = w; } }
}
DI void run_phase(const PP p, int ph, LAS unsigned char* lds, const int tid, const int c, const int skip = 0) {
    const int G = gridDim.x;
    if (ph == 0) { phase_mods(p, lds, tid, c); make_tables(p, tid, c); conv_weights(p, 0, lds, tid, c); return; }
    if (ph == NPH - 1) { phase_final(p, tid, c); return; }
    const int layer = (ph - 1) >> 3, sub = (ph - 1) & 7;
    const int M = layer == 0 ? TA : TL;
    if (sub == 0) { if (layer == 1) conv_weights(p, 1, lds, tid, c); phase_norm(p, layer, 0, TA, tid, c); return; }
    if (sub == 5) { phase_norm(p, layer, 1, M, tid, c); return; }
    const int H = G / 2 > 0 ? G / 2 : 1;
#pragma unroll 1
    for (int j = 0; j < 2; ++j) {
        unsigned char* ws = p.ws();
        const gbf16* A = nullptr; const gbf16* Bt = nullptr; int K = 0, nM = 0, nN = 0, cc = c, pmadd = 0, mode = 0; bool valid = true;
        if (sub == 1) {
            if (j == 0) { A = (const gbf16*)(ws + WS_HN); Bt = (const gbf16*)(ws + WS_WIN) + (size_t)256 * D; K = D; nM = TA / 256; nN = 6; mode = M_URM; }
            else { A = (const gbf16*)(ws + WS_WIN); Bt = (const gbf16*)(ws + WS_HN); K = D; nM = 3; nN = TA / 256; cc = (c + (G - (432 % G))) % G; pmadd = 6; mode = M_SWAP; }
        } else if (sub == 2) {
            if (j == 0) { A = (const gbf16*)(ws + WS_DFTL); Bt = (const gbf16*)(ws + WS_UTL); K = SEQ; nM = 16; nN = 8; mode = M_DFTL; }
            else { A = (const gbf16*)(ws + WS_DFTC); Bt = (const gbf16*)(ws + WS_UTC); K = CTX; nM = 2; nN = 8; cc = (c + H) % G; mode = M_DFTC; valid = (layer == 0); }
        } else if (sub == 3) {
            if (j == 0) { A = (const gbf16*)(ws + WS_G12); Bt = (const gbf16*)(ws + WS_WF2); K = 512; nM = M / 256; nN = 1; mode = M_MIXF; }
            else { A = (const gbf16*)(ws + WS_CVA); Bt = (const gbf16*)(ws + WS_WPW); K = 256; nM = M / 256; nN = 1; cc = (c + G - ((M / 256) % G)) % G; mode = M_MIXC; }
        } else if (sub == 4) { A = (const gbf16*)(ws + WS_MIX); Bt = (const gbf16*)(ws + WS_WOUT); K = D; nM = M / 256; nN = 4; mode = M_RES1; valid = (j == 0); }
        else if (sub == 6) { A = (const gbf16*)(ws + WS_HN); Bt = (const gbf16*)(ws + WS_W1); K = D; nM = M / 256; nN = 16; mode = M_HID; valid = (j == 0); }
        else { A = (const gbf16*)(ws + WS_HID); Bt = (const gbf16*)(ws + WS_W2); K = DFF; nM = M / 256; nN = 4; mode = M_RES2; valid = (j == 0); }
        if (valid && !(skip & 1)) { Sched S; S.init(nM, nN, G, cc); S.pmadd = pmadd; int tj = tid; asm volatile("" : "+v"(tj)); run_gemm(lds, A, Bt, K, S, mode, layer, p, tj); }
    }
    if (sub == 2) {
        if (c < H && !(skip & 2)) {
            const int nconv = layer == 0 ? 288 : 256;
            for (int it = c; it < nconv; it += H) {
                const bool lat = it < 256; const int i2 = it - 256;
                conv_tile(p, layer, lat ? (it >> 5) * SEQ : TL + (i2 >> 2) * CTX, lat ? SEQ : CTX, lat ? (it & 31) * 64 : (i2 & 3) * 64, lds, tid, c);
            }
        }
        const int natt = (skip & 4) ? 0 : (c >= H) ? 256 : (layer == 0 ? 32 : 0);
        const int a0 = (c >= H) ? c - H : c, astep = (c >= H) ? G - H : H;
#pragma unroll 1
        for (int it = a0; it < natt; it += astep) {
            if (c >= H) attn_item(p, layer, it >> 5, (it >> 5) * SEQ + (it & 31) * 64, 16, it & 31, lds, tid, c);
            else attn_item(p, layer, it >> 2, TL + (it >> 2) * CTX + (it & 3) * 64, 0, 0, lds, tid, c);
        }
    }
}

__global__ void __launch_bounds__(512, 2) fwd_kernel(Params prm) {
    extern __shared__ __attribute__((aligned(16))) unsigned char lds_raw[];
    LAS unsigned char* lds = (LAS unsigned char*)lds_raw;
    {
        const unsigned long long* ka = (const unsigned long long*)__builtin_amdgcn_kernarg_segment_ptr();
        if (threadIdx.x < 23) ((LAS unsigned long long*)(lds + LDSP_OFF))[threadIdx.x] = ka[threadIdx.x];
    }
    __syncthreads();
    PP p; p.P = (const LAS unsigned long long*)(lds + LDSP_OFF);
    const int lo = prm.ph_lo, hi = prm.ph_hi;
    const int wave_s = __builtin_amdgcn_readfirstlane((int)threadIdx.x >> 6);
#pragma unroll 1
    for (int ph = lo; ph < hi; ++ph) {
        if (ph > lo) cg::this_grid().sync();
        int lane_; asm volatile("v_mbcnt_lo_u32_b32 %0, -1, 0\n\tv_mbcnt_hi_u32_b32 %0, -1, %0" : "=v"(lane_));
        int tid = wave_s * 64 + lane_, bid = blockIdx.x;
        asm volatile("" : "+s"(bid));
        run_phase(p, ph, lds, tid, bid);
        __syncthreads();
#ifdef PROBE_REPEAT
        if ((PROBE_REPEAT >> ph) & 1) { cg::this_grid().sync(); run_phase(p, ph, lds, tid, bid, PROBE_SKIP); __syncthreads(); }
#endif
    }
}

extern "C" void kernel_launch(void* const* d_in, const int* in_sizes, int n_in, void* d_out, int out_size, void* d_ws, size_t ws_size, hipStream_t stream) {
    static int grid = 0;
    if (grid == 0) {
        if (n_in != 21 || ws_size < WS_END) { fprintf(stderr, "kernel_launch: unexpected n_in %d / ws_size %zu\n", n_in, ws_size); grid = -1; return; }
        int dev = 0, cus = 0, per_cu = 0;
        (void)hipGetDevice(&dev); (void)hipDeviceGetAttribute(&cus, hipDeviceAttributeMultiprocessorCount, dev);
        (void)hipFuncSetAttribute((const void*)fwd_kernel, hipFuncAttributeMaxDynamicSharedMemorySize, LDS_BYTES);
        (void)hipOccupancyMaxActiveBlocksPerMultiprocessor(&per_cu, (const void*)fwd_kernel, 512, LDS_BYTES);
        if (per_cu < 1) { fprintf(stderr, "kernel_launch: occupancy query says %d blocks/CU\n", per_cu); per_cu = 1; }
        (void)hipGetLastError();
        grid = cus > 0 ? cus : 256;
    }
    if (grid < 0) return;
    Params p{};
    for (int i = 0; i < 21; ++i) p.in[i] = (const float*)d_in[i];
    p.out = (float*)d_out; p.ws = (unsigned char*)d_ws;
#if SINGLE_LAUNCH
    p.ph_lo = 0; p.ph_hi = NPH;
    void* args[] = {&p};
    hipError_t e = hipLaunchCooperativeKernel((const void*)fwd_kernel, dim3(grid), dim3(512), args, LDS_BYTES, stream);
    if (e != hipSuccess) fprintf(stderr, "cooperative launch failed: %s (grid %d)\n", hipGetErrorString(e), grid);
#else
    for (int ph = 0; ph < NPH; ++ph) { p.ph_lo = ph; p.ph_hi = ph + 1; hipLaunchKernelGGL(fwd_kernel, dim3(grid), dim3(512), LDS_BYTES, stream, p); }
#endif
}
```

```cpp
#include <hip/hip_runtime.h>
#include <hip/hip_cooperative_groups.h>
#include <cstdio>
#include <cstdint>
namespace cg = cooperative_groups;
namespace pg8 {
#define PG8_LAS __attribute__((address_space(3)))
typedef unsigned short bf16_t;
typedef short bf16x8 __attribute__((ext_vector_type(8)));
typedef float f32x4 __attribute__((ext_vector_type(4)));
typedef unsigned u32x4 __attribute__((ext_vector_type(4)));
constexpr int BM = 256, BK = 64, HALF = 128, HTB = HALF * BK * 2  , STAGE_BYTES = 8 * HTB, NXCD = 8, WGM = 8;

__host__ __device__ __forceinline__ int lds_byte(int r, int c) { const int st = (r >> 4) * 2 + (c >> 5), rr = r & 15, cc = c & 31, ob = rr * 64 + cc * 2; return st * 1024 + (ob ^ (((ob >> 9) & 1) << 5)); }
__host__ __device__ __forceinline__ void stage_rc(int b, int& R, int& C) { const int st = b / 1024, sb = b % 1024, swz = sb ^ (((sb >> 9) & 1) << 5); R = (st >> 1) * 16 + swz / 64; C = (st & 1) * 32 + (swz % 64) / 2; }
__host__ __device__ __forceinline__ int perm32(int rho) { const int n = rho >> 4, i = rho & 15; return 8 * (i >> 2) + 4 * n + (i & 3); }

struct Unit { int pm, pn, ko; };
struct Gemm { const bf16_t* A; const bf16_t* Bt; int M, N, K; };

struct StaticOrder {
    int nM, nN, nwg, G, c;
    __host__ __device__ void init(int M, int N, int G_, int c_) { nM = M / BM; nN = N / BM; nwg = nM * nN; G = G_; c = c_; }
    __host__ __device__ bool next(int i, Unit& u) const {
        const long L = (long)i * G + c; if (L >= nwg) return false;
        int wgid = (int)L; { const int q = nwg / NXCD, r = nwg % NXCD, xcd = wgid % NXCD, off = wgid / NXCD; wgid = (xcd < r ? xcd * (q + 1) : r * (q + 1) + (xcd - r) * q) + off; }
        const int nig = WGM * nN, gid = wgid / nig, fm = gid * WGM, gsz = (nM - fm) < WGM ? (nM - fm) : WGM;
        u.pm = fm + ((wgid % nig) % gsz); u.pn = (wgid % nig) / gsz; u.ko = 0; return true;
    }
    __device__ __forceinline__ void a_ready(const Unit&) const {}
    __device__ __forceinline__ void done(const Unit&) const {}
};

template <class Epi, class Sched, bool ALIGN_EPI = false, bool SP2 = false>
__device__ __forceinline__ void gemm_phase(PG8_LAS unsigned char* lds, const Gemm g, const Sched& S, const Epi& E, const int tid_in) {
    const int tid = tid_in, wid = __builtin_amdgcn_readfirstlane(tid >> 6), lane = tid & 63, wr = wid >> 2, wc = wid & 3, fr = lane & 15, fq = lane >> 4;
    const int K = g.K, nt = (g.M ? g.M : K) / BK;
    unsigned voffA[2], voffB[2];
#pragma unroll
    for (int i = 0; i < 2; ++i) { int R, C; stage_rc(tid * 16 + i * 8192, R, C); const int Rb = Epi::PERM ? ((R & ~31) + perm32(R & 31)) : R;
        voffA[i] = (unsigned)(R * K + C) * 2u; voffB[i] = (unsigned)(Rb * K + C) * 2u; }
    const size_t kstep = (size_t)(BK * 2);
    const size_t hstep = (size_t)HALF * K * 2;
    const size_t tstep = 2 * hstep;
    const unsigned ldsw = (unsigned)wid * 1024u;
    const int aoff = lds_byte(wr * 64 + fr, fq * 8), boff = lds_byte(wc * 32 + fr, fq * 8);
#define PG8_SA(b, h) (((b) * 2 + (h)) * HTB)
#define PG8_SB(b, h) ((4 + (b) * 2 + (h)) * HTB)
#define PG8_STAGE(bufoff, gbase, voff) do { _Pragma("unroll") for (int _i = 0; _i < 2; ++_i) \
        __builtin_amdgcn_global_load_lds((const unsigned*)((const char*)(gbase) + (voff)[_i]), (PG8_LAS unsigned*)(lds + (bufoff) + ldsw + _i * 8192), 16, 0, 0); } while (0)
#define PG8_LDA(dst, b, h) do { _Pragma("unroll") for (int m = 0; m < 4; ++m) _Pragma("unroll") for (int k = 0; k < 2; ++k) dst[m][k] = *(const PG8_LAS bf16x8*)(lds + PG8_SA(b, h) + aoff + m * 2048 + k * 1024); } while (0)
#define PG8_LDB(dst, b, h) do { _Pragma("unroll") for (int n = 0; n < 2; ++n) _Pragma("unroll") for (int k = 0; k < 2; ++k) dst[n][k] = *(const PG8_LAS bf16x8*)(lds + PG8_SB(b, h) + boff + n * 2048 + k * 1024); } while (0)
#define PG8_MMA(ai, bj, At, Bt) do { __builtin_amdgcn_s_setprio(1); _Pragma("unroll") for (int m = 0; m < 4; ++m) _Pragma("unroll") for (int n = 0; n < 2; ++n) _Pragma("unroll") for (int k = 0; k < 2; ++k) \
        acc[ai][bj][m][n] = __builtin_amdgcn_mfma_f32_16x16x32_bf16(Bt[n][k], At[m][k], acc[ai][bj][m][n], 0, 0, 0); __builtin_amdgcn_s_setprio(0); } while (0)
#define PG8_WAIT_V(n) asm volatile("s_waitcnt vmcnt(" #n ")" ::: "memory")
#define PG8_WAIT_L(n) asm volatile("s_waitcnt lgkmcnt(" #n ")" ::: "memory")
#define PG8_BAR __builtin_amdgcn_s_barrier()
#define PG8_SCHED __builtin_amdgcn_sched_barrier(0)
    Unit cur, nxt; int ui = 0;
    if (!S.next(0, cur)) return;
    f32x4 acc[2][2][4][2];
#pragma unroll
    for (int a = 0; a < 2; ++a)
#pragma unroll
        for (int b = 0; b < 2; ++b)
#pragma unroll
            for (int m = 0; m < 4; ++m)
#pragma unroll
                for (int n = 0; n < 2; ++n) acc[a][b][m][n] = (f32x4){0.f, 0.f, 0.f, 0.f};
    bf16x8 At[4][2], B0[2][2], B1[2][2];
    const char* cA = (const char*)g.A + (size_t)cur.pm * tstep + cur.ko; const char* cB = (const char*)g.Bt + (size_t)cur.pn * tstep + cur.ko;
    S.a_ready(cur);
    if constexpr (SP2) {
        PG8_STAGE(PG8_SB(0, 0), cB, voffB); PG8_STAGE(PG8_SB(0, 1), cB + hstep, voffB); PG8_STAGE(PG8_SA(0, 0), cA, voffA); PG8_STAGE(PG8_SA(0, 1), cA + hstep, voffA);
        if (wr == 1) PG8_BAR;
        PG8_WAIT_V(2); PG8_BAR;
        PG8_STAGE(PG8_SB(1, 0), cB + kstep, voffB); PG8_STAGE(PG8_SA(1, 0), cA + kstep, voffA); PG8_STAGE(PG8_SB(1, 1), cB + hstep + kstep, voffB);
        PG8_WAIT_V(6); PG8_BAR;
    } else {
        PG8_STAGE(PG8_SB(0, 0), cB, voffB); PG8_STAGE(PG8_SA(0, 0), cA, voffA); PG8_STAGE(PG8_SB(0, 1), cB + hstep, voffB); PG8_STAGE(PG8_SA(0, 1), cA + hstep, voffA);
        if (wr == 1) PG8_BAR;
        PG8_WAIT_V(4); PG8_BAR;
        PG8_STAGE(PG8_SB(1, 0), cB + kstep, voffB); PG8_STAGE(PG8_SA(1, 0), cA + kstep, voffA); PG8_STAGE(PG8_SB(1, 1), cB + hstep + kstep, voffB);
        PG8_WAIT_V(6); PG8_BAR;
    }
    for (;;) {
        const bool has_next = S.next(ui + 1, nxt);
        const char* nA = has_next ? (const char*)g.A + (size_t)nxt.pm * tstep + nxt.ko : cA; const char* nB = has_next ? (const char*)g.Bt + (size_t)nxt.pn * tstep + nxt.ko : cB;
        for (int t = 0; t < nt; t += 2) {
            const bool last = (t == nt - 2);
            const char* a1 = cA + (size_t)(t + 1) * kstep;
            const char* a2 = last ? nA : cA + (size_t)(t + 2) * kstep; const char* b2 = last ? nB : cB + (size_t)(t + 2) * kstep;
            const char* a3 = a2 + kstep; const char* b3 = b2 + kstep;
            if (last && has_next) S.a_ready(nxt);
            if constexpr (SP2) {
            PG8_LDB(B0, 0, 0); PG8_LDB(B1, 0, 1); PG8_SCHED; PG8_LDA(At, 0, 0); PG8_STAGE(PG8_SA(1, 1), a1 + hstep, voffA);
            PG8_WAIT_V(8); PG8_WAIT_L(0); PG8_BAR; PG8_MMA(0, 0, At, B0); PG8_MMA(0, 1, At, B1); PG8_BAR; PG8_SCHED;
            PG8_LDA(At, 0, 1); PG8_STAGE(PG8_SB(0, 0), b2, voffB); PG8_STAGE(PG8_SB(0, 1), b2 + hstep, voffB); PG8_STAGE(PG8_SA(0, 0), a2, voffA);
            PG8_WAIT_V(8); PG8_WAIT_L(0); PG8_BAR; PG8_MMA(1, 0, At, B0); PG8_MMA(1, 1, At, B1); PG8_BAR; PG8_SCHED;
            PG8_LDB(B0, 1, 0); PG8_LDB(B1, 1, 1); PG8_SCHED; PG8_LDA(At, 1, 0); PG8_STAGE(PG8_SA(0, 1), a2 + hstep, voffA);
            PG8_WAIT_V(8); PG8_WAIT_L(0); PG8_BAR; PG8_MMA(0, 0, At, B0); PG8_MMA(0, 1, At, B1); PG8_BAR; PG8_SCHED;
            PG8_LDA(At, 1, 1); PG8_STAGE(PG8_SB(1, 0), b3, voffB); PG8_STAGE(PG8_SB(1, 1), b3 + hstep, voffB); PG8_STAGE(PG8_SA(1, 0), a3, voffA);
            PG8_WAIT_V(8); PG8_WAIT_L(0); PG8_BAR; PG8_MMA(1, 0, At, B0); PG8_MMA(1, 1, At, B1); PG8_BAR; PG8_SCHED;
            } else {
            PG8_LDB(B0, 0, 0); PG8_SCHED; PG8_LDA(At, 0, 0); PG8_STAGE(PG8_SA(1, 1), a1 + hstep, voffA);
            PG8_WAIT_L(8); PG8_BAR; PG8_WAIT_L(0); PG8_MMA(0, 0, At, B0); PG8_BAR; PG8_SCHED;
            PG8_LDB(B1, 0, 1); PG8_STAGE(PG8_SB(0, 0), b2, voffB);
            PG8_BAR; PG8_WAIT_L(0); PG8_MMA(0, 1, At, B1); PG8_BAR;
            PG8_LDA(At, 0, 1); PG8_STAGE(PG8_SA(0, 0), a2, voffA);
            PG8_BAR; PG8_WAIT_L(0); PG8_MMA(1, 0, At, B0); PG8_BAR; PG8_SCHED;
            PG8_STAGE(PG8_SB(0, 1), b2 + hstep, voffB);
            PG8_WAIT_V(6); PG8_BAR; PG8_MMA(1, 1, At, B1); PG8_BAR;
            PG8_LDB(B0, 1, 0); PG8_SCHED; PG8_LDA(At, 1, 0); PG8_STAGE(PG8_SA(0, 1), a2 + hstep, voffA);
            PG8_WAIT_L(8); PG8_BAR; PG8_WAIT_L(0); PG8_MMA(0, 0, At, B0); PG8_BAR; PG8_SCHED;
            PG8_LDB(B1, 1, 1); PG8_STAGE(PG8_SB(1, 0), b3, voffB);
            PG8_BAR; PG8_WAIT_L(0); PG8_MMA(0, 1, At, B1); PG8_BAR;
            PG8_LDA(At, 1, 1); PG8_STAGE(PG8_SA(1, 0), a3, voffA);
            PG8_BAR; PG8_WAIT_L(0); PG8_MMA(1, 0, At, B0); PG8_BAR; PG8_SCHED;
            PG8_STAGE(PG8_SB(1, 1), b3 + hstep, voffB);
            PG8_WAIT_V(6); PG8_BAR; PG8_MMA(1, 1, At, B1); PG8_BAR;
            }
        }
        if constexpr (ALIGN_EPI) { if (wr == 0) PG8_BAR; }
        if constexpr (!Epi::AFTER_DRAIN) { E(acc, cur, wr, wc, fr, fq); S.done(cur); }
        if (!has_next) break;
#pragma unroll
        for (int a = 0; a < 2; ++a)
#pragma unroll
            for (int b = 0; b < 2; ++b)
#pragma unroll
                for (int m = 0; m < 4; ++m)
#pragma unroll
                    for (int n = 0; n < 2; ++n) acc[a][b][m][n] = (f32x4){0.f, 0.f, 0.f, 0.f};
        cur = nxt; cA = nA; cB = nB; ++ui;
        if constexpr (ALIGN_EPI) { if (wr == 1) PG8_BAR; }
    }
    PG8_WAIT_V(0);
    if constexpr (!ALIGN_EPI) { if (wr == 0) PG8_BAR; }
    PG8_BAR;
    if constexpr (Epi::AFTER_DRAIN) { E.fused(acc, cur, wr, wc, fr, fq, lds, wid, lane); S.done(cur); }
#undef PG8_SA
#undef PG8_SB
#undef PG8_STAGE
#undef PG8_LDA
#undef PG8_LDB
#undef PG8_MMA
#undef PG8_WAIT_V
#undef PG8_WAIT_L
#undef PG8_BAR
#undef PG8_SCHED
}
}

#define LAS __attribute__((address_space(3)))
#define DI __device__ __forceinline__
typedef unsigned short bf16;
typedef short bf16x8 __attribute__((ext_vector_type(8)));
typedef short s16x4 __attribute__((ext_vector_type(4)));
typedef float f32x4 __attribute__((ext_vector_type(4)));
typedef float f32x16 __attribute__((ext_vector_type(16)));
typedef unsigned u32x4 __attribute__((ext_vector_type(4)));
typedef unsigned u32x2 __attribute__((ext_vector_type(2)));
typedef __bf16 bf16x2_t __attribute__((ext_vector_type(2)));
typedef float f32x2_t __attribute__((ext_vector_type(2)));
#define GAS __attribute__((address_space(1)))
typedef GAS float gfloat; typedef GAS unsigned short gbf16; typedef GAS char gchar; typedef GAS unsigned char guchar;

#ifndef SINGLE_LAUNCH
#define SINGLE_LAUNCH 1
#endif

constexpr int D = 1024, NB = 8, SEQ = 2048, CTX = 256, TL = NB * SEQ, TC = NB * CTX, TA = TL + TC;
constexpr int DIN = 2304, DFF = 4096, URM = 1024;
constexpr int NPH = 18;
constexpr int LDS_BYTES = 147456;
constexpr size_t MiB = 1u << 20;
constexpr size_t WS_CTL = 0, WS_MODS = 1 * MiB;
constexpr size_t WS_WIN = 2 * MiB, WS_WOUT = WS_WIN + (size_t)DIN * D * 2, WS_W1 = WS_WOUT + 2 * MiB, WS_W2 = WS_W1 + 8 * MiB, WS_WPW = WS_W2 + 8 * MiB, WS_WF2 = WS_WPW + 128 * 1024;
constexpr size_t WS_DFTL = 25 * MiB, WS_DFTC = 41 * MiB, WS_HCTX = 42 * MiB, WS_HN = 50 * MiB, WS_OV = 86 * MiB;
constexpr size_t WS_URM = WS_OV, WS_UTL = WS_OV + 36 * MiB, WS_UTC = WS_UTL + 8 * MiB, WS_KT = WS_UTC + 1 * MiB, WS_VT = WS_KT + 18 * MiB,
                 WS_G12 = WS_VT + 18 * MiB, WS_CVA = WS_G12 + 18 * MiB, WS_MIX = WS_CVA + 9 * MiB, WS_HID = WS_OV, WS_END = WS_OV + 144 * MiB;
constexpr size_t WS_SIDE = WS_END;
static_assert(WS_SIDE + 24 * MiB <= 256 * MiB, "side buffers");
static_assert(WS_WF2 + 256 * 1024 <= WS_DFTL && WS_MIX + 36 * MiB == WS_END && WS_END <= 256 * MiB, "ws map");

struct Params { const float* in[21]; float* out; unsigned char* ws; int ph_lo, ph_hi; };
constexpr int LDSP_OFF = 131072;
struct PP {
    const __attribute__((address_space(3))) unsigned long long* P;
    __device__ __forceinline__ unsigned long long ld(int i) const { const unsigned long long v = P[i]; const unsigned lo = __builtin_amdgcn_readfirstlane((unsigned)v), hi = __builtin_amdgcn_readfirstlane((unsigned)(v >> 32)); return ((unsigned long long)hi << 32) | lo; }
    __device__ __forceinline__ const gfloat* in(int i) const { return (const gfloat*)ld(i); }
    __device__ __forceinline__ gfloat* out() const { return (gfloat*)ld(21); }
    __device__ __forceinline__ unsigned char* ws() const { return (unsigned char*)ld(22); }
};

DI unsigned pk2(float lo, float hi) { f32x2_t v = {lo, hi}; bf16x2_t b = __builtin_convertvector(v, bf16x2_t); return __builtin_bit_cast(unsigned, b); }
DI float bf2f(short x) { return __builtin_bit_cast(float, ((unsigned)(unsigned short)x) << 16); }
DI float wave_sum(float v) {
#pragma unroll
    for (int o = 1; o < 64; o <<= 1) v += __shfl_xor(v, o);
    return v;
}
#define LDS_WAIT() asm volatile("s_waitcnt lgkmcnt(0)" ::: "memory")

struct Sched {
    int nM, nN, nwg, G, c, pmadd, pmbase, ksplit, kbytes;
    DI void init(int nM_, int nN_, int G_, int c_) { nM = nM_; nN = nN_; nwg = nM_ * nN_; G = G_; c = c_; pmadd = 0; pmbase = 0; ksplit = 1; kbytes = 0; }
    DI bool next(int i, pg8::Unit& u) const {
        const long L = (long)i * G + c; if (L >= (long)nwg * ksplit) return false;
        int wgid = (int)L; u.ko = 0;
        if (ksplit > 1) { u.ko = (wgid % ksplit) * kbytes; wgid /= ksplit; }
        else { const int q = nwg / 8, r = nwg % 8, xcd = wgid % 8, off = wgid / 8; wgid = (xcd < r ? xcd * (q + 1) : r * (q + 1) + (xcd - r) * q) + off; }
        const int nig = 8 * nN, gid = wgid / nig, fm = gid * 8, gsz = (nM - fm) < 8 ? (nM - fm) : 8;
        u.pm = fm + ((wgid % nig) % gsz); u.pn = (wgid % nig) / gsz;
        if (u.pm > 0) u.pm += pmadd;
        u.pm += pmbase;
        return true;
    }
    DI void a_ready(const pg8::Unit&) const {}
    DI void done(const pg8::Unit&) const {}
};

template <int ACT> DI void store_tile_bf16(const pg8::f32x4 (&acc)[2][2][4][2], gbf16* base, int ld, const gfloat* bias, int wr, int wc, int fr, int fq) {
    const unsigned loff = (unsigned)((wr * 64 + fr) * ld + wc * 32 + 8 * fq) * 2u;
    f32x4 bv[2][2];
#pragma unroll
    for (int bj = 0; bj < 2; ++bj)
#pragma unroll
        for (int n = 0; n < 2; ++n) bv[bj][n] = bias ? *(const GAS f32x4*)(bias + wc * 32 + 8 * fq + bj * 128 + 4 * n) : (f32x4){0.f, 0.f, 0.f, 0.f};
#pragma unroll
    for (int ai = 0; ai < 2; ++ai)
#pragma unroll
        for (int m = 0; m < 4; ++m) { gchar* rowp = (gchar*)base + (size_t)((ai * 128 + m * 16) * ld) * 2u;
#pragma unroll
            for (int bj = 0; bj < 2; ++bj) { f32x4 a = acc[ai][bj][m][0] + bv[bj][0], b = acc[ai][bj][m][1] + bv[bj][1];
                if (ACT == 1) {
#pragma unroll
                    for (int e = 0; e < 4; ++e) { const float x = fmaxf(a[e], 0.f); a[e] = x * x; const float y = fmaxf(b[e], 0.f); b[e] = y * y; } }
                u32x4 w; w.x = pk2(a.x, a.y); w.y = pk2(a.z, a.w); w.z = pk2(b.x, b.y); w.w = pk2(b.z, b.w);
                *(GAS u32x4*)(rowp + bj * 256 + loff) = w; } }
}
DI void store_kfrag(const pg8::f32x4 (&acc)[2][2][4][2], gbf16* base, int wr, int wc, int fr, int fq) {
    const unsigned loff = (unsigned)(wr * 2 * 16384 + (wc >> 1) * 2048 + fq * 512 + (wc & 1) * 256 + fr * 8) * 2u;
#pragma unroll
    for (int ai = 0; ai < 2; ++ai)
#pragma unroll
        for (int m = 0; m < 4; ++m)
#pragma unroll
            for (int bj = 0; bj < 2; ++bj) { const f32x4 a = acc[ai][bj][m][0], b = acc[ai][bj][m][1];
                u32x4 w; w.x = pk2(a.x, a.y); w.y = pk2(a.z, a.w); w.z = pk2(b.x, b.y); w.w = pk2(b.z, b.w);
                *(GAS u32x4*)((gchar*)base + (size_t)((ai * 4 + (m >> 1)) * 16384 + bj * 2 * 2048 + (m & 1) * 128) * 2u + loff) = w; }
}
DI void store_vfrag(const pg8::f32x4 (&acc)[2][2][4][2], gbf16* base, int wr, int wc, int fr, int fq) {
    const unsigned loff = (unsigned)(wc * 8 * 2048 + wr * 2048 + (fq >> 1) * 512 + fr * 8 + (fq & 1) * 4) * 2u;
#pragma unroll
    for (int ai = 0; ai < 2; ++ai)
#pragma unroll
        for (int m = 0; m < 4; ++m)
#pragma unroll
            for (int bj = 0; bj < 2; ++bj) { const f32x4 a = acc[ai][bj][m][0], b = acc[ai][bj][m][1];
                gchar* q = (gchar*)base + (size_t)(bj * 32 * 2048 + ai * 2 * 2048 + (m >> 1) * 1024 + (m & 1) * 128) * 2u + loff;
                u32x2 w0; w0.x = pk2(a.x, a.y); w0.y = pk2(a.z, a.w); u32x2 w1; w1.x = pk2(b.x, b.y); w1.y = pk2(b.z, b.w);
                *(GAS u32x2*)q = w0; *(GAS u32x2*)(q + 512) = w1; }
}
enum { M_URM = 0, M_SWAP, M_DFTL, M_DFTC, M_MIXF, M_MIXC, M_RES1, M_RES2, M_HID, M_RES1K, M_RES2K };
struct UEpi {
    static constexpr bool PERM = true, AFTER_DRAIN = false;
    int mode, layer; PP p;
    DI void operator()(const pg8::f32x4 (&acc)[2][2][4][2], const pg8::Unit& u, int wr, int wc, int fr, int fq) const {
        unsigned char* ws = p.ws();
        if (mode == M_RES1K || mode == M_RES2K) {
            const int kc = u.ko / (mode == M_RES1K ? (D / 4) * 2 : (DFF / 4) * 2);
            const int r2 = u.pm * 256 - TL;
            const gfloat* srcb = (mode == M_RES1K && layer == 0) ? p.in(2) : (const gfloat*)(ws + WS_HCTX);
            const gchar* sp = (const gchar*)(srcb + (size_t)r2 * D + u.pn * 256);
            gchar* d = (gchar*)((gfloat*)(ws + (kc == 0 ? WS_HCTX : WS_SIDE + (size_t)(kc - 1) * 8 * MiB)) + (size_t)r2 * D + u.pn * 256);
            const gfloat* gp = (const gfloat*)(ws + WS_MODS) + (size_t)layer * 9 * 6144 + (mode == M_RES1K ? 2 : 5) * D + 8 * 6144 + u.pn * 256 + wc * 32 + 8 * fq;
            const unsigned loff = (unsigned)((wr * 64 + fr) * D + wc * 32 + 8 * fq) * 4u;
            f32x4 gv[2][2];
#pragma unroll
            for (int bj = 0; bj < 2; ++bj)
#pragma unroll
                for (int n = 0; n < 2; ++n) gv[bj][n] = *(const GAS f32x4*)(gp + bj * 128 + 4 * n);
#pragma unroll
            for (int ai = 0; ai < 2; ++ai)
#pragma unroll
                for (int m = 0; m < 4; ++m) { const size_t ro = (size_t)((ai * 128 + m * 16) * D) * 4u;
#pragma unroll
                    for (int bj = 0; bj < 2; ++bj) {
                        f32x4 x0 = (f32x4){0.f, 0.f, 0.f, 0.f}, x1 = x0;
                        if (kc == 0) { x0 = *(const GAS f32x4*)(sp + ro + bj * 512 + loff); x1 = *(const GAS f32x4*)(sp + ro + bj * 512 + 16 + loff); }
                        *(GAS f32x4*)(d + ro + bj * 512 + loff) = x0 + gv[bj][0] * acc[ai][bj][m][0];
                        *(GAS f32x4*)(d + ro + bj * 512 + 16 + loff) = x1 + gv[bj][1] * acc[ai][bj][m][1]; } }
            return;
        }
        if (mode == M_RES1 || mode == M_RES2) {
            const bool first = (mode == M_RES1 && layer == 0);
            const int row0 = u.pm * 256; const bool lat = row0 < TL; const int r2 = lat ? row0 : row0 - TL, midx = lat ? (row0 >> 11) : 8;
            const gfloat* srcb = lat ? (first ? p.in(0) : (const gfloat*)p.out()) : (first ? p.in(2) : (const gfloat*)(ws + WS_HCTX));
            gfloat* dstb = lat ? p.out() : (gfloat*)(ws + WS_HCTX);
            const gchar* s = (const gchar*)(srcb + (size_t)r2 * D + u.pn * 256);
            gchar* d = (gchar*)(dstb + (size_t)r2 * D + u.pn * 256);
            const gfloat* gp = (const gfloat*)(ws + WS_MODS) + (size_t)layer * 9 * 6144 + (mode == M_RES1 ? 2 : 5) * D + midx * 6144 + u.pn * 256 + wc * 32 + 8 * fq;
            const unsigned loff = (unsigned)((wr * 64 + fr) * D + wc * 32 + 8 * fq) * 4u;
            f32x4 gv[2][2];
#pragma unroll
            for (int bj = 0; bj < 2; ++bj)
#pragma unroll
                for (int n = 0; n < 2; ++n) gv[bj][n] = *(const GAS f32x4*)(gp + bj * 128 + 4 * n);
#pragma unroll
            for (int ai = 0; ai < 2; ++ai)
#pragma unroll
                for (int m = 0; m < 4; ++m) { const size_t ro = (size_t)((ai * 128 + m * 16) * D) * 4u;
#pragma unroll
                    for (int bj = 0; bj < 2; ++bj) {
                        const f32x4 x0 = *(const GAS f32x4*)(s + ro + bj * 512 + loff), x1 = *(const GAS f32x4*)(s + ro + bj * 512 + 16 + loff);
                        *(GAS f32x4*)(d + ro + bj * 512 + loff) = x0 + gv[bj][0] * acc[ai][bj][m][0];
                        *(GAS f32x4*)(d + ro + bj * 512 + 16 + loff) = x1 + gv[bj][1] * acc[ai][bj][m][1]; } }
            return;
        }
        gbf16* base; int ld; const gfloat* bias = nullptr;
        if (mode == M_URM) {
            if (u.pn >= 4) { store_kfrag(acc, (gbf16*)(ws + WS_KT) + (size_t)(u.pm * 64 + (u.pn - 4) * 4) * 2048, wr, wc, fr, fq); return; }
            ld = URM; base = (gbf16*)(ws + WS_URM) + (size_t)(u.pm * 256) * URM + u.pn * 256; }
        else if (mode == M_HID) { ld = DFF; base = (gbf16*)(ws + WS_HID) + (size_t)(u.pm * 256) * DFF + u.pn * 256; }
        else if (mode == M_SWAP) {
            if (u.pm != 0) { store_vfrag(acc, (gbf16*)(ws + WS_VT) + (size_t)(u.pn * 64 + (u.pm - 7) * 4) * 2048, wr, wc, fr, fq); return; }
            const int tok0 = u.pn * 256; const bool lat = tok0 < TL;
            const int bb = lat ? (tok0 >> 11) : ((tok0 - TL) >> 8), l0 = lat ? (tok0 & (SEQ - 1)) : 0; ld = lat ? SEQ : CTX;
            base = (gbf16*)(ws + (lat ? WS_UTL : WS_UTC)) + (size_t)(bb * 256) * ld + l0;
        } else if (mode == M_DFTL || mode == M_DFTC) {
            const int L = mode == M_DFTL ? SEQ : CTX, lshift = mode == M_DFTL ? 11 : 8, rowbase = mode == M_DFTL ? 0 : TL;
            const int row0 = u.pm * 256, cs = row0 >> lshift, lp0 = row0 & (L - 1);
            ld = 512; base = (gbf16*)(ws + WS_G12) + (size_t)(rowbase + u.pn * L + lp0) * 512 + cs * 256;
        } else {
            ld = D; base = (gbf16*)(ws + WS_MIX) + (size_t)(u.pm * 256) * D + (mode == M_MIXC ? 256 : 0);
            if (mode == M_MIXC) bias = p.in(15) + layer * 256;
        }
        if (mode == M_HID) store_tile_bf16<1>(acc, base, ld, nullptr, wr, wc, fr, fq);
        else store_tile_bf16<0>(acc, base, ld, bias, wr, wc, fr, fq);
    }
};
DI void run_gemm(LAS unsigned char* lds, const gbf16* A, const gbf16* Bt, int K, int Kext, const Sched& S, int mode, int layer, PP p, const int tid) {
    pg8::Gemm g{(const bf16*)A, (const bf16*)Bt, Kext, 0, K}; UEpi e{mode, layer, p};
    pg8::gemm_phase<UEpi, Sched, true, true>(lds, g, S, e, tid);
}

DI void phase_mods(const PP p, LAS unsigned char* lds, const int tid_, const int bid_) {
    const int tid = tid_, lane = tid & 63, wave = tid >> 6;
    LAS float* s = (LAS float*)lds;
    LAS float* red = (LAS float*)(lds + 36864);
    gfloat* mods = (gfloat*)(p.ws() + WS_MODS);
    for (int i = tid; i < 9 * 1024; i += 512) { const int j = i >> 10, k = i & 1023; const float v = j < 8 ? p.in(1)[j * 1024 + k] : p.in(3)[k]; s[i] = v / (1.f + expf(-v)); }
    __syncthreads();
    for (int item = bid_; item < 192; item += gridDim.x) {
        const int layer = item / 96, cgp = item % 96, col = cgp * 64 + lane;
        const gfloat* W = p.in(4) + (size_t)layer * 1024 * 6144 + col;
        float acc[9];
#pragma unroll
        for (int j = 0; j < 9; ++j) acc[j] = 0.f;
        const int k0 = wave * 128;
#pragma unroll 8
        for (int k = k0; k < k0 + 128; ++k) { const float w = W[(size_t)k * 6144];
#pragma unroll
            for (int j = 0; j < 9; ++j) acc[j] += s[j * 1024 + k] * w; }
#pragma unroll
        for (int j = 0; j < 9; ++j) red[(wave * 9 + j) * 64 + lane] = acc[j];
        __syncthreads();
        for (int t = tid; t < 576; t += 512) { const int j = t >> 6, l = t & 63; float v = p.in(5)[layer * 6144 + cgp * 64 + l];
#pragma unroll
            for (int w = 0; w < 8; ++w) v += red[(w * 9 + j) * 64 + l];
            mods[(size_t)(layer * 9 + j) * 6144 + cgp * 64 + l] = v; }
        __syncthreads();
    }
}
DI void make_tables(const PP p, const int tid_, const int bid_) {
    gbf16* DL = (gbf16*)(p.ws() + WS_DFTL); gbf16* DC = (gbf16*)(p.ws() + WS_DFTC);
    const int gt = bid_ * 512 + tid_, NT = gridDim.x * 512;
    for (int i = gt; i < 4096 * 256; i += NT) { const int row = i >> 8, l0 = (i & 255) * 8, cs = row >> 11, lp = row & 2047;
        float v[8];
#pragma unroll
        for (int e = 0; e < 8; ++e) { const int ph = (lp * (l0 + e)) & 2047; const float x = (float)ph * (1.f / 1024.f); v[e] = (cs ? sinpif(x) : cospif(x)) * 0.022097086912079608f; }
        u32x4 w; w.x = pk2(v[0], v[1]); w.y = pk2(v[2], v[3]); w.z = pk2(v[4], v[5]); w.w = pk2(v[6], v[7]);
        *(GAS u32x4*)(DL + (size_t)row * 2048 + l0) = w; }
    for (int i = gt; i < 512 * 32; i += NT) { const int row = i >> 5, l0 = (i & 31) * 8, cs = row >> 8, lp = row & 255;
        float v[8];
#pragma unroll
        for (int e = 0; e < 8; ++e) { const int ph = (lp * (l0 + e)) & 255; const float x = (float)ph * (1.f / 128.f); v[e] = (cs ? sinpif(x) : cospif(x)) * 0.0625f; }
        u32x4 w; w.x = pk2(v[0], v[1]); w.y = pk2(v[2], v[3]); w.z = pk2(v[4], v[5]); w.w = pk2(v[6], v[7]);
        *(GAS u32x4*)(DC + (size_t)row * 256 + l0) = w; }
}
DI void transpose_item(const gfloat* W, int K, int N, gbf16* WT, LAS float* scr, int item, int lane) {
    const int nblk = N / 32, kb = item / nblk, nb = item % nblk, k0 = 64 * kb, n0 = 32 * nb;
#pragma unroll 8
    for (int i = 0; i < 32; ++i) { const int kk = 2 * i + (lane >> 5); scr[kk * 33 + (lane & 31)] = W[(size_t)(k0 + kk) * N + n0 + (lane & 31)]; }
    LDS_WAIT(); asm volatile("" ::: "memory");
    const int c = lane & 7;
#pragma unroll
    for (int j = 0; j < 4; ++j) { const int n = (lane >> 3) + 8 * j; const LAS float* sp = scr + (8 * c) * 33 + n;
        u32x4 o; o.x = pk2(sp[0 * 33], sp[1 * 33]); o.y = pk2(sp[2 * 33], sp[3 * 33]); o.z = pk2(sp[4 * 33], sp[5 * 33]); o.w = pk2(sp[6 * 33], sp[7 * 33]);
        *(GAS u32x4*)(WT + (size_t)(n0 + n) * K + k0 + 8 * c) = o; }
    LDS_WAIT(); asm volatile("" ::: "memory");
}
DI void conv_weights(const PP p, int layer, LAS unsigned char* lds, const int tid_, const int bid_) {
    const int lane = tid_ & 63, wave = tid_ >> 6;
    LAS float* scr = (LAS float*)(lds + 57344 + wave * 8448);
    const int gw = bid_ * 8 + wave, NGW = gridDim.x * 8;
    const gfloat* Win = p.in(8) + (size_t)layer * D * DIN; const gfloat* Wout = p.in(17) + (size_t)layer * D * D;
    const gfloat* W1 = p.in(18) + (size_t)layer * D * DFF; const gfloat* W2 = p.in(19) + (size_t)layer * DFF * D; const gfloat* Wpw = p.in(14) + (size_t)layer * 256 * 256;
    gbf16* WinT = (gbf16*)(p.ws() + WS_WIN); gbf16* WoutT = (gbf16*)(p.ws() + WS_WOUT); gbf16* W1T = (gbf16*)(p.ws() + WS_W1); gbf16* W2T = (gbf16*)(p.ws() + WS_W2); gbf16* WpwT = (gbf16*)(p.ws() + WS_WPW);
    constexpr int I_IN = 16 * 72, I_OUT = 16 * 32, I_1 = 16 * 128, I_2 = 64 * 32, I_PW = 4 * 8, NIT = I_IN + I_OUT + I_1 + I_2 + I_PW;
    for (int it = gw; it < NIT; it += NGW) {
        int r = it;
        if (r < I_IN) { transpose_item(Win, D, DIN, WinT, scr, r, lane); continue; } r -= I_IN;
        if (r < I_OUT) { transpose_item(Wout, D, D, WoutT, scr, r, lane); continue; } r -= I_OUT;
        if (r < I_1) { transpose_item(W1, D, DFF, W1T, scr, r, lane); continue; } r -= I_1;
        if (r < I_2) { transpose_item(W2, DFF, D, W2T, scr, r, lane); continue; } r -= I_2;
        transpose_item(Wpw, 256, 256, WpwT, scr, r, lane);
    }
    const gfloat* Wf = p.in(9) + (size_t)layer * 256 * 256; gbf16* Wf2t = (gbf16*)(p.ws() + WS_WF2);
    for (int o = bid_ * 512 + tid_; o < 256 * 512; o += gridDim.x * 512) {
        const int n = o >> 9, k = o & 511, cs = k >> 8, g = (k >> 6) & 3, j = k & 63;
        float acc = 0.f;
        for (int jp = 0; jp < 64; ++jp) { const float x = (float)((j * jp) & 63) * (1.f / 32.f); const float t = cs ? sinpif(x) : cospif(x); acc += t * Wf[(size_t)(g * 64 + jp) * 256 + n]; }
        acc *= cs ? -0.125f : 0.125f;
        Wf2t[(size_t)n * 512 + k] = (bf16)(pk2(acc, 0.f) & 0xffffu);
    }
}
DI void phase_norm(const PP p, int layer, int which, int nrows, const int tid_, const int bid_) {
    const int lane = tid_ & 63, wave = tid_ >> 6;
    const int gw = bid_ * 8 + wave, NGW = gridDim.x * 8;
    const bool first = (layer == 0 && which == 0);
    const gfloat* hl = first ? p.in(0) : p.out(); const gfloat* hc = first ? p.in(2) : (const gfloat*)(p.ws() + WS_HCTX);
    const gfloat* g = p.in(which ? 7 : 6) + layer * D;
    const gfloat* mods = (const gfloat*)(p.ws() + WS_MODS) + (size_t)layer * 9 * 6144 + (which ? 3 : 0) * D;
    gbf16* hn = (gbf16*)(p.ws() + WS_HN);
    for (int row = gw; row < nrows; row += NGW) {
        const gfloat* src = row < TL ? hl + (size_t)row * D : hc + (size_t)(row - TL) * D;
        const int midx = row < TL ? (row >> 11) : 8;
        f32x4 v[4]; float ss = 0.f;
#pragma unroll
        for (int jj = 0; jj < 4; ++jj) v[jj] = *(const GAS f32x4*)(src + 4 * (lane + 64 * jj));
        if (!first && row >= TL) {
            const gfloat* sd = (const gfloat*)(p.ws() + WS_SIDE) + (size_t)(row - TL) * D; gfloat* hw = (gfloat*)(p.ws() + WS_HCTX) + (size_t)(row - TL) * D;
#pragma unroll
            for (int jj = 0; jj < 4; ++jj) { const int k = 4 * (lane + 64 * jj);
                v[jj] += (*(const GAS f32x4*)(sd + k) + *(const GAS f32x4*)(sd + 2 * 1024 * 1024 + k)) + *(const GAS f32x4*)(sd + 4 * 1024 * 1024 + k);
                *(GAS f32x4*)(hw + k) = v[jj]; } }
#pragma unroll
        for (int jj = 0; jj < 4; ++jj) ss += (v[jj].x * v[jj].x + v[jj].y * v[jj].y) + (v[jj].z * v[jj].z + v[jj].w * v[jj].w);
        const float rinv = 1.f / sqrtf(wave_sum(ss) * (1.f / D) + 1e-6f);
#pragma unroll
        for (int jj = 0; jj < 4; ++jj) { const int k = 4 * (lane + 64 * jj);
            const f32x4 gg = *(const GAS f32x4*)(g + k), sh = *(const GAS f32x4*)(mods + midx * 6144 + k), sc = *(const GAS f32x4*)(mods + midx * 6144 + D + k);
            const f32x4 y = (v[jj] * rinv * gg) * (sc + 1.f) + sh;
            u32x2 w; w.x = pk2(y.x, y.y); w.y = pk2(y.z, y.w);
            *(GAS u32x2*)(hn + (size_t)row * D + k) = w; }
    }
}
DI void phase_final(const PP p, const int tid_, const int bid_) {
    const int lane = tid_ & 63, wave = tid_ >> 6;
    const int gw = bid_ * 8 + wave, NGW = gridDim.x * 8;
    const gfloat* g = p.in(20);
    for (int row = gw; row < TL; row += NGW) {
        gfloat* src = p.out() + (size_t)row * D;
        f32x4 v[4]; float ss = 0.f;
#pragma unroll
        for (int jj = 0; jj < 4; ++jj) { v[jj] = *(const GAS f32x4*)(src + 4 * (lane + 64 * jj)); ss += (v[jj].x * v[jj].x + v[jj].y * v[jj].y) + (v[jj].z * v[jj].z + v[jj].w * v[jj].w); }
        const float rinv = 1.f / sqrtf(wave_sum(ss) * (1.f / D) + 1e-6f);
#pragma unroll
        for (int jj = 0; jj < 4; ++jj) { const int k = 4 * (lane + 64 * jj); const f32x4 gg = *(const GAS f32x4*)(g + k); *(GAS f32x4*)(src + k) = v[jj] * rinv * gg; }
    }
}
DI void conv_tile(const PP p, int layer, int seqbase, int L, int t0, LAS unsigned char* lds, const int tid_, const int bid_) {
    int tid = tid_; asm volatile("" : "+v"(tid));
    const int lane = tid & 63;
    LAS float* vt = (LAS float*)lds;
    LAS float* red1 = (LAS float*)(lds + 98304);
    LAS float* red2 = (LAS float*)(lds + 98304 + 1024);
    const gbf16* Urm = (const gbf16*)(p.ws() + WS_URM);
    gbf16* cva = (gbf16*)(p.ws() + WS_CVA);
    __syncthreads();
    for (int idx = tid; idx < 94 * 32; idx += 512) { const int tt = idx >> 5, c8 = (idx & 31) * 8, pos = t0 - 15 + tt;
        float v[8];
        if (pos >= 0 && pos < L) { const gbf16* rp = Urm + (size_t)(seqbase + pos) * URM + c8; const bf16x8 a8 = *(const GAS bf16x8*)rp, g8 = *(const GAS bf16x8*)(rp + 256);
#pragma unroll
            for (int e = 0; e < 8; ++e) { const float a = bf2f(a8[e]), gt = bf2f(g8[e]); v[e] = a / (1.f + __expf(-gt)); } }
        else {
#pragma unroll
            for (int e = 0; e < 8; ++e) v[e] = 0.f; }
        *(LAS f32x4*)(vt + tt * 256 + c8) = (f32x4){v[0], v[1], v[2], v[3]}; *(LAS f32x4*)(vt + tt * 256 + c8 + 4) = (f32x4){v[4], v[5], v[6], v[7]}; }
    __syncthreads();
    const int c = tid & 255, th = tid >> 8, wq = (tid >> 6) & 3;
    const gfloat* dw = p.in(10) + (size_t)layer * 31 * 256 + c;
    float w[31];
#pragma unroll
    for (int tap = 0; tap < 31; ++tap) w[tap] = dw[tap * 256];
    const float bias = p.in(11)[layer * 256 + c], lg = p.in(12)[layer * 256 + c], lb = p.in(13)[layer * 256 + c];
    for (int ch = 0; ch < 4; ++ch) {
        const int tb = th * 32 + ch * 8;
        float o[8];
#pragma unroll
        for (int e = 0; e < 8; ++e) { float acc = bias;
#pragma unroll
            for (int tap = 0; tap < 31; ++tap) acc += w[tap] * vt[(tb + e + tap) * 256 + c];
            o[e] = acc; }
#pragma unroll
        for (int e = 0; e < 8; ++e) { const float s1 = wave_sum(o[e]); if (lane == 0) red1[(tb + e) * 4 + wq] = s1; }
        __syncthreads();
#pragma unroll
        for (int e = 0; e < 8; ++e) { const LAS float* r = red1 + (tb + e) * 4; const float mean = ((r[0] + r[1]) + (r[2] + r[3])) * (1.f / 256.f); o[e] -= mean;
            const float s2 = wave_sum(o[e] * o[e]); if (lane == 0) red2[(tb + e) * 4 + wq] = s2; }
        __syncthreads();
#pragma unroll
        for (int e = 0; e < 8; ++e) { const LAS float* r = red2 + (tb + e) * 4; const float var = ((r[0] + r[1]) + (r[2] + r[3])) * (1.f / 256.f);
            const float y = o[e] / sqrtf(var + 1e-5f) * lg + lb; const float z = y / (1.f + __expf(-y));
            cva[(size_t)(seqbase + t0 + tb + e) * 256 + c] = (bf16)(pk2(z, 0.f) & 0xffffu); }
    }
}
#define MFMA32(a, b, c) __builtin_amdgcn_mfma_f32_32x32x16_bf16((a), (b), (c), 0, 0, 0)
DI void attn_load(const gchar* KtB, const gchar* VtB, int tile, int b, int h, int rs, int lane, bf16x8 (&kf)[4], bf16x8 (&vf)[2][2]) {
    const int tileg = tile >= 8 ? (b * 64 + rs * 2 + (tile - 8)) : (TL / 32 + b * 8 + tile);
    const unsigned off = (unsigned)((tileg * 8 + h) * 2048 + lane * 8) * 2u;
#pragma unroll
    for (int ks = 0; ks < 4; ++ks) kf[ks] = *(const GAS bf16x8*)(KtB + off + ks * 1024);
#pragma unroll
    for (int dt = 0; dt < 2; ++dt)
#pragma unroll
        for (int t = 0; t < 2; ++t) vf[dt][t] = *(const GAS bf16x8*)(VtB + off + (dt * 2 + t) * 1024);
}
template <bool LOCAL> DI void attn_compute(const bf16x8 (&kf)[4], const bf16x8 (&vf)[2][2], const LAS bf16x8* ql_, f32x16 (&o)[2][2], float (&m)[2], float (&ls)[2],
                                           const LAS float* bl, int lt, int ql, int half) {
    const float SCL = 0.125f * 1.4426950408889634f, NINF = -__builtin_inff();
#pragma unroll
    for (int qt = 0; qt < 2; ++qt) {
        f32x16 sv;
#pragma unroll
        for (int v = 0; v < 16; ++v) sv[v] = 0.f;
#pragma unroll
        for (int ks = 0; ks < 4; ++ks) sv = MFMA32(kf[ks], ql_[(qt * 4 + ks) * 64], sv);
        float mx = NINF;
        if (LOCAL) {
            const int qc = qt * 32 + ql, cs = min(max(qc - 8, 0), 48);
            const int kc0 = (lt & 1) * 32 + 4 * half;
            const int d0 = kc0 - cs, b0 = (lt >> 1) * 31 + kc0 - qc + 15;
            float bias[16];
#pragma unroll
            for (int v = 0; v < 16; ++v) { const int dv = (v & 3) + 8 * (v >> 2); const int bi = min(max(b0 + dv, 0), 247); bias[v] = ((const volatile LAS float*)bl)[bi]; }
#pragma unroll
            for (int v = 0; v < 16; ++v) { const int dv = (v & 3) + 8 * (v >> 2); const bool valid = (unsigned)(d0 + dv) < 16u;
                const float x = valid ? sv[v] * SCL + bias[v] : NINF; sv[v] = x; mx = fmaxf(mx, x); }
        } else {
#pragma unroll
            for (int v = 0; v < 16; ++v) { const float x = sv[v] * SCL; sv[v] = x; mx = fmaxf(mx, x); }
        }
        mx = fmaxf(mx, __shfl_xor(mx, 32));
        const float mn = fmaxf(m[qt], mx), alpha = __builtin_amdgcn_exp2f(m[qt] - mn); m[qt] = mn;
        float sum = 0.f;
#pragma unroll
        for (int v = 0; v < 16; ++v) { const float pv = __builtin_amdgcn_exp2f(sv[v] - mn); sv[v] = pv; sum += pv; }
        ls[qt] = ls[qt] * alpha + sum;
#pragma unroll
        for (int dt = 0; dt < 2; ++dt)
#pragma unroll
            for (int v = 0; v < 16; ++v) o[dt][qt][v] *= alpha;
#pragma unroll
        for (int t = 0; t < 2; ++t) { u32x4 pw; pw.x = pk2(sv[8 * t + 0], sv[8 * t + 1]); pw.y = pk2(sv[8 * t + 2], sv[8 * t + 3]); pw.z = pk2(sv[8 * t + 4], sv[8 * t + 5]); pw.w = pk2(sv[8 * t + 6], sv[8 * t + 7]);
            const bf16x8 pf = __builtin_bit_cast(bf16x8, pw);
#pragma unroll
            for (int dt = 0; dt < 2; ++dt) o[dt][qt] = MFMA32(vf[dt][t], pf, o[dt][qt]); }
    }
}
DI void attn_item(const PP p, int layer, int b, int qbase, int nloc, int r, LAS unsigned char* lds, const int tid_, const int bid_) {
    int tid = tid_; asm volatile("" : "+v"(tid));
    const int lane = tid & 63, h = __builtin_amdgcn_readfirstlane(tid >> 6), ql = lane & 31, half = lane >> 5;
    const gchar* UrmB = (const gchar*)(p.ws() + WS_URM); const gchar* KtB = (const gchar*)(p.ws() + WS_KT); const gchar* VtB = (const gchar*)(p.ws() + WS_VT);
    LAS float* bl = (LAS float*)(lds + h * 9216);
    LAS bf16x8* qlds = (LAS bf16x8*)(lds + h * 9216 + 1024) + lane;
    const int rs = min(max(r - 4, 0), 24);
    const float LOG2E = 1.4426950408889634f, NINF = -__builtin_inff();
    __syncthreads();
    if (nloc) { const gfloat* rp = p.in(16) + (size_t)(layer * 8 + h) * 465;
        for (int i = lane; i < 248; i += 64) { const int kr = i / 31, co = i - kr * 31; bl[i] = rp[(rs - r + 7 + kr) * 31 + co] * LOG2E; } }
    __syncthreads();
#pragma unroll
    for (int qt = 0; qt < 2; ++qt) { const unsigned qoff = (unsigned)((qbase + qt * 32 + ql) * URM + 512 + h * 64 + 32 * half) * 2u;
#pragma unroll
        for (int ks = 0; ks < 4; ++ks) qlds[(qt * 4 + ks) * 64] = *(const GAS bf16x8*)(UrmB + qoff + 16 * ks); }
    f32x16 o[2][2];
#pragma unroll
    for (int a = 0; a < 2; ++a)
#pragma unroll
        for (int c = 0; c < 2; ++c)
#pragma unroll
            for (int v = 0; v < 16; ++v) o[a][c][v] = 0.f;
    float m[2] = {NINF, NINF}, ls[2] = {0.f, 0.f};
    const int ntiles = 8 + nloc;
    bf16x8 kf[4], vf[2][2], kn[4], vn[2][2];
    attn_load(KtB, VtB, 0, b, h, rs, lane, kf, vf);
#pragma unroll 1
    for (int tile = 0; tile < ntiles; ++tile) {
        asm volatile("" ::: "memory");
        const int tn = tile + 1 < ntiles ? tile + 1 : tile;
        attn_load(KtB, VtB, tn, b, h, rs, lane, kn, vn);
        if (tile < 8) attn_compute<false>(kf, vf, qlds, o, m, ls, bl, 0, ql, half);
        else attn_compute<true>(kf, vf, qlds, o, m, ls, bl, tile - 8, ql, half);
#pragma unroll
        for (int ks = 0; ks < 4; ++ks) kf[ks] = kn[ks];
#pragma unroll
        for (int dt = 0; dt < 2; ++dt)
#pragma unroll
            for (int t = 0; t < 2; ++t) vf[dt][t] = vn[dt][t];
    }
    int tid2 = tid_; asm volatile("" : "+v"(tid2));
    const int ql2 = tid2 & 31, half2 = (tid2 >> 5) & 1; gbf16* mixo = (gbf16*)(p.ws() + WS_MIX);
#pragma unroll
    for (int qt = 0; qt < 2; ++qt) { const float lt_ = ls[qt] + __shfl_xor(ls[qt], 32); const float inv = 1.f / lt_; const int token = qbase + qt * 32 + ql2;
#pragma unroll
        for (int dt = 0; dt < 2; ++dt)
#pragma unroll
            for (int i = 0; i < 4; ++i) { const int d = dt * 32 + 8 * i + 4 * half2; u32x2 w; w.x = pk2(o[dt][qt][4 * i] * inv, o[dt][qt][4 * i + 1] * inv); w.y = pk2(o[dt][qt][4 * i + 2] * inv, o[dt][qt][4 * i + 3] * inv);
                *(GAS u32x2*)((gchar*)mixo + (unsigned)(token * D + 512 + h * 64 + d) * 2u) = w; } }
}
DI void run_phase(const PP p, int ph, LAS unsigned char* lds, const int tid, const int c, const int skip = 0) {
    const int G = gridDim.x;
    if (ph == 0) { phase_mods(p, lds, tid, c); make_tables(p, tid, c); conv_weights(p, 0, lds, tid, c); return; }
    if (ph == NPH - 1) { phase_final(p, tid, c); return; }
    const int layer = (ph - 1) >> 3, sub = (ph - 1) & 7;
    const int M = layer == 0 ? TA : TL;
    if (sub == 0) { if (layer == 1) conv_weights(p, 1, lds, tid, c); phase_norm(p, layer, 0, TA, tid, c); return; }
    if (sub == 5) { phase_norm(p, layer, 1, M, tid, c); return; }
    const int H = G / 2 > 0 ? G / 2 : 1;
#pragma unroll 1
    for (int j = 0; j < 2; ++j) {
        unsigned char* ws = p.ws();
        const gbf16* A = nullptr; const gbf16* Bt = nullptr; int K = 0, nM = 0, nN = 0, cc = c, pmadd = 0, mode = 0, pmbase = 0, ksplit = 1; bool valid = true;
        if (sub == 1) {
            if (j == 0) { A = (const gbf16*)(ws + WS_HN); Bt = (const gbf16*)(ws + WS_WIN) + (size_t)256 * D; K = D; nM = TA / 256; nN = 6; mode = M_URM; }
            else { A = (const gbf16*)(ws + WS_WIN); Bt = (const gbf16*)(ws + WS_HN); K = D; nM = 3; nN = TA / 256; cc = (c + (G - (432 % G))) % G; pmadd = 6; mode = M_SWAP; }
        } else if (sub == 2) {
            if (j == 0) { A = (const gbf16*)(ws + WS_DFTL); Bt = (const gbf16*)(ws + WS_UTL); K = SEQ; nM = 16; nN = 8; mode = M_DFTL; }
            else { A = (const gbf16*)(ws + WS_DFTC); Bt = (const gbf16*)(ws + WS_UTC); K = CTX; nM = 2; nN = 8; cc = (c + H) % G; mode = M_DFTC; valid = (layer == 0); }
        } else if (sub == 3) {
            if (j == 0) { A = (const gbf16*)(ws + WS_G12); Bt = (const gbf16*)(ws + WS_WF2); K = 512; nM = M / 256; nN = 1; mode = M_MIXF; }
            else { A = (const gbf16*)(ws + WS_CVA); Bt = (const gbf16*)(ws + WS_WPW); K = 256; nM = M / 256; nN = 1; cc = (c + G - ((M / 256) % G)) % G; mode = M_MIXC; }
        } else if (sub == 4) { A = (const gbf16*)(ws + WS_MIX); Bt = (const gbf16*)(ws + WS_WOUT); K = D; nN = 4;
            if (j == 0) { nM = TL / 256; mode = M_RES1; } else { nM = TC / 256; pmbase = TL / 256; ksplit = 4; mode = M_RES1K; valid = (layer == 0); }
        }
        else if (sub == 6) { A = (const gbf16*)(ws + WS_HN); Bt = (const gbf16*)(ws + WS_W1); K = D; nM = M / 256; nN = 16; mode = M_HID; valid = (j == 0); }
        else { A = (const gbf16*)(ws + WS_HID); Bt = (const gbf16*)(ws + WS_W2); K = DFF; nN = 4;
            if (j == 0) { nM = TL / 256; mode = M_RES2; } else { nM = TC / 256; pmbase = TL / 256; ksplit = 4; mode = M_RES2K; valid = (layer == 0); }
        }
        if (valid && !(skip & 1)) { Sched S; S.init(nM, nN, G, cc); S.pmadd = pmadd; S.pmbase = pmbase; S.ksplit = ksplit; S.kbytes = (K / ksplit) * 2; int tj = tid; asm volatile("" : "+v"(tj)); run_gemm(lds, A, Bt, K, ksplit > 1 ? K / ksplit : 0, S, mode, layer, p, tj); }
    }
    if (sub == 2) {
        const int natt = (skip & 4) ? 0 : (layer == 0 ? 288 : 256), nconv = (skip & 2) ? 0 : (layer == 0 ? 288 : 256);
        unsigned* ctr = (unsigned*)(p.ws() + WS_CTL) + 64 * layer + 16 * (skip != 0);
        LAS int* slot = (LAS int*)(lds + LDSP_OFF + 512);
#pragma unroll 1
        for (;;) {
            __syncthreads();
            if (tid == 0) *slot = (int)__hip_atomic_fetch_add(ctr, 1u, __ATOMIC_RELAXED, __HIP_MEMORY_SCOPE_AGENT);
            __syncthreads();
            const int it = __builtin_amdgcn_readfirstlane(*slot);
            if (it >= natt + nconv) break;
            if (it < natt) {
                if (it < 256) attn_item(p, layer, it >> 5, (it >> 5) * SEQ + (it & 31) * 64, 16, it & 31, lds, tid, c);
                else { const int i2 = it - 256; attn_item(p, layer, i2 >> 2, TL + (i2 >> 2) * CTX + (i2 & 3) * 64, 0, 0, lds, tid, c); }
            } else {
                const int ic = it - natt; const bool lat = ic < 256; const int i2 = ic - 256;
                conv_tile(p, layer, lat ? (ic >> 5) * SEQ : TL + (i2 >> 2) * CTX, lat ? SEQ : CTX, lat ? (ic & 31) * 64 : (i2 & 3) * 64, lds, tid, c);
            }
        }
    }
}

__global__ void __launch_bounds__(512, 2) fwd_kernel(Params prm) {
    extern __shared__ __attribute__((aligned(16))) unsigned char lds_raw[];
    LAS unsigned char* lds = (LAS unsigned char*)lds_raw;
    {
        const unsigned long long* ka = (const unsigned long long*)__builtin_amdgcn_kernarg_segment_ptr();
        if (threadIdx.x < 23) ((LAS unsigned long long*)(lds + LDSP_OFF))[threadIdx.x] = ka[threadIdx.x];
    }
    __syncthreads();
    PP p; p.P = (const LAS unsigned long long*)(lds + LDSP_OFF);
    const int lo = prm.ph_lo, hi = prm.ph_hi;
    const int wave_s = __builtin_amdgcn_readfirstlane((int)threadIdx.x >> 6);
#pragma unroll 1
    for (int ph = lo; ph < hi; ++ph) {
        if (ph > lo) cg::this_grid().sync();
        int lane_; asm volatile("v_mbcnt_lo_u32_b32 %0, -1, 0\n\tv_mbcnt_hi_u32_b32 %0, -1, %0" : "=v"(lane_));
        int tid = wave_s * 64 + lane_, bid = blockIdx.x;
        asm volatile("" : "+s"(bid));
        run_phase(p, ph, lds, tid, bid);
        __syncthreads();
#ifdef PROBE_REPEAT
        if ((PROBE_REPEAT >> ph) & 1) { cg::this_grid().sync(); run_phase(p, ph, lds, tid, bid, PROBE_SKIP); __syncthreads(); }
#endif
    }
}

extern "C" void kernel_launch(void* const* d_in, const int* in_sizes, int n_in, void* d_out, int out_size, void* d_ws, size_t ws_size, hipStream_t stream) {
    static int grid = 0;
    if (grid == 0) {
        if (n_in != 21 || ws_size < WS_SIDE + 24 * MiB) { fprintf(stderr, "kernel_launch: unexpected n_in %d / ws_size %zu\n", n_in, ws_size); grid = -1; return; }
        int dev = 0, cus = 0, per_cu = 0;
        (void)hipGetDevice(&dev); (void)hipDeviceGetAttribute(&cus, hipDeviceAttributeMultiprocessorCount, dev);
        (void)hipFuncSetAttribute((const void*)fwd_kernel, hipFuncAttributeMaxDynamicSharedMemorySize, LDS_BYTES);
        (void)hipOccupancyMaxActiveBlocksPerMultiprocessor(&per_cu, (const void*)fwd_kernel, 512, LDS_BYTES);
        if (per_cu < 1) { fprintf(stderr, "kernel_launch: occupancy query says %d blocks/CU\n", per_cu); per_cu = 1; }
        (void)hipGetLastError();
        grid = cus > 0 ? cus : 256;
    }
    if (grid < 0) return;
    (void)hipMemsetAsync((char*)d_ws + WS_CTL, 0, 4096, stream);
    Params p{};
    for (int i = 0; i < 21; ++i) p.in[i] = (const float*)d_in[i];
    p.out = (float*)d_out; p.ws = (unsigned char*)d_ws;
#if SINGLE_LAUNCH
    p.ph_lo = 0; p.ph_hi = NPH;
    void* args[] = {&p};
    hipError_t e = hipLaunchCooperativeKernel((const void*)fwd_kernel, dim3(grid), dim3(512), args, LDS_BYTES, stream);
    if (e != hipSuccess) fprintf(stderr, "cooperative launch failed: %s (grid %d)\n", hipGetErrorString(e), grid);
#else
    for (int ph = 0; ph < NPH; ++ph) { p.ph_lo = ph; p.ph_hi = ph + 1; hipLaunchKernelGGL(fwd_kernel, dim3(grid), dim3(512), LDS_BYTES, stream, p); }
#endif
}
```

```cpp
#include <hip/hip_runtime.h>
#include <hip/hip_cooperative_groups.h>
#include <cstdio>
#include <cstdint>
namespace cg = cooperative_groups;
namespace pg8 {
#define PG8_LAS __attribute__((address_space(3)))
typedef unsigned short bf16_t;
typedef short bf16x8 __attribute__((ext_vector_type(8)));
typedef float f32x4 __attribute__((ext_vector_type(4)));
typedef unsigned u32x4 __attribute__((ext_vector_type(4)));
constexpr int BM = 256, BK = 64, HALF = 128, HTB = HALF * BK * 2  , STAGE_BYTES = 8 * HTB, NXCD = 8, WGM = 8;

__host__ __device__ __forceinline__ int lds_byte(int r, int c) { const int st = (r >> 4) * 2 + (c >> 5), rr = r & 15, cc = c & 31, ob = rr * 64 + cc * 2; return st * 1024 + (ob ^ (((ob >> 9) & 1) << 5)); }
__host__ __device__ __forceinline__ void stage_rc(int b, int& R, int& C) { const int st = b / 1024, sb = b % 1024, swz = sb ^ (((sb >> 9) & 1) << 5); R = (st >> 1) * 16 + swz / 64; C = (st & 1) * 32 + (swz % 64) / 2; }
__host__ __device__ __forceinline__ int perm32(int rho) { const int n = rho >> 4, i = rho & 15; return 8 * (i >> 2) + 4 * n + (i & 3); }

struct Unit { int pm, pn, ko; };
struct Gemm { const bf16_t* A; const bf16_t* Bt; int M, N, K; };

struct StaticOrder {
    int nM, nN, nwg, G, c;
    __host__ __device__ void init(int M, int N, int G_, int c_) { nM = M / BM; nN = N / BM; nwg = nM * nN; G = G_; c = c_; }
    __host__ __device__ bool next(int i, Unit& u) const {
        const long L = (long)i * G + c; if (L >= nwg) return false;
        int wgid = (int)L; { const int q = nwg / NXCD, r = nwg % NXCD, xcd = wgid % NXCD, off = wgid / NXCD; wgid = (xcd < r ? xcd * (q + 1) : r * (q + 1) + (xcd - r) * q) + off; }
        const int nig = WGM * nN, gid = wgid / nig, fm = gid * WGM, gsz = (nM - fm) < WGM ? (nM - fm) : WGM;
        u.pm = fm + ((wgid % nig) % gsz); u.pn = (wgid % nig) / gsz; u.ko = 0; return true;
    }
    __device__ __forceinline__ void a_ready(const Unit&) const {}
    __device__ __forceinline__ void done(const Unit&) const {}
};

template <class Epi, class Sched, bool ALIGN_EPI = false, bool SP2 = false>
__device__ __forceinline__ void gemm_phase(PG8_LAS unsigned char* lds, const Gemm g, const Sched& S, const Epi& E, const int tid_in) {
    const int tid = tid_in, wid = __builtin_amdgcn_readfirstlane(tid >> 6), lane = tid & 63, wr = wid >> 2, wc = wid & 3, fr = lane & 15, fq = lane >> 4;
    const int K = g.K, nt = (g.M ? g.M : K) / BK;
    unsigned voffA[2], voffB[2];
#pragma unroll
    for (int i = 0; i < 2; ++i) { int R, C; stage_rc(tid * 16 + i * 8192, R, C); const int Rb = Epi::PERM ? ((R & ~31) + perm32(R & 31)) : R;
        voffA[i] = (unsigned)(R * K + C) * 2u; voffB[i] = (unsigned)(Rb * K + C) * 2u; }
    const size_t kstep = (size_t)(BK * 2);
    const size_t hstep = (size_t)HALF * K * 2;
    const size_t tstep = 2 * hstep;
    const unsigned ldsw = (unsigned)wid * 1024u;
    const int aoff = lds_byte(wr * 64 + fr, fq * 8), boff = lds_byte(wc * 32 + fr, fq * 8);
#define PG8_SA(b, h) (((b) * 2 + (h)) * HTB)
#define PG8_SB(b, h) ((4 + (b) * 2 + (h)) * HTB)
#define PG8_STAGE(bufoff, gbase, voff) do { _Pragma("unroll") for (int _i = 0; _i < 2; ++_i) \
        __builtin_amdgcn_global_load_lds((const unsigned*)((const char*)(gbase) + (voff)[_i]), (PG8_LAS unsigned*)(lds + (bufoff) + ldsw + _i * 8192), 16, 0, 0); } while (0)
#define PG8_LDA(dst, b, h) do { _Pragma("unroll") for (int m = 0; m < 4; ++m) _Pragma("unroll") for (int k = 0; k < 2; ++k) dst[m][k] = *(const PG8_LAS bf16x8*)(lds + PG8_SA(b, h) + aoff + m * 2048 + k * 1024); } while (0)
#define PG8_LDB(dst, b, h) do { _Pragma("unroll") for (int n = 0; n < 2; ++n) _Pragma("unroll") for (int k = 0; k < 2; ++k) dst[n][k] = *(const PG8_LAS bf16x8*)(lds + PG8_SB(b, h) + boff + n * 2048 + k * 1024); } while (0)
#define PG8_MMA(ai, bj, At, Bt) do { __builtin_amdgcn_s_setprio(1); _Pragma("unroll") for (int m = 0; m < 4; ++m) _Pragma("unroll") for (int n = 0; n < 2; ++n) _Pragma("unroll") for (int k = 0; k < 2; ++k) \
        acc[ai][bj][m][n] = __builtin_amdgcn_mfma_f32_16x16x32_bf16(Bt[n][k], At[m][k], acc[ai][bj][m][n], 0, 0, 0); __builtin_amdgcn_s_setprio(0); } while (0)
#define PG8_WAIT_V(n) asm volatile("s_waitcnt vmcnt(" #n ")" ::: "memory")
#define PG8_WAIT_L(n) asm volatile("s_waitcnt lgkmcnt(" #n ")" ::: "memory")
#define PG8_BAR __builtin_amdgcn_s_barrier()
#define PG8_SCHED __builtin_amdgcn_sched_barrier(0)
    Unit cur, nxt; int ui = 0;
    if (!S.next(0, cur)) return;
    f32x4 acc[2][2][4][2];
#pragma unroll
    for (int a = 0; a < 2; ++a)
#pragma unroll
        for (int b = 0; b < 2; ++b)
#pragma unroll
            for (int m = 0; m < 4; ++m)
#pragma unroll
                for (int n = 0; n < 2; ++n) acc[a][b][m][n] = (f32x4){0.f, 0.f, 0.f, 0.f};
    bf16x8 At[4][2], B0[2][2], B1[2][2];
    const char* cA = (const char*)g.A + (size_t)cur.pm * tstep + cur.ko; const char* cB = (const char*)g.Bt + (size_t)cur.pn * tstep + cur.ko;
    S.a_ready(cur);
    if constexpr (SP2) {
        PG8_STAGE(PG8_SB(0, 0), cB, voffB); PG8_STAGE(PG8_SB(0, 1), cB + hstep, voffB); PG8_STAGE(PG8_SA(0, 0), cA, voffA); PG8_STAGE(PG8_SA(0, 1), cA + hstep, voffA);
        if (wr == 1) PG8_BAR;
        PG8_WAIT_V(2); PG8_BAR;
        PG8_STAGE(PG8_SB(1, 0), cB + kstep, voffB); PG8_STAGE(PG8_SA(1, 0), cA + kstep, voffA); PG8_STAGE(PG8_SB(1, 1), cB + hstep + kstep, voffB);
        PG8_WAIT_V(6); PG8_BAR;
    } else {
        PG8_STAGE(PG8_SB(0, 0), cB, voffB); PG8_STAGE(PG8_SA(0, 0), cA, voffA); PG8_STAGE(PG8_SB(0, 1), cB + hstep, voffB); PG8_STAGE(PG8_SA(0, 1), cA + hstep, voffA);
        if (wr == 1) PG8_BAR;
        PG8_WAIT_V(4); PG8_BAR;
        PG8_STAGE(PG8_SB(1, 0), cB + kstep, voffB); PG8_STAGE(PG8_SA(1, 0), cA + kstep, voffA); PG8_STAGE(PG8_SB(1, 1), cB + hstep + kstep, voffB);
        PG8_WAIT_V(6); PG8_BAR;
    }
    for (;;) {
        const bool has_next = S.next(ui + 1, nxt);
        const char* nA = has_next ? (const char*)g.A + (size_t)nxt.pm * tstep + nxt.ko : cA; const char* nB = has_next ? (const char*)g.Bt + (size_t)nxt.pn * tstep + nxt.ko : cB;
        for (int t = 0; t < nt; t += 2) {
            const bool last = (t == nt - 2);
            const char* a1 = cA + (size_t)(t + 1) * kstep;
            const char* a2 = last ? nA : cA + (size_t)(t + 2) * kstep; const char* b2 = last ? nB : cB + (size_t)(t + 2) * kstep;
            const char* a3 = a2 + kstep; const char* b3 = b2 + kstep;
            if (last && has_next) S.a_ready(nxt);
            if constexpr (SP2) {
            PG8_LDB(B0, 0, 0); PG8_LDB(B1, 0, 1); PG8_SCHED; PG8_LDA(At, 0, 0); PG8_STAGE(PG8_SA(1, 1), a1 + hstep, voffA);
            PG8_WAIT_V(8); PG8_WAIT_L(0); PG8_BAR; PG8_MMA(0, 0, At, B0); PG8_MMA(0, 1, At, B1); PG8_BAR; PG8_SCHED;
            PG8_LDA(At, 0, 1); PG8_STAGE(PG8_SB(0, 0), b2, voffB); PG8_STAGE(PG8_SB(0, 1), b2 + hstep, voffB); PG8_STAGE(PG8_SA(0, 0), a2, voffA);
            PG8_WAIT_V(8); PG8_WAIT_L(0); PG8_BAR; PG8_MMA(1, 0, At, B0); PG8_MMA(1, 1, At, B1); PG8_BAR; PG8_SCHED;
            PG8_LDB(B0, 1, 0); PG8_LDB(B1, 1, 1); PG8_SCHED; PG8_LDA(At, 1, 0); PG8_STAGE(PG8_SA(0, 1), a2 + hstep, voffA);
            PG8_WAIT_V(8); PG8_WAIT_L(0); PG8_BAR; PG8_MMA(0, 0, At, B0); PG8_MMA(0, 1, At, B1); PG8_BAR; PG8_SCHED;
            PG8_LDA(At, 1, 1); PG8_STAGE(PG8_SB(1, 0), b3, voffB); PG8_STAGE(PG8_SB(1, 1), b3 + hstep, voffB); PG8_STAGE(PG8_SA(1, 0), a3, voffA);
            PG8_WAIT_V(8); PG8_WAIT_L(0); PG8_BAR; PG8_MMA(1, 0, At, B0); PG8_MMA(1, 1, At, B1); PG8_BAR; PG8_SCHED;
            } else {
            PG8_LDB(B0, 0, 0); PG8_SCHED; PG8_LDA(At, 0, 0); PG8_STAGE(PG8_SA(1, 1), a1 + hstep, voffA);
            PG8_WAIT_L(8); PG8_BAR; PG8_WAIT_L(0); PG8_MMA(0, 0, At, B0); PG8_BAR; PG8_SCHED;
            PG8_LDB(B1, 0, 1); PG8_STAGE(PG8_SB(0, 0), b2, voffB);
            PG8_BAR; PG8_WAIT_L(0); PG8_MMA(0, 1, At, B1); PG8_BAR;
            PG8_LDA(At, 0, 1); PG8_STAGE(PG8_SA(0, 0), a2, voffA);
            PG8_BAR; PG8_WAIT_L(0); PG8_MMA(1, 0, At, B0); PG8_BAR; PG8_SCHED;
            PG8_STAGE(PG8_SB(0, 1), b2 + hstep, voffB);
            PG8_WAIT_V(6); PG8_BAR; PG8_MMA(1, 1, At, B1); PG8_BAR;
            PG8_LDB(B0, 1, 0); PG8_SCHED; PG8_LDA(At, 1, 0); PG8_STAGE(PG8_SA(0, 1), a2 + hstep, voffA);
            PG8_WAIT_L(8); PG8_BAR; PG8_WAIT_L(0); PG8_MMA(0, 0, At, B0); PG8_BAR; PG8_SCHED;
            PG8_LDB(B1, 1, 1); PG8_STAGE(PG8_SB(1, 0), b3, voffB);
            PG8_BAR; PG8_WAIT_L(0); PG8_MMA(0, 1, At, B1); PG8_BAR;
            PG8_LDA(At, 1, 1); PG8_STAGE(PG8_SA(1, 0), a3, voffA);
            PG8_BAR; PG8_WAIT_L(0); PG8_MMA(1, 0, At, B0); PG8_BAR; PG8_SCHED;
            PG8_STAGE(PG8_SB(1, 1), b3 + hstep, voffB);
            PG8_WAIT_V(6); PG8_BAR; PG8_MMA(1, 1, At, B1); PG8_BAR;
            }
        }
        if constexpr (ALIGN_EPI) { if (wr == 0) PG8_BAR; }
        if constexpr (!Epi::AFTER_DRAIN) { E(acc, cur, wr, wc, fr, fq); S.done(cur); }
        if (!has_next) break;
#pragma unroll
        for (int a = 0; a < 2; ++a)
#pragma unroll
            for (int b = 0; b < 2; ++b)
#pragma unroll
                for (int m = 0; m < 4; ++m)
#pragma unroll
                    for (int n = 0; n < 2; ++n) acc[a][b][m][n] = (f32x4){0.f, 0.f, 0.f, 0.f};
        cur = nxt; cA = nA; cB = nB; ++ui;
        if constexpr (ALIGN_EPI) { if (wr == 1) PG8_BAR; }
    }
    PG8_WAIT_V(0);
    if constexpr (!ALIGN_EPI) { if (wr == 0) PG8_BAR; }
    PG8_BAR;
    if constexpr (Epi::AFTER_DRAIN) { E.fused(acc, cur, wr, wc, fr, fq, lds, wid, lane); S.done(cur); }
#undef PG8_SA
#undef PG8_SB
#undef PG8_STAGE
#undef PG8_LDA
#undef PG8_LDB
#undef PG8_MMA
#undef PG8_WAIT_V
#undef PG8_WAIT_L
#undef PG8_BAR
#undef PG8_SCHED
}
}

#define LAS __attribute__((address_space(3)))
#define DI __device__ __forceinline__
typedef unsigned short bf16;
typedef short bf16x8 __attribute__((ext_vector_type(8)));
typedef short s16x4 __attribute__((ext_vector_type(4)));
typedef float f32x4 __attribute__((ext_vector_type(4)));
typedef float f32x16 __attribute__((ext_vector_type(16)));
typedef unsigned u32x4 __attribute__((ext_vector_type(4)));
typedef unsigned u32x2 __attribute__((ext_vector_type(2)));
typedef __bf16 bf16x2_t __attribute__((ext_vector_type(2)));
typedef float f32x2_t __attribute__((ext_vector_type(2)));
#define GAS __attribute__((address_space(1)))
typedef GAS float gfloat; typedef GAS unsigned short gbf16; typedef GAS char gchar; typedef GAS unsigned char guchar;

#ifndef SINGLE_LAUNCH
#define SINGLE_LAUNCH 1
#endif

constexpr int D = 1024, NB = 8, SEQ = 2048, CTX = 256, TL = NB * SEQ, TC = NB * CTX, TA = TL + TC;
constexpr int DIN = 2304, DFF = 4096, URM = 1024;
constexpr int NPH = 18;
constexpr int LDS_BYTES = 147456;
constexpr size_t MiB = 1u << 20;
constexpr size_t WS_CTL = 0, WS_MODS = 1 * MiB;
constexpr size_t WS_WIN = 2 * MiB, WS_WOUT = WS_WIN + (size_t)DIN * D * 2, WS_W1 = WS_WOUT + 2 * MiB, WS_W2 = WS_W1 + 8 * MiB, WS_WPW = WS_W2 + 8 * MiB, WS_WF2 = WS_WPW + 128 * 1024;
constexpr size_t WS_DFTL = 25 * MiB, WS_DFTC = 41 * MiB, WS_HCTX = 42 * MiB, WS_HN = 50 * MiB, WS_OV = 86 * MiB;
constexpr size_t WS_URM = WS_OV, WS_UTL = WS_OV + 36 * MiB, WS_UTC = WS_UTL + 8 * MiB, WS_KT = WS_UTC + 1 * MiB, WS_VT = WS_KT + 18 * MiB,
                 WS_G12 = WS_VT + 18 * MiB, WS_CVA = WS_G12 + 18 * MiB, WS_MIX = WS_CVA + 9 * MiB, WS_HID = WS_OV, WS_END = WS_OV + 144 * MiB;
constexpr size_t WS_SIDE = WS_END;
static_assert(WS_SIDE + 24 * MiB <= 256 * MiB, "side buffers");
static_assert(WS_WF2 + 256 * 1024 <= WS_DFTL && WS_MIX + 36 * MiB == WS_END && WS_END <= 256 * MiB, "ws map");

struct Params { const float* in[21]; float* out; unsigned char* ws; int ph_lo, ph_hi; };
constexpr int LDSP_OFF = 131072;
struct PP {
    const __attribute__((address_space(3))) unsigned long long* P;
    __device__ __forceinline__ unsigned long long ld(int i) const { const unsigned long long v = P[i]; const unsigned lo = __builtin_amdgcn_readfirstlane((unsigned)v), hi = __builtin_amdgcn_readfirstlane((unsigned)(v >> 32)); return ((unsigned long long)hi << 32) | lo; }
    __device__ __forceinline__ const gfloat* in(int i) const { return (const gfloat*)ld(i); }
    __device__ __forceinline__ gfloat* out() const { return (gfloat*)ld(21); }
    __device__ __forceinline__ unsigned char* ws() const { return (unsigned char*)ld(22); }
};

DI unsigned pk2(float lo, float hi) { f32x2_t v = {lo, hi}; bf16x2_t b = __builtin_convertvector(v, bf16x2_t); return __builtin_bit_cast(unsigned, b); }
DI float bf2f(short x) { return __builtin_bit_cast(float, ((unsigned)(unsigned short)x) << 16); }
DI float wave_sum(float v) {
#pragma unroll
    for (int o = 1; o < 64; o <<= 1) v += __shfl_xor(v, o);
    return v;
}
#define LDS_WAIT() asm volatile("s_waitcnt lgkmcnt(0)" ::: "memory")

struct Sched {
    int nM, nN, nwg, G, c, pmadd, pmbase, ksplit, kbytes;
    DI void init(int nM_, int nN_, int G_, int c_) { nM = nM_; nN = nN_; nwg = nM_ * nN_; G = G_; c = c_; pmadd = 0; pmbase = 0; ksplit = 1; kbytes = 0; }
    DI bool next(int i, pg8::Unit& u) const {
        const long L = (long)i * G + c; if (L >= (long)nwg * ksplit) return false;
        int wgid = (int)L; u.ko = 0;
        if (ksplit > 1) { u.ko = (wgid % ksplit) * kbytes; wgid /= ksplit; }
        else { const int q = nwg / 8, r = nwg % 8, xcd = wgid % 8, off = wgid / 8; wgid = (xcd < r ? xcd * (q + 1) : r * (q + 1) + (xcd - r) * q) + off; }
        const int nig = 8 * nN, gid = wgid / nig, fm = gid * 8, gsz = (nM - fm) < 8 ? (nM - fm) : 8;
        u.pm = fm + ((wgid % nig) % gsz); u.pn = (wgid % nig) / gsz;
        if (u.pm > 0) u.pm += pmadd;
        u.pm += pmbase;
        return true;
    }
    DI void a_ready(const pg8::Unit&) const {}
    DI void done(const pg8::Unit&) const {}
};

template <int ACT> DI void store_tile_bf16(const pg8::f32x4 (&acc)[2][2][4][2], gbf16* base, int ld, const gfloat* bias, int wr, int wc, int fr, int fq) {
    const unsigned loff = (unsigned)((wr * 64 + fr) * ld + wc * 32 + 8 * fq) * 2u;
    f32x4 bv[2][2];
#pragma unroll
    for (int bj = 0; bj < 2; ++bj)
#pragma unroll
        for (int n = 0; n < 2; ++n) bv[bj][n] = bias ? *(const GAS f32x4*)(bias + wc * 32 + 8 * fq + bj * 128 + 4 * n) : (f32x4){0.f, 0.f, 0.f, 0.f};
#pragma unroll
    for (int ai = 0; ai < 2; ++ai)
#pragma unroll
        for (int m = 0; m < 4; ++m) { gchar* rowp = (gchar*)base + (size_t)((ai * 128 + m * 16) * ld) * 2u;
#pragma unroll
            for (int bj = 0; bj < 2; ++bj) { f32x4 a = acc[ai][bj][m][0] + bv[bj][0], b = acc[ai][bj][m][1] + bv[bj][1];
                if (ACT == 1) {
#pragma unroll
                    for (int e = 0; e < 4; ++e) { const float x = fmaxf(a[e], 0.f); a[e] = x * x; const float y = fmaxf(b[e], 0.f); b[e] = y * y; } }
                u32x4 w; w.x = pk2(a.x, a.y); w.y = pk2(a.z, a.w); w.z = pk2(b.x, b.y); w.w = pk2(b.z, b.w);
                *(GAS u32x4*)(rowp + bj * 256 + loff) = w; } }
}
DI void store_kfrag(const pg8::f32x4 (&acc)[2][2][4][2], gbf16* base, int wr, int wc, int fr, int fq) {
    const unsigned loff = (unsigned)(wr * 2 * 16384 + (wc >> 1) * 2048 + fq * 512 + (wc & 1) * 256 + fr * 8) * 2u;
#pragma unroll
    for (int ai = 0; ai < 2; ++ai)
#pragma unroll
        for (int m = 0; m < 4; ++m)
#pragma unroll
            for (int bj = 0; bj < 2; ++bj) { const f32x4 a = acc[ai][bj][m][0], b = acc[ai][bj][m][1];
                u32x4 w; w.x = pk2(a.x, a.y); w.y = pk2(a.z, a.w); w.z = pk2(b.x, b.y); w.w = pk2(b.z, b.w);
                *(GAS u32x4*)((gchar*)base + (size_t)((ai * 4 + (m >> 1)) * 16384 + bj * 2 * 2048 + (m & 1) * 128) * 2u + loff) = w; }
}
DI void store_vfrag(const pg8::f32x4 (&acc)[2][2][4][2], gbf16* base, int wr, int wc, int fr, int fq) {
    const unsigned loff = (unsigned)(wc * 8 * 2048 + wr * 2048 + (fq >> 1) * 512 + fr * 8 + (fq & 1) * 4) * 2u;
#pragma unroll
    for (int ai = 0; ai < 2; ++ai)
#pragma unroll
        for (int m = 0; m < 4; ++m)
#pragma unroll
            for (int bj = 0; bj < 2; ++bj) { const f32x4 a = acc[ai][bj][m][0], b = acc[ai][bj][m][1];
                gchar* q = (gchar*)base + (size_t)(bj * 32 * 2048 + ai * 2 * 2048 + (m >> 1) * 1024 + (m & 1) * 128) * 2u + loff;
                u32x2 w0; w0.x = pk2(a.x, a.y); w0.y = pk2(a.z, a.w); u32x2 w1; w1.x = pk2(b.x, b.y); w1.y = pk2(b.z, b.w);
                *(GAS u32x2*)q = w0; *(GAS u32x2*)(q + 512) = w1; }
}
enum { M_URM = 0, M_SWAP, M_DFTL, M_DFTC, M_MIXF, M_MIXC, M_RES1, M_RES2, M_HID, M_RES1K, M_RES2K };
struct UEpi {
    static constexpr bool PERM = true, AFTER_DRAIN = false;
    int mode, layer; PP p;
    DI void operator()(const pg8::f32x4 (&acc)[2][2][4][2], const pg8::Unit& u, int wr, int wc, int fr, int fq) const {
        unsigned char* ws = p.ws();
        if (mode == M_RES1K || mode == M_RES2K) {
            const int kc = u.ko / (mode == M_RES1K ? (D / 4) * 2 : (DFF / 4) * 2);
            const int r2 = u.pm * 256 - TL;
            const gfloat* srcb = (mode == M_RES1K && layer == 0) ? p.in(2) : (const gfloat*)(ws + WS_HCTX);
            const gchar* sp = (const gchar*)(srcb + (size_t)r2 * D + u.pn * 256);
            gchar* d = (gchar*)((gfloat*)(ws + (kc == 0 ? WS_HCTX : WS_SIDE + (size_t)(kc - 1) * 8 * MiB)) + (size_t)r2 * D + u.pn * 256);
            const gfloat* gp = (const gfloat*)(ws + WS_MODS) + (size_t)layer * 9 * 6144 + (mode == M_RES1K ? 2 : 5) * D + 8 * 6144 + u.pn * 256 + wc * 32 + 8 * fq;
            const unsigned loff = (unsigned)((wr * 64 + fr) * D + wc * 32 + 8 * fq) * 4u;
            f32x4 gv[2][2];
#pragma unroll
            for (int bj = 0; bj < 2; ++bj)
#pragma unroll
                for (int n = 0; n < 2; ++n) gv[bj][n] = *(const GAS f32x4*)(gp + bj * 128 + 4 * n);
#pragma unroll
            for (int ai = 0; ai < 2; ++ai)
#pragma unroll
                for (int m = 0; m < 4; ++m) { const size_t ro = (size_t)((ai * 128 + m * 16) * D) * 4u;
#pragma unroll
                    for (int bj = 0; bj < 2; ++bj) {
                        f32x4 x0 = (f32x4){0.f, 0.f, 0.f, 0.f}, x1 = x0;
                        if (kc == 0) { x0 = *(const GAS f32x4*)(sp + ro + bj * 512 + loff); x1 = *(const GAS f32x4*)(sp + ro + bj * 512 + 16 + loff); }
                        *(GAS f32x4*)(d + ro + bj * 512 + loff) = x0 + gv[bj][0] * acc[ai][bj][m][0];
                        *(GAS f32x4*)(d + ro + bj * 512 + 16 + loff) = x1 + gv[bj][1] * acc[ai][bj][m][1]; } }
            return;
        }
        if (mode == M_RES1 || mode == M_RES2) {
            const bool first = (mode == M_RES1 && layer == 0);
            const int row0 = u.pm * 256; const bool lat = row0 < TL; const int r2 = lat ? row0 : row0 - TL, midx = lat ? (row0 >> 11) : 8;
            const gfloat* srcb = lat ? (first ? p.in(0) : (const gfloat*)p.out()) : (first ? p.in(2) : (const gfloat*)(ws + WS_HCTX));
            gfloat* dstb = lat ? p.out() : (gfloat*)(ws + WS_HCTX);
            const gchar* s = (const gchar*)(srcb + (size_t)r2 * D + u.pn * 256);
            gchar* d = (gchar*)(dstb + (size_t)r2 * D + u.pn * 256);
            const gfloat* gp = (const gfloat*)(ws + WS_MODS) + (size_t)layer * 9 * 6144 + (mode == M_RES1 ? 2 : 5) * D + midx * 6144 + u.pn * 256 + wc * 32 + 8 * fq;
            const unsigned loff = (unsigned)((wr * 64 + fr) * D + wc * 32 + 8 * fq) * 4u;
            f32x4 gv[2][2];
#pragma unroll
            for (int bj = 0; bj < 2; ++bj)
#pragma unroll
                for (int n = 0; n < 2; ++n) gv[bj][n] = *(const GAS f32x4*)(gp + bj * 128 + 4 * n);
#pragma unroll
            for (int ai = 0; ai < 2; ++ai)
#pragma unroll
                for (int m = 0; m < 4; ++m) { const size_t ro = (size_t)((ai * 128 + m * 16) * D) * 4u;
#pragma unroll
                    for (int bj = 0; bj < 2; ++bj) {
                        const f32x4 x0 = *(const GAS f32x4*)(s + ro + bj * 512 + loff), x1 = *(const GAS f32x4*)(s + ro + bj * 512 + 16 + loff);
                        *(GAS f32x4*)(d + ro + bj * 512 + loff) = x0 + gv[bj][0] * acc[ai][bj][m][0];
                        *(GAS f32x4*)(d + ro + bj * 512 + 16 + loff) = x1 + gv[bj][1] * acc[ai][bj][m][1]; } }
            return;
        }
        gbf16* base; int ld; const gfloat* bias = nullptr;
        if (mode == M_URM) {
            if (u.pn >= 4) { store_kfrag(acc, (gbf16*)(ws + WS_KT) + (size_t)(u.pm * 64 + (u.pn - 4) * 4) * 2048, wr, wc, fr, fq); return; }
            ld = URM; base = (gbf16*)(ws + WS_URM) + (size_t)(u.pm * 256) * URM + u.pn * 256; }
        else if (mode == M_HID) { ld = DFF; base = (gbf16*)(ws + WS_HID) + (size_t)(u.pm * 256) * DFF + u.pn * 256; }
        else if (mode == M_SWAP) {
            if (u.pm != 0) { store_vfrag(acc, (gbf16*)(ws + WS_VT) + (size_t)(u.pn * 64 + (u.pm - 7) * 4) * 2048, wr, wc, fr, fq); return; }
            const int tok0 = u.pn * 256; const bool lat = tok0 < TL;
            const int bb = lat ? (tok0 >> 11) : ((tok0 - TL) >> 8), l0 = lat ? (tok0 & (SEQ - 1)) : 0; ld = lat ? SEQ : CTX;
            base = (gbf16*)(ws + (lat ? WS_UTL : WS_UTC)) + (size_t)(bb * 256) * ld + l0;
        } else if (mode == M_DFTL || mode == M_DFTC) {
            const int L = mode == M_DFTL ? SEQ : CTX, lshift = mode == M_DFTL ? 11 : 8, rowbase = mode == M_DFTL ? 0 : TL;
            const int row0 = u.pm * 256, cs = row0 >> lshift, lp0 = row0 & (L - 1);
            ld = 512; base = (gbf16*)(ws + WS_G12) + (size_t)(rowbase + u.pn * L + lp0) * 512 + cs * 256;
        } else {
            ld = D; base = (gbf16*)(ws + WS_MIX) + (size_t)(u.pm * 256) * D + (mode == M_MIXC ? 256 : 0);
            if (mode == M_MIXC) bias = p.in(15) + layer * 256;
        }
        if (mode == M_HID) store_tile_bf16<1>(acc, base, ld, nullptr, wr, wc, fr, fq);
        else store_tile_bf16<0>(acc, base, ld, bias, wr, wc, fr, fq);
    }
};
DI void run_gemm(LAS unsigned char* lds, const gbf16* A, const gbf16* Bt, int K, int Kext, const Sched& S, int mode, int layer, PP p, const int tid) {
    pg8::Gemm g{(const bf16*)A, (const bf16*)Bt, Kext, 0, K}; UEpi e{mode, layer, p};
    pg8::gemm_phase<UEpi, Sched, true, true>(lds, g, S, e, tid);
}
#define XB_TMO      128
#define XB_XCNT(j)  (256  + 64 * (j))
#define XB_XSUB(j)  (1280 + 64 * (j))
#define XB_XGEN(j)  (2304 + 64 * (j))
#define XB_TOP      3328
#define XB_TOPGEN   3392
#define XCD_BAR_WORDS 3456
#define XB_SPIN_CAP (1u << 18)

__device__ __forceinline__ unsigned xb_ld(unsigned* p)              { return __hip_atomic_load(p, __ATOMIC_RELAXED, __HIP_MEMORY_SCOPE_AGENT); }
__device__ __forceinline__ unsigned xb_add(unsigned* p, unsigned v) { return __hip_atomic_fetch_add(p, v, __ATOMIC_RELAXED, __HIP_MEMORY_SCOPE_AGENT); }
__device__ __forceinline__ unsigned xb_xcc_id() { return (unsigned)__builtin_amdgcn_s_getreg((3 << 11) | 20) & 0xFu; }
#define XB_SPIN(cond, bar) do { unsigned _sp = 0; while (cond) { __builtin_amdgcn_s_sleep(1); \
    if ((++_sp & 255u) == 0u) { if (xb_ld(&(bar)[XB_TMO])) break; if (_sp > XB_SPIN_CAP) { atomicAdd(&(bar)[XB_TMO], 1u); break; } } } } while (0)

struct XcdBarrier {
    unsigned* bar; unsigned x;
    volatile LAS unsigned* st;
};

__device__ __forceinline__ XcdBarrier xcd_barrier_post(unsigned* bar, volatile LAS unsigned* st) {
    XcdBarrier b; b.bar = bar; b.x = xb_xcc_id(); b.st = st;
    if (threadIdx.x == 0) (void)xb_add(&bar[XB_XCNT(b.x)], 1u);
    return b;
}
__device__ __forceinline__ void xcd_barrier_complete(unsigned* bar, unsigned x, unsigned& nloc, unsigned& nx) {
    const unsigned G = gridDim.x * gridDim.y * gridDim.z;
    unsigned sum, cnt, mine, sp = 0u;
    for (;;) {
        sum = 0u; cnt = 0u; mine = 0u;
#pragma unroll
        for (unsigned j = 0; j < 16; ++j) { const unsigned c = xb_ld(&bar[XB_XCNT(j)]); sum += c; cnt += (c > 0u) ? 1u : 0u; mine = (j == x) ? c : mine; }
        if (sum == G) break;
        __builtin_amdgcn_s_sleep(1);
        if ((++sp & 255u) == 0u) { if (xb_ld(&bar[XB_TMO])) break; if (sp > XB_SPIN_CAP) { atomicAdd(&bar[XB_TMO], 1u); break; } }
    }
    nloc = mine > 0u ? mine : 1u; nx = cnt > 0u ? cnt : 1u;
}

__device__ __forceinline__ void xcd_barrier(const XcdBarrier& b) {
    asm volatile("s_waitcnt vmcnt(0)" ::: "memory");
    __syncthreads();
    if (threadIdx.x == 0) {
        unsigned* bar = b.bar;
        __builtin_amdgcn_s_waitcnt(0);
        unsigned nloc = b.st[0], nx = b.st[1];
        if (nloc == 0u) { xcd_barrier_complete(bar, b.x, nloc, nx); b.st[0] = nloc; b.st[1] = nx; }
        const unsigned old = xb_add(&bar[XB_XSUB(b.x)], 1u);
        const unsigned gen = old / nloc;
        if (old + 1u == (gen + 1u) * nloc) {
            __builtin_amdgcn_fence(__ATOMIC_RELEASE, "agent");
            asm volatile("s_waitcnt vmcnt(0)" ::: "memory");
            const unsigned og = xb_add(&bar[XB_TOP], 1u);
            const unsigned tg = og / nx;
            if (og + 1u == (tg + 1u) * nx) xb_add(&bar[XB_TOPGEN], 1u);
            else XB_SPIN(xb_ld(&bar[XB_TOPGEN]) == tg, bar);
            __builtin_amdgcn_fence(__ATOMIC_ACQUIRE, "agent");
            xb_add(&bar[XB_XGEN(b.x)], 1u);
            asm volatile("s_waitcnt vmcnt(0)" ::: "memory");
        } else {
            XB_SPIN(xb_ld(&bar[XB_XGEN(b.x)]) == gen, bar);
            __builtin_amdgcn_fence(__ATOMIC_ACQUIRE, "agent");
            asm volatile("s_waitcnt vmcnt(0)" ::: "memory");
        }
    }
    __syncthreads();
}

DI void phase_mods(const PP p, LAS unsigned char* lds, const int tid_, const int bid_) {
    const int tid = tid_, lane = tid & 63, wave = tid >> 6;
    LAS float* s = (LAS float*)lds;
    LAS float* red = (LAS float*)(lds + 36864);
    gfloat* mods = (gfloat*)(p.ws() + WS_MODS);
    for (int i = tid; i < 9 * 1024; i += 512) { const int j = i >> 10, k = i & 1023; const float v = j < 8 ? p.in(1)[j * 1024 + k] : p.in(3)[k]; s[i] = v / (1.f + expf(-v)); }
    __syncthreads();
    for (int item = bid_; item < 192; item += gridDim.x) {
        const int layer = item / 96, cgp = item % 96, col = cgp * 64 + lane;
        const gfloat* W = p.in(4) + (size_t)layer * 1024 * 6144 + col;
        float acc[9];
#pragma unroll
        for (int j = 0; j < 9; ++j) acc[j] = 0.f;
        const int k0 = wave * 128;
#pragma unroll 8
        for (int k = k0; k < k0 + 128; ++k) { const float w = W[(size_t)k * 6144];
#pragma unroll
            for (int j = 0; j < 9; ++j) acc[j] += s[j * 1024 + k] * w; }
#pragma unroll
        for (int j = 0; j < 9; ++j) red[(wave * 9 + j) * 64 + lane] = acc[j];
        __syncthreads();
        for (int t = tid; t < 576; t += 512) { const int j = t >> 6, l = t & 63; float v = p.in(5)[layer * 6144 + cgp * 64 + l];
#pragma unroll
            for (int w = 0; w < 8; ++w) v += red[(w * 9 + j) * 64 + l];
            mods[(size_t)(layer * 9 + j) * 6144 + cgp * 64 + l] = v; }
        __syncthreads();
    }
}
DI void make_tables(const PP p, const int tid_, const int bid_) {
    gbf16* DL = (gbf16*)(p.ws() + WS_DFTL); gbf16* DC = (gbf16*)(p.ws() + WS_DFTC);
    const int gt = bid_ * 512 + tid_, NT = gridDim.x * 512;
    for (int i = gt; i < 4096 * 256; i += NT) { const int row = i >> 8, l0 = (i & 255) * 8, cs = row >> 11, lp = row & 2047;
        float v[8];
#pragma unroll
        for (int e = 0; e < 8; ++e) { const int ph = (lp * (l0 + e)) & 2047; const float x = (float)ph * (1.f / 1024.f); v[e] = (cs ? sinpif(x) : cospif(x)) * 0.022097086912079608f; }
        u32x4 w; w.x = pk2(v[0], v[1]); w.y = pk2(v[2], v[3]); w.z = pk2(v[4], v[5]); w.w = pk2(v[6], v[7]);
        *(GAS u32x4*)(DL + (size_t)row * 2048 + l0) = w; }
    for (int i = gt; i < 512 * 32; i += NT) { const int row = i >> 5, l0 = (i & 31) * 8, cs = row >> 8, lp = row & 255;
        float v[8];
#pragma unroll
        for (int e = 0; e < 8; ++e) { const int ph = (lp * (l0 + e)) & 255; const float x = (float)ph * (1.f / 128.f); v[e] = (cs ? sinpif(x) : cospif(x)) * 0.0625f; }
        u32x4 w; w.x = pk2(v[0], v[1]); w.y = pk2(v[2], v[3]); w.z = pk2(v[4], v[5]); w.w = pk2(v[6], v[7]);
        *(GAS u32x4*)(DC + (size_t)row * 256 + l0) = w; }
}
DI void transpose_item(const gfloat* W, int K, int N, gbf16* WT, LAS float* scr, int item, int lane) {
    const int nblk = N / 32, kb = item / nblk, nb = item % nblk, k0 = 64 * kb, n0 = 32 * nb;
#pragma unroll 8
    for (int i = 0; i < 32; ++i) { const int kk = 2 * i + (lane >> 5); scr[kk * 33 + (lane & 31)] = W[(size_t)(k0 + kk) * N + n0 + (lane & 31)]; }
    LDS_WAIT(); asm volatile("" ::: "memory");
    const int c = lane & 7;
#pragma unroll
    for (int j = 0; j < 4; ++j) { const int n = (lane >> 3) + 8 * j; const LAS float* sp = scr + (8 * c) * 33 + n;
        u32x4 o; o.x = pk2(sp[0 * 33], sp[1 * 33]); o.y = pk2(sp[2 * 33], sp[3 * 33]); o.z = pk2(sp[4 * 33], sp[5 * 33]); o.w = pk2(sp[6 * 33], sp[7 * 33]);
        *(GAS u32x4*)(WT + (size_t)(n0 + n) * K + k0 + 8 * c) = o; }
    LDS_WAIT(); asm volatile("" ::: "memory");
}
DI void conv_weights(const PP p, int layer, LAS unsigned char* lds, const int tid_, const int bid_) {
    const int lane = tid_ & 63, wave = tid_ >> 6;
    LAS float* scr = (LAS float*)(lds + 57344 + wave * 8448);
    const int gw = bid_ * 8 + wave, NGW = gridDim.x * 8;
    const gfloat* Win = p.in(8) + (size_t)layer * D * DIN; const gfloat* Wout = p.in(17) + (size_t)layer * D * D;
    const gfloat* W1 = p.in(18) + (size_t)layer * D * DFF; const gfloat* W2 = p.in(19) + (size_t)layer * DFF * D; const gfloat* Wpw = p.in(14) + (size_t)layer * 256 * 256;
    gbf16* WinT = (gbf16*)(p.ws() + WS_WIN); gbf16* WoutT = (gbf16*)(p.ws() + WS_WOUT); gbf16* W1T = (gbf16*)(p.ws() + WS_W1); gbf16* W2T = (gbf16*)(p.ws() + WS_W2); gbf16* WpwT = (gbf16*)(p.ws() + WS_WPW);
    constexpr int I_IN = 16 * 72, I_OUT = 16 * 32, I_1 = 16 * 128, I_2 = 64 * 32, I_PW = 4 * 8, NIT = I_IN + I_OUT + I_1 + I_2 + I_PW;
    for (int it = gw; it < NIT; it += NGW) {
        int r = it;
        if (r < I_IN) { transpose_item(Win, D, DIN, WinT, scr, r, lane); continue; } r -= I_IN;
        if (r < I_OUT) { transpose_item(Wout, D, D, WoutT, scr, r, lane); continue; } r -= I_OUT;
        if (r < I_1) { transpose_item(W1, D, DFF, W1T, scr, r, lane); continue; } r -= I_1;
        if (r < I_2) { transpose_item(W2, DFF, D, W2T, scr, r, lane); continue; } r -= I_2;
        transpose_item(Wpw, 256, 256, WpwT, scr, r, lane);
    }
    const gfloat* Wf = p.in(9) + (size_t)layer * 256 * 256; gbf16* Wf2t = (gbf16*)(p.ws() + WS_WF2);
    for (int o = bid_ * 512 + tid_; o < 256 * 512; o += gridDim.x * 512) {
        const int n = o >> 9, k = o & 511, cs = k >> 8, g = (k >> 6) & 3, j = k & 63;
        float acc = 0.f;
        for (int jp = 0; jp < 64; ++jp) { const float x = (float)((j * jp) & 63) * (1.f / 32.f); const float t = cs ? sinpif(x) : cospif(x); acc += t * Wf[(size_t)(g * 64 + jp) * 256 + n]; }
        acc *= cs ? -0.125f : 0.125f;
        Wf2t[(size_t)n * 512 + k] = (bf16)(pk2(acc, 0.f) & 0xffffu);
    }
}
DI void phase_norm(const PP p, int layer, int which, int nrows, const int tid_, const int bid_) {
    const int lane = tid_ & 63, wave = tid_ >> 6;
    const int gw = bid_ * 8 + wave, NGW = gridDim.x * 8;
    const bool first = (layer == 0 && which == 0);
    const gfloat* hl = first ? p.in(0) : p.out(); const gfloat* hc = first ? p.in(2) : (const gfloat*)(p.ws() + WS_HCTX);
    const gfloat* g = p.in(which ? 7 : 6) + layer * D;
    const gfloat* mods = (const gfloat*)(p.ws() + WS_MODS) + (size_t)layer * 9 * 6144 + (which ? 3 : 0) * D;
    gbf16* hn = (gbf16*)(p.ws() + WS_HN);
    for (int row = gw; row < nrows; row += NGW) {
        const gfloat* src = row < TL ? hl + (size_t)row * D : hc + (size_t)(row - TL) * D;
        const int midx = row < TL ? (row >> 11) : 8;
        f32x4 v[4]; float ss = 0.f;
#pragma unroll
        for (int jj = 0; jj < 4; ++jj) v[jj] = *(const GAS f32x4*)(src + 4 * (lane + 64 * jj));
        if (!first && row >= TL) {
            const gfloat* sd = (const gfloat*)(p.ws() + WS_SIDE) + (size_t)(row - TL) * D; gfloat* hw = (gfloat*)(p.ws() + WS_HCTX) + (size_t)(row - TL) * D;
#pragma unroll
            for (int jj = 0; jj < 4; ++jj) { const int k = 4 * (lane + 64 * jj);
                v[jj] += (*(const GAS f32x4*)(sd + k) + *(const GAS f32x4*)(sd + 2 * 1024 * 1024 + k)) + *(const GAS f32x4*)(sd + 4 * 1024 * 1024 + k);
                *(GAS f32x4*)(hw + k) = v[jj]; } }
#pragma unroll
        for (int jj = 0; jj < 4; ++jj) ss += (v[jj].x * v[jj].x + v[jj].y * v[jj].y) + (v[jj].z * v[jj].z + v[jj].w * v[jj].w);
        const float rinv = 1.f / sqrtf(wave_sum(ss) * (1.f / D) + 1e-6f);
#pragma unroll
        for (int jj = 0; jj < 4; ++jj) { const int k = 4 * (lane + 64 * jj);
            const f32x4 gg = *(const GAS f32x4*)(g + k), sh = *(const GAS f32x4*)(mods + midx * 6144 + k), sc = *(const GAS f32x4*)(mods + midx * 6144 + D + k);
            const f32x4 y = (v[jj] * rinv * gg) * (sc + 1.f) + sh;
            u32x2 w; w.x = pk2(y.x, y.y); w.y = pk2(y.z, y.w);
            *(GAS u32x2*)(hn + (size_t)row * D + k) = w; }
    }
}
DI void phase_final(const PP p, const int tid_, const int bid_) {
    const int lane = tid_ & 63, wave = tid_ >> 6;
    const int gw = bid_ * 8 + wave, NGW = gridDim.x * 8;
    const gfloat* g = p.in(20);
    for (int row = gw; row < TL; row += NGW) {
        gfloat* src = p.out() + (size_t)row * D;
        f32x4 v[4]; float ss = 0.f;
#pragma unroll
        for (int jj = 0; jj < 4; ++jj) { v[jj] = *(const GAS f32x4*)(src + 4 * (lane + 64 * jj)); ss += (v[jj].x * v[jj].x + v[jj].y * v[jj].y) + (v[jj].z * v[jj].z + v[jj].w * v[jj].w); }
        const float rinv = 1.f / sqrtf(wave_sum(ss) * (1.f / D) + 1e-6f);
#pragma unroll
        for (int jj = 0; jj < 4; ++jj) { const int k = 4 * (lane + 64 * jj); const f32x4 gg = *(const GAS f32x4*)(g + k); *(GAS f32x4*)(src + k) = v[jj] * rinv * gg; }
    }
}
DI void conv_tile(const PP p, int layer, int seqbase, int L, int t0, LAS unsigned char* lds, const int tid_, const int bid_) {
    int tid = tid_; asm volatile("" : "+v"(tid));
    const int lane = tid & 63;
    LAS float* vt = (LAS float*)lds;
    LAS float* red1 = (LAS float*)(lds + 98304);
    LAS float* red2 = (LAS float*)(lds + 98304 + 1024);
    const gbf16* Urm = (const gbf16*)(p.ws() + WS_URM);
    gbf16* cva = (gbf16*)(p.ws() + WS_CVA);
    __syncthreads();
    for (int idx = tid; idx < 94 * 32; idx += 512) { const int tt = idx >> 5, c8 = (idx & 31) * 8, pos = t0 - 15 + tt;
        float v[8];
        if (pos >= 0 && pos < L) { const gbf16* rp = Urm + (size_t)(seqbase + pos) * URM + c8; const bf16x8 a8 = *(const GAS bf16x8*)rp, g8 = *(const GAS bf16x8*)(rp + 256);
#pragma unroll
            for (int e = 0; e < 8; ++e) { const float a = bf2f(a8[e]), gt = bf2f(g8[e]); v[e] = a / (1.f + __expf(-gt)); } }
        else {
#pragma unroll
            for (int e = 0; e < 8; ++e) v[e] = 0.f; }
        *(LAS f32x4*)(vt + tt * 256 + c8) = (f32x4){v[0], v[1], v[2], v[3]}; *(LAS f32x4*)(vt + tt * 256 + c8 + 4) = (f32x4){v[4], v[5], v[6], v[7]}; }
    __syncthreads();
    const int c = tid & 255, th = tid >> 8, wq = (tid >> 6) & 3;
    const gfloat* dw = p.in(10) + (size_t)layer * 31 * 256 + c;
    float w[31];
#pragma unroll
    for (int tap = 0; tap < 31; ++tap) w[tap] = dw[tap * 256];
    const float bias = p.in(11)[layer * 256 + c], lg = p.in(12)[layer * 256 + c], lb = p.in(13)[layer * 256 + c];
    for (int ch = 0; ch < 4; ++ch) {
        const int tb = th * 32 + ch * 8;
        float o[8];
#pragma unroll
        for (int e = 0; e < 8; ++e) { float acc = bias;
#pragma unroll
            for (int tap = 0; tap < 31; ++tap) acc += w[tap] * vt[(tb + e + tap) * 256 + c];
            o[e] = acc; }
#pragma unroll
        for (int e = 0; e < 8; ++e) { const float s1 = wave_sum(o[e]); if (lane == 0) red1[(tb + e) * 4 + wq] = s1; }
        __syncthreads();
#pragma unroll
        for (int e = 0; e < 8; ++e) { const LAS float* r = red1 + (tb + e) * 4; const float mean = ((r[0] + r[1]) + (r[2] + r[3])) * (1.f / 256.f); o[e] -= mean;
            const float s2 = wave_sum(o[e] * o[e]); if (lane == 0) red2[(tb + e) * 4 + wq] = s2; }
        __syncthreads();
#pragma unroll
        for (int e = 0; e < 8; ++e) { const LAS float* r = red2 + (tb + e) * 4; const float var = ((r[0] + r[1]) + (r[2] + r[3])) * (1.f / 256.f);
            const float y = o[e] / sqrtf(var + 1e-5f) * lg + lb; const float z = y / (1.f + __expf(-y));
            cva[(size_t)(seqbase + t0 + tb + e) * 256 + c] = (bf16)(pk2(z, 0.f) & 0xffffu); }
    }
}
#define MFMA32(a, b, c) __builtin_amdgcn_mfma_f32_32x32x16_bf16((a), (b), (c), 0, 0, 0)
DI void attn_load(const gchar* KtB, const gchar* VtB, int tile, int b, int h, int rs, int lane, bf16x8 (&kf)[4], bf16x8 (&vf)[2][2]) {
    const int tileg = tile >= 8 ? (b * 64 + rs * 2 + (tile - 8)) : (TL / 32 + b * 8 + tile);
    const unsigned off = (unsigned)((tileg * 8 + h) * 2048 + lane * 8) * 2u;
#pragma unroll
    for (int ks = 0; ks < 4; ++ks) kf[ks] = *(const GAS bf16x8*)(KtB + off + ks * 1024);
#pragma unroll
    for (int dt = 0; dt < 2; ++dt)
#pragma unroll
        for (int t = 0; t < 2; ++t) vf[dt][t] = *(const GAS bf16x8*)(VtB + off + (dt * 2 + t) * 1024);
}
template <bool LOCAL> DI void attn_compute(const bf16x8 (&kf)[4], const bf16x8 (&vf)[2][2], const LAS bf16x8* ql_, f32x16 (&o)[2][2], float (&m)[2], float (&ls)[2],
                                           const LAS float* bl, int lt, int ql, int half) {
    const float SCL = 0.125f * 1.4426950408889634f, NINF = -__builtin_inff();
#pragma unroll
    for (int qt = 0; qt < 2; ++qt) {
        f32x16 sv;
#pragma unroll
        for (int v = 0; v < 16; ++v) sv[v] = 0.f;
#pragma unroll
        for (int ks = 0; ks < 4; ++ks) sv = MFMA32(kf[ks], ql_[(qt * 4 + ks) * 64], sv);
        float mx = NINF;
        if (LOCAL) {
            const int qc = qt * 32 + ql, cs = min(max(qc - 8, 0), 48);
            const int kc0 = (lt & 1) * 32 + 4 * half;
            const int d0 = kc0 - cs, b0 = (lt >> 1) * 31 + kc0 - qc + 15;
            float bias[16];
#pragma unroll
            for (int v = 0; v < 16; ++v) { const int dv = (v & 3) + 8 * (v >> 2); const int bi = min(max(b0 + dv, 0), 247); bias[v] = ((const volatile LAS float*)bl)[bi]; }
#pragma unroll
            for (int v = 0; v < 16; ++v) { const int dv = (v & 3) + 8 * (v >> 2); const bool valid = (unsigned)(d0 + dv) < 16u;
                const float x = valid ? sv[v] * SCL + bias[v] : NINF; sv[v] = x; mx = fmaxf(mx, x); }
        } else {
#pragma unroll
            for (int v = 0; v < 16; ++v) { const float x = sv[v] * SCL; sv[v] = x; mx = fmaxf(mx, x); }
        }
        mx = fmaxf(mx, __shfl_xor(mx, 32));
        const float mn = fmaxf(m[qt], mx), alpha = __builtin_amdgcn_exp2f(m[qt] - mn); m[qt] = mn;
        float sum = 0.f;
#pragma unroll
        for (int v = 0; v < 16; ++v) { const float pv = __builtin_amdgcn_exp2f(sv[v] - mn); sv[v] = pv; sum += pv; }
        ls[qt] = ls[qt] * alpha + sum;
#pragma unroll
        for (int dt = 0; dt < 2; ++dt)
#pragma unroll
            for (int v = 0; v < 16; ++v) o[dt][qt][v] *= alpha;
#pragma unroll
        for (int t = 0; t < 2; ++t) { u32x4 pw; pw.x = pk2(sv[8 * t + 0], sv[8 * t + 1]); pw.y = pk2(sv[8 * t + 2], sv[8 * t + 3]); pw.z = pk2(sv[8 * t + 4], sv[8 * t + 5]); pw.w = pk2(sv[8 * t + 6], sv[8 * t + 7]);
            const bf16x8 pf = __builtin_bit_cast(bf16x8, pw);
#pragma unroll
            for (int dt = 0; dt < 2; ++dt) o[dt][qt] = MFMA32(vf[dt][t], pf, o[dt][qt]); }
    }
}
DI void attn_item(const PP p, int layer, int b, int qbase, int nloc, int r, LAS unsigned char* lds, const int tid_, const int bid_) {
    int tid = tid_; asm volatile("" : "+v"(tid));
    const int lane = tid & 63, h = __builtin_amdgcn_readfirstlane(tid >> 6), ql = lane & 31, half = lane >> 5;
    const gchar* UrmB = (const gchar*)(p.ws() + WS_URM); const gchar* KtB = (const gchar*)(p.ws() + WS_KT); const gchar* VtB = (const gchar*)(p.ws() + WS_VT);
    LAS float* bl = (LAS float*)(lds + h * 9216);
    LAS bf16x8* qlds = (LAS bf16x8*)(lds + h * 9216 + 1024) + lane;
    const int rs = min(max(r - 4, 0), 24);
    const float LOG2E = 1.4426950408889634f, NINF = -__builtin_inff();
    __syncthreads();
    if (nloc) { const gfloat* rp = p.in(16) + (size_t)(layer * 8 + h) * 465;
        for (int i = lane; i < 248; i += 64) { const int kr = i / 31, co = i - kr * 31; bl[i] = rp[(rs - r + 7 + kr) * 31 + co] * LOG2E; } }
    __syncthreads();
#pragma unroll
    for (int qt = 0; qt < 2; ++qt) { const unsigned qoff = (unsigned)((qbase + qt * 32 + ql) * URM + 512 + h * 64 + 32 * half) * 2u;
#pragma unroll
        for (int ks = 0; ks < 4; ++ks) qlds[(qt * 4 + ks) * 64] = *(const GAS bf16x8*)(UrmB + qoff + 16 * ks); }
    f32x16 o[2][2];
#pragma unroll
    for (int a = 0; a < 2; ++a)
#pragma unroll
        for (int c = 0; c < 2; ++c)
#pragma unroll
            for (int v = 0; v < 16; ++v) o[a][c][v] = 0.f;
    float m[2] = {NINF, NINF}, ls[2] = {0.f, 0.f};
    const int ntiles = 8 + nloc;
    bf16x8 kf[4], vf[2][2], kn[4], vn[2][2];
    attn_load(KtB, VtB, 0, b, h, rs, lane, kf, vf);
#pragma unroll 1
    for (int tile = 0; tile < ntiles; ++tile) {
        asm volatile("" ::: "memory");
        const int tn = tile + 1 < ntiles ? tile + 1 : tile;
        attn_load(KtB, VtB, tn, b, h, rs, lane, kn, vn);
        if (tile < 8) attn_compute<false>(kf, vf, qlds, o, m, ls, bl, 0, ql, half);
        else attn_compute<true>(kf, vf, qlds, o, m, ls, bl, tile - 8, ql, half);
#pragma unroll
        for (int ks = 0; ks < 4; ++ks) kf[ks] = kn[ks];
#pragma unroll
        for (int dt = 0; dt < 2; ++dt)
#pragma unroll
            for (int t = 0; t < 2; ++t) vf[dt][t] = vn[dt][t];
    }
    int tid2 = tid_; asm volatile("" : "+v"(tid2));
    const int ql2 = tid2 & 31, half2 = (tid2 >> 5) & 1; gbf16* mixo = (gbf16*)(p.ws() + WS_MIX);
#pragma unroll
    for (int qt = 0; qt < 2; ++qt) { const float lt_ = ls[qt] + __shfl_xor(ls[qt], 32); const float inv = 1.f / lt_; const int token = qbase + qt * 32 + ql2;
#pragma unroll
        for (int dt = 0; dt < 2; ++dt)
#pragma unroll
            for (int i = 0; i < 4; ++i) { const int d = dt * 32 + 8 * i + 4 * half2; u32x2 w; w.x = pk2(o[dt][qt][4 * i] * inv, o[dt][qt][4 * i + 1] * inv); w.y = pk2(o[dt][qt][4 * i + 2] * inv, o[dt][qt][4 * i + 3] * inv);
                *(GAS u32x2*)((gchar*)mixo + (unsigned)(token * D + 512 + h * 64 + d) * 2u) = w; } }
}
DI void run_phase(const PP p, int ph, LAS unsigned char* lds, const int tid, const int c, const int skip = 0) {
    const int G = gridDim.x;
    if (ph == 0) { phase_mods(p, lds, tid, c); make_tables(p, tid, c); conv_weights(p, 0, lds, tid, c); return; }
    if (ph == NPH - 1) { phase_final(p, tid, c); return; }
    const int layer = (ph - 1) >> 3, sub = (ph - 1) & 7;
    const int M = layer == 0 ? TA : TL;
    if (sub == 0) { if (layer == 1) conv_weights(p, 1, lds, tid, c); phase_norm(p, layer, 0, TA, tid, c); return; }
    if (sub == 5) { phase_norm(p, layer, 1, M, tid, c); return; }
    const int H = G / 2 > 0 ? G / 2 : 1;
#pragma unroll 1
    for (int j = 0; j < 2; ++j) {
        unsigned char* ws = p.ws();
        const gbf16* A = nullptr; const gbf16* Bt = nullptr; int K = 0, nM = 0, nN = 0, cc = c, pmadd = 0, mode = 0, pmbase = 0, ksplit = 1; bool valid = true;
        if (sub == 1) {
            if (j == 0) { A = (const gbf16*)(ws + WS_HN); Bt = (const gbf16*)(ws + WS_WIN) + (size_t)256 * D; K = D; nM = TA / 256; nN = 6; mode = M_URM; }
            else { A = (const gbf16*)(ws + WS_WIN); Bt = (const gbf16*)(ws + WS_HN); K = D; nM = 3; nN = TA / 256; cc = (c + (G - (432 % G))) % G; pmadd = 6; mode = M_SWAP; }
        } else if (sub == 2) {
            if (j == 0) { A = (const gbf16*)(ws + WS_DFTL); Bt = (const gbf16*)(ws + WS_UTL); K = SEQ; nM = 16; nN = 8; mode = M_DFTL; }
            else { A = (const gbf16*)(ws + WS_DFTC); Bt = (const gbf16*)(ws + WS_UTC); K = CTX; nM = 2; nN = 8; cc = (c + H) % G; mode = M_DFTC; valid = (layer == 0); }
        } else if (sub == 3) {
            if (j == 0) { A = (const gbf16*)(ws + WS_G12); Bt = (const gbf16*)(ws + WS_WF2); K = 512; nM = M / 256; nN = 1; mode = M_MIXF; }
            else { A = (const gbf16*)(ws + WS_CVA); Bt = (const gbf16*)(ws + WS_WPW); K = 256; nM = M / 256; nN = 1; cc = (c + G - ((M / 256) % G)) % G; mode = M_MIXC; }
        } else if (sub == 4) { A = (const gbf16*)(ws + WS_MIX); Bt = (const gbf16*)(ws + WS_WOUT); K = D; nN = 4;
            if (j == 0) { nM = TL / 256; mode = M_RES1; } else { nM = TC / 256; pmbase = TL / 256; ksplit = 4; mode = M_RES1K; valid = (layer == 0); }
        }
        else if (sub == 6) { A = (const gbf16*)(ws + WS_HN); Bt = (const gbf16*)(ws + WS_W1); K = D; nM = M / 256; nN = 16; mode = M_HID; valid = (j == 0); }
        else { A = (const gbf16*)(ws + WS_HID); Bt = (const gbf16*)(ws + WS_W2); K = DFF; nN = 4;
            if (j == 0) { nM = TL / 256; mode = M_RES2; } else { nM = TC / 256; pmbase = TL / 256; ksplit = 4; mode = M_RES2K; valid = (layer == 0); }
        }
        if (valid && !(skip & 1)) { Sched S; S.init(nM, nN, G, cc); S.pmadd = pmadd; S.pmbase = pmbase; S.ksplit = ksplit; S.kbytes = (K / ksplit) * 2; int tj = tid; asm volatile("" : "+v"(tj)); run_gemm(lds, A, Bt, K, ksplit > 1 ? K / ksplit : 0, S, mode, layer, p, tj); }
    }
    if (sub == 2) {
        const int natt = (skip & 4) ? 0 : (layer == 0 ? 288 : 256), nconv = (skip & 2) ? 0 : (layer == 0 ? 288 : 256);
        unsigned* ctr = (unsigned*)(p.ws() + WS_CTL) + 64 * layer + 16 * (skip != 0);
        LAS int* slot = (LAS int*)(lds + LDSP_OFF + 512);
#pragma unroll 1
        for (;;) {
            __syncthreads();
            if (tid == 0) *slot = (int)__hip_atomic_fetch_add(ctr, 1u, __ATOMIC_RELAXED, __HIP_MEMORY_SCOPE_AGENT);
            __syncthreads();
            const int it = __builtin_amdgcn_readfirstlane(*slot);
            if (it >= natt + nconv) break;
            if (it < natt) {
                if (it < 256) attn_item(p, layer, it >> 5, (it >> 5) * SEQ + (it & 31) * 64, 16, it & 31, lds, tid, c);
                else { const int i2 = it - 256; attn_item(p, layer, i2 >> 2, TL + (i2 >> 2) * CTX + (i2 & 3) * 64, 0, 0, lds, tid, c); }
            } else {
                const int ic = it - natt; const bool lat = ic < 256; const int i2 = ic - 256;
                conv_tile(p, layer, lat ? (ic >> 5) * SEQ : TL + (i2 >> 2) * CTX, lat ? SEQ : CTX, lat ? (ic & 31) * 64 : (i2 & 3) * 64, lds, tid, c);
            }
        }
    }
}

__global__ void __launch_bounds__(512, 2) fwd_kernel(Params prm) {
    extern __shared__ __attribute__((aligned(16))) unsigned char lds_raw[];
    LAS unsigned char* lds = (LAS unsigned char*)lds_raw;
    {
        const unsigned long long* ka = (const unsigned long long*)__builtin_amdgcn_kernarg_segment_ptr();
        if (threadIdx.x < 23) ((LAS unsigned long long*)(lds + LDSP_OFF))[threadIdx.x] = ka[threadIdx.x];
    }
    __syncthreads();
    PP p; p.P = (const LAS unsigned long long*)(lds + LDSP_OFF);
    if (threadIdx.x < 2) ((LAS unsigned*)(lds + LDSP_OFF + 1024))[threadIdx.x] = 0u;
    __syncthreads();
    const XcdBarrier xbar = xcd_barrier_post((unsigned*)(prm.ws + WS_CTL) + 4096, (volatile LAS unsigned*)(lds + LDSP_OFF + 1024));
    const int lo = prm.ph_lo, hi = prm.ph_hi;
    const int wave_s = __builtin_amdgcn_readfirstlane((int)threadIdx.x >> 6);
#pragma unroll 1
    for (int ph = lo; ph < hi; ++ph) {
        if (ph > lo) { if (ph == lo + 1) cg::this_grid().sync(); else xcd_barrier(xbar); }
        int lane_; asm volatile("v_mbcnt_lo_u32_b32 %0, -1, 0\n\tv_mbcnt_hi_u32_b32 %0, -1, %0" : "=v"(lane_));
        int tid = wave_s * 64 + lane_, bid = blockIdx.x;
        asm volatile("" : "+s"(bid));
        run_phase(p, ph, lds, tid, bid);
        __syncthreads();
#ifdef PROBE_REPEAT
        if ((PROBE_REPEAT >> ph) & 1) { xcd_barrier(xbar); run_phase(p, ph, lds, tid, bid, PROBE_SKIP); __syncthreads(); }
#endif
    }
}

extern "C" void kernel_launch(void* const* d_in, const int* in_sizes, int n_in, void* d_out, int out_size, void* d_ws, size_t ws_size, hipStream_t stream) {
    static int grid = 0;
    if (grid == 0) {
        if (n_in != 21 || ws_size < WS_SIDE + 24 * MiB) { fprintf(stderr, "kernel_launch: unexpected n_in %d / ws_size %zu\n", n_in, ws_size); grid = -1; return; }
        int dev = 0, cus = 0, per_cu = 0;
        (void)hipGetDevice(&dev); (void)hipDeviceGetAttribute(&cus, hipDeviceAttributeMultiprocessorCount, dev);
        (void)hipFuncSetAttribute((const void*)fwd_kernel, hipFuncAttributeMaxDynamicSharedMemorySize, LDS_BYTES);
        (void)hipOccupancyMaxActiveBlocksPerMultiprocessor(&per_cu, (const void*)fwd_kernel, 512, LDS_BYTES);
        if (per_cu < 1) { fprintf(stderr, "kernel_launch: occupancy query says %d blocks/CU\n", per_cu); per_cu = 1; }
        (void)hipGetLastError();
        grid = cus > 0 ? cus : 256;
    }
    if (grid < 0) return;
    (void)hipMemsetAsync((char*)d_ws + WS_CTL, 0, 65536, stream);
    Params p{};
    for (int i = 0; i < 21; ++i) p.in[i] = (const float*)d_in[i];
    p.out = (float*)d_out; p.ws = (unsigned char*)d_ws;
#if SINGLE_LAUNCH
    p.ph_lo = 0; p.ph_hi = NPH;
    void* args[] = {&p};
    hipError_t e = hipLaunchCooperativeKernel((const void*)fwd_kernel, dim3(grid), dim3(512), args, LDS_BYTES, stream);
    if (e != hipSuccess) fprintf(stderr, "cooperative launch failed: %s (grid %d)\n", hipGetErrorString(e), grid);
#else
    for (int ph = 0; ph < NPH; ++ph) { p.ph_lo = ph; p.ph_hi = ph + 1; hipLaunchKernelGGL(fwd_kernel, dim3(grid), dim3(512), LDS_BYTES, stream, p); }
#endif
}
```

```cpp
#include <hip/hip_runtime.h>
#include <hip/hip_cooperative_groups.h>
#include <cstdio>
#include <cstdint>
namespace cg = cooperative_groups;
namespace pg8 {
#define PG8_LAS __attribute__((address_space(3)))
typedef unsigned short bf16_t;
typedef short bf16x8 __attribute__((ext_vector_type(8)));
typedef float f32x4 __attribute__((ext_vector_type(4)));
typedef unsigned u32x4 __attribute__((ext_vector_type(4)));
constexpr int BM = 256, BK = 64, HALF = 128, HTB = HALF * BK * 2  , STAGE_BYTES = 8 * HTB, NXCD = 8, WGM = 8;

__host__ __device__ __forceinline__ int lds_byte(int r, int c) { const int st = (r >> 4) * 2 + (c >> 5), rr = r & 15, cc = c & 31, ob = rr * 64 + cc * 2; return st * 1024 + (ob ^ (((ob >> 9) & 1) << 5)); }
__host__ __device__ __forceinline__ void stage_rc(int b, int& R, int& C) { const int st = b / 1024, sb = b % 1024, swz = sb ^ (((sb >> 9) & 1) << 5); R = (st >> 1) * 16 + swz / 64; C = (st & 1) * 32 + (swz % 64) / 2; }
__host__ __device__ __forceinline__ int perm32(int rho) { const int n = rho >> 4, i = rho & 15; return 8 * (i >> 2) + 4 * n + (i & 3); }

struct Unit { int pm, pn, ko; };
struct Gemm { const bf16_t* A; const bf16_t* Bt; int M, N, K; };

struct StaticOrder {
    int nM, nN, nwg, G, c;
    __host__ __device__ void init(int M, int N, int G_, int c_) { nM = M / BM; nN = N / BM; nwg = nM * nN; G = G_; c = c_; }
    __host__ __device__ bool next(int i, Unit& u) const {
        const long L = (long)i * G + c; if (L >= nwg) return false;
        int wgid = (int)L; { const int q = nwg / NXCD, r = nwg % NXCD, xcd = wgid % NXCD, off = wgid / NXCD; wgid = (xcd < r ? xcd * (q + 1) : r * (q + 1) + (xcd - r) * q) + off; }
        const int nig = WGM * nN, gid = wgid / nig, fm = gid * WGM, gsz = (nM - fm) < WGM ? (nM - fm) : WGM;
        u.pm = fm + ((wgid % nig) % gsz); u.pn = (wgid % nig) / gsz; u.ko = 0; return true;
    }
    __device__ __forceinline__ void a_ready(const Unit&) const {}
    __device__ __forceinline__ void done(const Unit&) const {}
};

template <class Epi, class Sched, bool ALIGN_EPI = false, bool SP2 = false>
__device__ __forceinline__ void gemm_phase(PG8_LAS unsigned char* lds, const Gemm g, const Sched& S, const Epi& E, const int tid_in) {
    const int tid = tid_in, wid = __builtin_amdgcn_readfirstlane(tid >> 6), lane = tid & 63, wr = wid >> 2, wc = wid & 3, fr = lane & 15, fq = lane >> 4;
    const int K = g.K, nt = (g.M ? g.M : K) / BK;
    unsigned voffA[2], voffB[2];
#pragma unroll
    for (int i = 0; i < 2; ++i) { int R, C; stage_rc(tid * 16 + i * 8192, R, C); const int Rb = Epi::PERM ? ((R & ~31) + perm32(R & 31)) : R;
        voffA[i] = (unsigned)(R * K + C) * 2u; voffB[i] = (unsigned)(Rb * K + C) * 2u; }
    const size_t kstep = (size_t)(BK * 2);
    const size_t hstep = (size_t)HALF * K * 2;
    const size_t tstep = 2 * hstep;
    const unsigned ldsw = (unsigned)wid * 1024u;
    const int aoff = lds_byte(wr * 64 + fr, fq * 8), boff = lds_byte(wc * 32 + fr, fq * 8);
#define PG8_SA(b, h) (((b) * 2 + (h)) * HTB)
#define PG8_SB(b, h) ((4 + (b) * 2 + (h)) * HTB)
#define PG8_STAGE(bufoff, gbase, voff) do { _Pragma("unroll") for (int _i = 0; _i < 2; ++_i) \
        __builtin_amdgcn_global_load_lds((const unsigned*)((const char*)(gbase) + (voff)[_i]), (PG8_LAS unsigned*)(lds + (bufoff) + ldsw + _i * 8192), 16, 0, 0); } while (0)
#define PG8_LDA(dst, b, h) do { _Pragma("unroll") for (int m = 0; m < 4; ++m) _Pragma("unroll") for (int k = 0; k < 2; ++k) dst[m][k] = *(const PG8_LAS bf16x8*)(lds + PG8_SA(b, h) + aoff + m * 2048 + k * 1024); } while (0)
#define PG8_LDB(dst, b, h) do { _Pragma("unroll") for (int n = 0; n < 2; ++n) _Pragma("unroll") for (int k = 0; k < 2; ++k) dst[n][k] = *(const PG8_LAS bf16x8*)(lds + PG8_SB(b, h) + boff + n * 2048 + k * 1024); } while (0)
#define PG8_MMA(ai, bj, At, Bt) do { __builtin_amdgcn_s_setprio(1); _Pragma("unroll") for (int m = 0; m < 4; ++m) _Pragma("unroll") for (int n = 0; n < 2; ++n) _Pragma("unroll") for (int k = 0; k < 2; ++k) \
        acc[ai][bj][m][n] = __builtin_amdgcn_mfma_f32_16x16x32_bf16(Bt[n][k], At[m][k], acc[ai][bj][m][n], 0, 0, 0); __builtin_amdgcn_s_setprio(0); } while (0)
#define PG8_WAIT_V(n) asm volatile("s_waitcnt vmcnt(" #n ")" ::: "memory")
#define PG8_WAIT_L(n) asm volatile("s_waitcnt lgkmcnt(" #n ")" ::: "memory")
#define PG8_BAR __builtin_amdgcn_s_barrier()
#define PG8_SCHED __builtin_amdgcn_sched_barrier(0)
    Unit cur, nxt; int ui = 0;
    if (!S.next(0, cur)) return;
    f32x4 acc[2][2][4][2];
#pragma unroll
    for (int a = 0; a < 2; ++a)
#pragma unroll
        for (int b = 0; b < 2; ++b)
#pragma unroll
            for (int m = 0; m < 4; ++m)
#pragma unroll
                for (int n = 0; n < 2; ++n) acc[a][b][m][n] = (f32x4){0.f, 0.f, 0.f, 0.f};
    bf16x8 At[4][2], B0[2][2], B1[2][2];
    const char* cA = (const char*)g.A + (size_t)cur.pm * tstep + cur.ko; const char* cB = (const char*)g.Bt + (size_t)cur.pn * tstep + cur.ko;
    S.a_ready(cur);
    if constexpr (SP2) {
        PG8_STAGE(PG8_SB(0, 0), cB, voffB); PG8_STAGE(PG8_SB(0, 1), cB + hstep, voffB); PG8_STAGE(PG8_SA(0, 0), cA, voffA); PG8_STAGE(PG8_SA(0, 1), cA + hstep, voffA);
        if (wr == 1) PG8_BAR;
        PG8_WAIT_V(2); PG8_BAR;
        PG8_STAGE(PG8_SB(1, 0), cB + kstep, voffB); PG8_STAGE(PG8_SA(1, 0), cA + kstep, voffA); PG8_STAGE(PG8_SB(1, 1), cB + hstep + kstep, voffB);
        PG8_WAIT_V(6); PG8_BAR;
    } else {
        PG8_STAGE(PG8_SB(0, 0), cB, voffB); PG8_STAGE(PG8_SA(0, 0), cA, voffA); PG8_STAGE(PG8_SB(0, 1), cB + hstep, voffB); PG8_STAGE(PG8_SA(0, 1), cA + hstep, voffA);
        if (wr == 1) PG8_BAR;
        PG8_WAIT_V(4); PG8_BAR;
        PG8_STAGE(PG8_SB(1, 0), cB + kstep, voffB); PG8_STAGE(PG8_SA(1, 0), cA + kstep, voffA); PG8_STAGE(PG8_SB(1, 1), cB + hstep + kstep, voffB);
        PG8_WAIT_V(6); PG8_BAR;
    }
    for (;;) {
        const bool has_next = S.next(ui + 1, nxt);
        const char* nA = has_next ? (const char*)g.A + (size_t)nxt.pm * tstep + nxt.ko : cA; const char* nB = has_next ? (const char*)g.Bt + (size_t)nxt.pn * tstep + nxt.ko : cB;
        for (int t = 0; t < nt; t += 2) {
            const bool last = (t == nt - 2);
            const char* a1 = cA + (size_t)(t + 1) * kstep;
            const char* a2 = last ? nA : cA + (size_t)(t + 2) * kstep; const char* b2 = last ? nB : cB + (size_t)(t + 2) * kstep;
            const char* a3 = a2 + kstep; const char* b3 = b2 + kstep;
            if (last && has_next) S.a_ready(nxt);
            if constexpr (SP2) {
            PG8_LDB(B0, 0, 0); PG8_LDB(B1, 0, 1); PG8_SCHED; PG8_LDA(At, 0, 0); PG8_STAGE(PG8_SA(1, 1), a1 + hstep, voffA);
            PG8_WAIT_V(8); PG8_WAIT_L(0); PG8_BAR; PG8_MMA(0, 0, At, B0); PG8_MMA(0, 1, At, B1); PG8_BAR; PG8_SCHED;
            PG8_LDA(At, 0, 1); PG8_STAGE(PG8_SB(0, 0), b2, voffB); PG8_STAGE(PG8_SB(0, 1), b2 + hstep, voffB); PG8_STAGE(PG8_SA(0, 0), a2, voffA);
            PG8_WAIT_V(8); PG8_WAIT_L(0); PG8_BAR; PG8_MMA(1, 0, At, B0); PG8_MMA(1, 1, At, B1); PG8_BAR; PG8_SCHED;
            PG8_LDB(B0, 1, 0); PG8_LDB(B1, 1, 1); PG8_SCHED; PG8_LDA(At, 1, 0); PG8_STAGE(PG8_SA(0, 1), a2 + hstep, voffA);
            PG8_WAIT_V(8); PG8_WAIT_L(0); PG8_BAR; PG8_MMA(0, 0, At, B0); PG8_MMA(0, 1, At, B1); PG8_BAR; PG8_SCHED;
            PG8_LDA(At, 1, 1); PG8_STAGE(PG8_SB(1, 0), b3, voffB); PG8_STAGE(PG8_SB(1, 1), b3 + hstep, voffB); PG8_STAGE(PG8_SA(1, 0), a3, voffA);
            PG8_WAIT_V(8); PG8_WAIT_L(0); PG8_BAR; PG8_MMA(1, 0, At, B0); PG8_MMA(1, 1, At, B1); PG8_BAR; PG8_SCHED;
            } else {
            PG8_LDB(B0, 0, 0); PG8_SCHED; PG8_LDA(At, 0, 0); PG8_STAGE(PG8_SA(1, 1), a1 + hstep, voffA);
            PG8_WAIT_L(8); PG8_BAR; PG8_WAIT_L(0); PG8_MMA(0, 0, At, B0); PG8_BAR; PG8_SCHED;
            PG8_LDB(B1, 0, 1); PG8_STAGE(PG8_SB(0, 0), b2, voffB);
            PG8_BAR; PG8_WAIT_L(0); PG8_MMA(0, 1, At, B1); PG8_BAR;
            PG8_LDA(At, 0, 1); PG8_STAGE(PG8_SA(0, 0), a2, voffA);
            PG8_BAR; PG8_WAIT_L(0); PG8_MMA(1, 0, At, B0); PG8_BAR; PG8_SCHED;
            PG8_STAGE(PG8_SB(0, 1), b2 + hstep, voffB);
            PG8_WAIT_V(6); PG8_BAR; PG8_MMA(1, 1, At, B1); PG8_BAR;
            PG8_LDB(B0, 1, 0); PG8_SCHED; PG8_LDA(At, 1, 0); PG8_STAGE(PG8_SA(0, 1), a2 + hstep, voffA);
            PG8_WAIT_L(8); PG8_BAR; PG8_WAIT_L(0); PG8_MMA(0, 0, At, B0); PG8_BAR; PG8_SCHED;
            PG8_LDB(B1, 1, 1); PG8_STAGE(PG8_SB(1, 0), b3, voffB);
            PG8_BAR; PG8_WAIT_L(0); PG8_MMA(0, 1, At, B1); PG8_BAR;
            PG8_LDA(At, 1, 1); PG8_STAGE(PG8_SA(1, 0), a3, voffA);
            PG8_BAR; PG8_WAIT_L(0); PG8_MMA(1, 0, At, B0); PG8_BAR; PG8_SCHED;
            PG8_STAGE(PG8_SB(1, 1), b3 + hstep, voffB);
            PG8_WAIT_V(6); PG8_BAR; PG8_MMA(1, 1, At, B1); PG8_BAR;
            }
        }
        if constexpr (ALIGN_EPI) { if (wr == 0) PG8_BAR; }
        if constexpr (!Epi::AFTER_DRAIN) { E(acc, cur, wr, wc, fr, fq); S.done(cur); }
        if (!has_next) break;
#pragma unroll
        for (int a = 0; a < 2; ++a)
#pragma unroll
            for (int b = 0; b < 2; ++b)
#pragma unroll
                for (int m = 0; m < 4; ++m)
#pragma unroll
                    for (int n = 0; n < 2; ++n) acc[a][b][m][n] = (f32x4){0.f, 0.f, 0.f, 0.f};
        cur = nxt; cA = nA; cB = nB; ++ui;
        if constexpr (ALIGN_EPI) { if (wr == 1) PG8_BAR; }
    }
    PG8_WAIT_V(0);
    if constexpr (!ALIGN_EPI) { if (wr == 0) PG8_BAR; }
    PG8_BAR;
    if constexpr (Epi::AFTER_DRAIN) { E.fused(acc, cur, wr, wc, fr, fq, lds, wid, lane); S.done(cur); }
#undef PG8_SA
#undef PG8_SB
#undef PG8_STAGE
#undef PG8_LDA
#undef PG8_LDB
#undef PG8_MMA
#undef PG8_WAIT_V
#undef PG8_WAIT_L
#undef PG8_BAR
#undef PG8_SCHED
}
}

#define LAS __attribute__((address_space(3)))
#define DI __device__ __forceinline__
typedef unsigned short bf16;
typedef short bf16x8 __attribute__((ext_vector_type(8)));
typedef short s16x4 __attribute__((ext_vector_type(4)));
typedef float f32x4 __attribute__((ext_vector_type(4)));
typedef float f32x16 __attribute__((ext_vector_type(16)));
typedef unsigned u32x4 __attribute__((ext_vector_type(4)));
typedef unsigned u32x2 __attribute__((ext_vector_type(2)));
typedef __bf16 bf16x2_t __attribute__((ext_vector_type(2)));
typedef float f32x2_t __attribute__((ext_vector_type(2)));
#define GAS __attribute__((address_space(1)))
typedef GAS float gfloat; typedef GAS unsigned short gbf16; typedef GAS char gchar; typedef GAS unsigned char guchar;

#ifndef SINGLE_LAUNCH
#define SINGLE_LAUNCH 1
#endif

constexpr int D = 1024, NB = 8, SEQ = 2048, CTX = 256, TL = NB * SEQ, TC = NB * CTX, TA = TL + TC;
constexpr int DIN = 2304, DFF = 4096, URM = 1024;
constexpr int NPH = 18;
constexpr int LDS_BYTES = 147456;
constexpr size_t MiB = 1u << 20;
constexpr size_t WS_CTL = 0, WS_MODS = 1 * MiB;
constexpr size_t WS_WIN = 2 * MiB, WS_WOUT = WS_WIN + (size_t)DIN * D * 2, WS_W1 = WS_WOUT + 2 * MiB, WS_W2 = WS_W1 + 8 * MiB, WS_WPW = WS_W2 + 8 * MiB, WS_WF2 = WS_WPW + 128 * 1024;
constexpr size_t WS_DFTL = 25 * MiB, WS_DFTC = 41 * MiB, WS_HCTX = 42 * MiB, WS_HN = 50 * MiB, WS_OV = 86 * MiB;
constexpr size_t WS_URM = WS_OV, WS_UTL = WS_OV + 36 * MiB, WS_UTC = WS_UTL + 8 * MiB, WS_KT = WS_UTC + 1 * MiB, WS_VT = WS_KT + 18 * MiB,
                 WS_G12 = WS_VT + 18 * MiB, WS_CVA = WS_G12 + 18 * MiB, WS_MIX = WS_CVA + 9 * MiB, WS_HID = WS_OV, WS_END = WS_OV + 144 * MiB;
constexpr size_t WS_SIDE = WS_END;
static_assert(WS_SIDE + 24 * MiB <= 256 * MiB, "side buffers");
static_assert(WS_WF2 + 256 * 1024 <= WS_DFTL && WS_MIX + 36 * MiB == WS_END && WS_END <= 256 * MiB, "ws map");

struct Params { const float* in[21]; float* out; unsigned char* ws; int ph_lo, ph_hi; };
constexpr int LDSP_OFF = 131072;
struct PP {
    const __attribute__((address_space(3))) unsigned long long* P;
    __device__ __forceinline__ unsigned long long ld(int i) const { const unsigned long long v = P[i]; const unsigned lo = __builtin_amdgcn_readfirstlane((unsigned)v), hi = __builtin_amdgcn_readfirstlane((unsigned)(v >> 32)); return ((unsigned long long)hi << 32) | lo; }
    __device__ __forceinline__ const gfloat* in(int i) const { return (const gfloat*)ld(i); }
    __device__ __forceinline__ gfloat* out() const { return (gfloat*)ld(21); }
    __device__ __forceinline__ unsigned char* ws() const { return (unsigned char*)ld(22); }
};

DI unsigned pk2(float lo, float hi) { f32x2_t v = {lo, hi}; bf16x2_t b = __builtin_convertvector(v, bf16x2_t); return __builtin_bit_cast(unsigned, b); }
DI float bf2f(short x) { return __builtin_bit_cast(float, ((unsigned)(unsigned short)x) << 16); }
DI float wave_sum(float v) {
#pragma unroll
    for (int o = 1; o < 64; o <<= 1) v += __shfl_xor(v, o);
    return v;
}
#define LDS_WAIT() asm volatile("s_waitcnt lgkmcnt(0)" ::: "memory")

struct Sched {
    int nM, nN, nwg, G, c, pmadd, pmbase, ksplit, kbytes;
    DI void init(int nM_, int nN_, int G_, int c_) { nM = nM_; nN = nN_; nwg = nM_ * nN_; G = G_; c = c_; pmadd = 0; pmbase = 0; ksplit = 1; kbytes = 0; }
    DI bool next(int i, pg8::Unit& u) const {
        const long L = (long)i * G + c; if (L >= (long)nwg * ksplit) return false;
        int wgid = (int)L; u.ko = 0;
        if (ksplit > 1) { u.ko = (wgid % ksplit) * kbytes; wgid /= ksplit; }
        else { const int q = nwg / 8, r = nwg % 8, xcd = wgid % 8, off = wgid / 8; wgid = (xcd < r ? xcd * (q + 1) : r * (q + 1) + (xcd - r) * q) + off; }
        const int nig = 8 * nN, gid = wgid / nig, fm = gid * 8, gsz = (nM - fm) < 8 ? (nM - fm) : 8;
        u.pm = fm + ((wgid % nig) % gsz); u.pn = (wgid % nig) / gsz;
        if (u.pm > 0) u.pm += pmadd;
        u.pm += pmbase;
        return true;
    }
    DI void a_ready(const pg8::Unit&) const {}
    DI void done(const pg8::Unit&) const {}
};

template <int ACT> DI void store_tile_bf16(const pg8::f32x4 (&acc)[2][2][4][2], gbf16* base, int ld, const gfloat* bias, int wr, int wc, int fr, int fq) {
    const unsigned loff = (unsigned)((wr * 64 + fr) * ld + wc * 32 + 8 * fq) * 2u;
    f32x4 bv[2][2];
#pragma unroll
    for (int bj = 0; bj < 2; ++bj)
#pragma unroll
        for (int n = 0; n < 2; ++n) bv[bj][n] = bias ? *(const GAS f32x4*)(bias + wc * 32 + 8 * fq + bj * 128 + 4 * n) : (f32x4){0.f, 0.f, 0.f, 0.f};
#pragma unroll
    for (int ai = 0; ai < 2; ++ai)
#pragma unroll
        for (int m = 0; m < 4; ++m) { gchar* rowp = (gchar*)base + (size_t)((ai * 128 + m * 16) * ld) * 2u;
#pragma unroll
            for (int bj = 0; bj < 2; ++bj) { f32x4 a = acc[ai][bj][m][0] + bv[bj][0], b = acc[ai][bj][m][1] + bv[bj][1];
                if (ACT == 1) {
#pragma unroll
                    for (int e = 0; e < 4; ++e) { const float x = fmaxf(a[e], 0.f); a[e] = x * x; const float y = fmaxf(b[e], 0.f); b[e] = y * y; } }
                u32x4 w; w.x = pk2(a.x, a.y); w.y = pk2(a.z, a.w); w.z = pk2(b.x, b.y); w.w = pk2(b.z, b.w);
                *(GAS u32x4*)(rowp + bj * 256 + loff) = w; } }
}
DI void store_kfrag(const pg8::f32x4 (&acc)[2][2][4][2], gbf16* base, int wr, int wc, int fr, int fq) {
    const unsigned loff = (unsigned)(wr * 2 * 16384 + (wc >> 1) * 2048 + fq * 512 + (wc & 1) * 256 + fr * 8) * 2u;
#pragma unroll
    for (int ai = 0; ai < 2; ++ai)
#pragma unroll
        for (int m = 0; m < 4; ++m)
#pragma unroll
            for (int bj = 0; bj < 2; ++bj) { const f32x4 a = acc[ai][bj][m][0], b = acc[ai][bj][m][1];
                u32x4 w; w.x = pk2(a.x, a.y); w.y = pk2(a.z, a.w); w.z = pk2(b.x, b.y); w.w = pk2(b.z, b.w);
                *(GAS u32x4*)((gchar*)base + (size_t)((ai * 4 + (m >> 1)) * 16384 + bj * 2 * 2048 + (m & 1) * 128) * 2u + loff) = w; }
}
DI void store_vfrag(const pg8::f32x4 (&acc)[2][2][4][2], gbf16* base, int wr, int wc, int fr, int fq) {
    const unsigned loff = (unsigned)(wc * 8 * 2048 + wr * 2048 + (fq >> 1) * 512 + fr * 8 + (fq & 1) * 4) * 2u;
#pragma unroll
    for (int ai = 0; ai < 2; ++ai)
#pragma unroll
        for (int m = 0; m < 4; ++m)
#pragma unroll
            for (int bj = 0; bj < 2; ++bj) { const f32x4 a = acc[ai][bj][m][0], b = acc[ai][bj][m][1];
                gchar* q = (gchar*)base + (size_t)(bj * 32 * 2048 + ai * 2 * 2048 + (m >> 1) * 1024 + (m & 1) * 128) * 2u + loff;
                u32x2 w0; w0.x = pk2(a.x, a.y); w0.y = pk2(a.z, a.w); u32x2 w1; w1.x = pk2(b.x, b.y); w1.y = pk2(b.z, b.w);
                *(GAS u32x2*)q = w0; *(GAS u32x2*)(q + 512) = w1; }
}
enum { M_URM = 0, M_SWAP, M_DFTL, M_DFTC, M_MIXF, M_MIXC, M_RES1, M_RES2, M_HID, M_RES1K, M_RES2K };
struct UEpi {
    static constexpr bool PERM = true, AFTER_DRAIN = false;
    int mode, layer; PP p;
    DI void operator()(const pg8::f32x4 (&acc)[2][2][4][2], const pg8::Unit& u, int wr, int wc, int fr, int fq) const {
        unsigned char* ws = p.ws();
        if (mode == M_RES1K || mode == M_RES2K) {
            const int kc = u.ko / (mode == M_RES1K ? (D / 4) * 2 : (DFF / 4) * 2);
            const int r2 = u.pm * 256 - TL;
            const gfloat* srcb = (mode == M_RES1K && layer == 0) ? p.in(2) : (const gfloat*)(ws + WS_HCTX);
            const gchar* sp = (const gchar*)(srcb + (size_t)r2 * D + u.pn * 256);
            gchar* d = (gchar*)((gfloat*)(ws + (kc == 0 ? WS_HCTX : WS_SIDE + (size_t)(kc - 1) * 8 * MiB)) + (size_t)r2 * D + u.pn * 256);
            const gfloat* gp = (const gfloat*)(ws + WS_MODS) + (size_t)layer * 9 * 6144 + (mode == M_RES1K ? 2 : 5) * D + 8 * 6144 + u.pn * 256 + wc * 32 + 8 * fq;
            const unsigned loff = (unsigned)((wr * 64 + fr) * D + wc * 32 + 8 * fq) * 4u;
            f32x4 gv[2][2];
#pragma unroll
            for (int bj = 0; bj < 2; ++bj)
#pragma unroll
                for (int n = 0; n < 2; ++n) gv[bj][n] = *(const GAS f32x4*)(gp + bj * 128 + 4 * n);
#pragma unroll
            for (int ai = 0; ai < 2; ++ai)
#pragma unroll
                for (int m = 0; m < 4; ++m) { const size_t ro = (size_t)((ai * 128 + m * 16) * D) * 4u;
#pragma unroll
                    for (int bj = 0; bj < 2; ++bj) {
                        f32x4 x0 = (f32x4){0.f, 0.f, 0.f, 0.f}, x1 = x0;
                        if (kc == 0) { x0 = *(const GAS f32x4*)(sp + ro + bj * 512 + loff); x1 = *(const GAS f32x4*)(sp + ro + bj * 512 + 16 + loff); }
                        *(GAS f32x4*)(d + ro + bj * 512 + loff) = x0 + gv[bj][0] * acc[ai][bj][m][0];
                        *(GAS f32x4*)(d + ro + bj * 512 + 16 + loff) = x1 + gv[bj][1] * acc[ai][bj][m][1]; } }
            return;
        }
        if (mode == M_RES1 || mode == M_RES2) {
            const bool first = (mode == M_RES1 && layer == 0);
            const int row0 = u.pm * 256; const bool lat = row0 < TL; const int r2 = lat ? row0 : row0 - TL, midx = lat ? (row0 >> 11) : 8;
            const gfloat* srcb = lat ? (first ? p.in(0) : (const gfloat*)p.out()) : (first ? p.in(2) : (const gfloat*)(ws + WS_HCTX));
            gfloat* dstb = lat ? p.out() : (gfloat*)(ws + WS_HCTX);
            const gchar* s = (const gchar*)(srcb + (size_t)r2 * D + u.pn * 256);
            gchar* d = (gchar*)(dstb + (size_t)r2 * D + u.pn * 256);
            const gfloat* gp = (const gfloat*)(ws + WS_MODS) + (size_t)layer * 9 * 6144 + (mode == M_RES1 ? 2 : 5) * D + midx * 6144 + u.pn * 256 + wc * 32 + 8 * fq;
            const unsigned loff = (unsigned)((wr * 64 + fr) * D + wc * 32 + 8 * fq) * 4u;
            f32x4 gv[2][2];
#pragma unroll
            for (int bj = 0; bj < 2; ++bj)
#pragma unroll
                for (int n = 0; n < 2; ++n) gv[bj][n] = *(const GAS f32x4*)(gp + bj * 128 + 4 * n);
#pragma unroll
            for (int ai = 0; ai < 2; ++ai)
#pragma unroll
                for (int m = 0; m < 4; ++m) { const size_t ro = (size_t)((ai * 128 + m * 16) * D) * 4u;
#pragma unroll
                    for (int bj = 0; bj < 2; ++bj) {
                        const f32x4 x0 = *(const GAS f32x4*)(s + ro + bj * 512 + loff), x1 = *(const GAS f32x4*)(s + ro + bj * 512 + 16 + loff);
                        *(GAS f32x4*)(d + ro + bj * 512 + loff) = x0 + gv[bj][0] * acc[ai][bj][m][0];
                        *(GAS f32x4*)(d + ro + bj * 512 + 16 + loff) = x1 + gv[bj][1] * acc[ai][bj][m][1]; } }
            return;
        }
        gbf16* base; int ld; const gfloat* bias = nullptr;
        if (mode == M_URM) {
            if (u.pn >= 4) { store_kfrag(acc, (gbf16*)(ws + WS_KT) + (size_t)(u.pm * 64 + (u.pn - 4) * 4) * 2048, wr, wc, fr, fq); return; }
            ld = URM; base = (gbf16*)(ws + WS_URM) + (size_t)(u.pm * 256) * URM + u.pn * 256; }
        else if (mode == M_HID) { ld = DFF; base = (gbf16*)(ws + WS_HID) + (size_t)(u.pm * 256) * DFF + u.pn * 256; }
        else if (mode == M_SWAP) {
            if (u.pm != 0) { store_vfrag(acc, (gbf16*)(ws + WS_VT) + (size_t)(u.pn * 64 + (u.pm - 7) * 4) * 2048, wr, wc, fr, fq); return; }
            const int tok0 = u.pn * 256; const bool lat = tok0 < TL;
            const int bb = lat ? (tok0 >> 11) : ((tok0 - TL) >> 8), l0 = lat ? (tok0 & (SEQ - 1)) : 0; ld = lat ? SEQ : CTX;
            base = (gbf16*)(ws + (lat ? WS_UTL : WS_UTC)) + (size_t)(bb * 256) * ld + l0;
        } else if (mode == M_DFTL || mode == M_DFTC) {
            const int L = mode == M_DFTL ? SEQ : CTX, lshift = mode == M_DFTL ? 11 : 8, rowbase = mode == M_DFTL ? 0 : TL;
            const int row0 = u.pm * 256, cs = row0 >> lshift, lp0 = row0 & (L - 1);
            ld = 512; base = (gbf16*)(ws + WS_G12) + (size_t)(rowbase + u.pn * L + lp0) * 512 + cs * 256;
        } else {
            ld = D; base = (gbf16*)(ws + WS_MIX) + (size_t)(u.pm * 256) * D + (mode == M_MIXC ? 256 : 0);
            if (mode == M_MIXC) bias = p.in(15) + layer * 256;
        }
        if (mode == M_HID) store_tile_bf16<1>(acc, base, ld, nullptr, wr, wc, fr, fq);
        else store_tile_bf16<0>(acc, base, ld, bias, wr, wc, fr, fq);
    }
};
DI void run_gemm(LAS unsigned char* lds, const gbf16* A, const gbf16* Bt, int K, int Kext, const Sched& S, int mode, int layer, PP p, const int tid) {
    pg8::Gemm g{(const bf16*)A, (const bf16*)Bt, Kext, 0, K}; UEpi e{mode, layer, p};
    pg8::gemm_phase<UEpi, Sched, true, true>(lds, g, S, e, tid);
}
#define XB_TMO      128
#define XB_XCNT(j)  (256  + 64 * (j))
#define XB_XSUB(j)  (1280 + 64 * (j))
#define XB_XGEN(j)  (2304 + 64 * (j))
#define XB_TOP      3328
#define XB_TOPGEN   3392
#define XCD_BAR_WORDS 3456
#define XB_SPIN_CAP (1u << 18)

__device__ __forceinline__ unsigned xb_ld(unsigned* p)              { return __hip_atomic_load(p, __ATOMIC_RELAXED, __HIP_MEMORY_SCOPE_AGENT); }
__device__ __forceinline__ unsigned xb_add(unsigned* p, unsigned v) { return __hip_atomic_fetch_add(p, v, __ATOMIC_RELAXED, __HIP_MEMORY_SCOPE_AGENT); }
__device__ __forceinline__ unsigned xb_xcc_id() { return (unsigned)__builtin_amdgcn_s_getreg((3 << 11) | 20) & 0xFu; }
#define XB_SPIN(cond, bar) do { unsigned _sp = 0; while (cond) { __builtin_amdgcn_s_sleep(1); \
    if ((++_sp & 255u) == 0u) { if (xb_ld(&(bar)[XB_TMO])) break; if (_sp > XB_SPIN_CAP) { atomicAdd(&(bar)[XB_TMO], 1u); break; } } } } while (0)

struct XcdBarrier {
    unsigned* bar; unsigned x;
    volatile LAS unsigned* st;
};

__device__ __forceinline__ XcdBarrier xcd_barrier_post(unsigned* bar, volatile LAS unsigned* st) {
    XcdBarrier b; b.bar = bar; b.x = xb_xcc_id(); b.st = st;
    if (threadIdx.x == 0) (void)xb_add(&bar[XB_XCNT(b.x)], 1u);
    return b;
}
__device__ __forceinline__ void xcd_barrier_complete(unsigned* bar, unsigned x, unsigned& nloc, unsigned& nx) {
    const unsigned G = gridDim.x * gridDim.y * gridDim.z;
    unsigned sum, cnt, mine, sp = 0u;
    for (;;) {
        sum = 0u; cnt = 0u; mine = 0u;
#pragma unroll
        for (unsigned j = 0; j < 16; ++j) { const unsigned c = xb_ld(&bar[XB_XCNT(j)]); sum += c; cnt += (c > 0u) ? 1u : 0u; mine = (j == x) ? c : mine; }
        if (sum == G) break;
        __builtin_amdgcn_s_sleep(1);
        if ((++sp & 255u) == 0u) { if (xb_ld(&bar[XB_TMO])) break; if (sp > XB_SPIN_CAP) { atomicAdd(&bar[XB_TMO], 1u); break; } }
    }
    nloc = mine > 0u ? mine : 1u; nx = cnt > 0u ? cnt : 1u;
}

__device__ __forceinline__ void xcd_barrier(const XcdBarrier& b) {
    asm volatile("s_waitcnt vmcnt(0)" ::: "memory");
    __syncthreads();
    if (threadIdx.x == 0) {
        unsigned* bar = b.bar;
        __builtin_amdgcn_s_waitcnt(0);
        unsigned nloc = b.st[0], nx = b.st[1];
        if (nloc == 0u) { xcd_barrier_complete(bar, b.x, nloc, nx); b.st[0] = nloc; b.st[1] = nx; }
        const unsigned old = xb_add(&bar[XB_XSUB(b.x)], 1u);
        const unsigned gen = old / nloc;
        if (old + 1u == (gen + 1u) * nloc) {
            __builtin_amdgcn_fence(__ATOMIC_RELEASE, "agent");
            asm volatile("s_waitcnt vmcnt(0)" ::: "memory");
            const unsigned og = xb_add(&bar[XB_TOP], 1u);
            const unsigned tg = og / nx;
            if (og + 1u == (tg + 1u) * nx) xb_add(&bar[XB_TOPGEN], 1u);
            else XB_SPIN(xb_ld(&bar[XB_TOPGEN]) == tg, bar);
            __builtin_amdgcn_fence(__ATOMIC_ACQUIRE, "agent");
            xb_add(&bar[XB_XGEN(b.x)], 1u);
            asm volatile("s_waitcnt vmcnt(0)" ::: "memory");
        } else {
            XB_SPIN(xb_ld(&bar[XB_XGEN(b.x)]) == gen, bar);
            __builtin_amdgcn_fence(__ATOMIC_ACQUIRE, "agent");
            asm volatile("s_waitcnt vmcnt(0)" ::: "memory");
        }
    }
    __syncthreads();
}

DI void phase_mods(const PP p, LAS unsigned char* lds, const int tid_, const int bid_) {
    const int tid = tid_, lane = tid & 63, wave = tid >> 6;
    LAS float* s = (LAS float*)lds;
    LAS float* red = (LAS float*)(lds + 36864);
    gfloat* mods = (gfloat*)(p.ws() + WS_MODS);
    for (int i = tid; i < 9 * 1024; i += 512) { const int j = i >> 10, k = i & 1023; const float v = j < 8 ? p.in(1)[j * 1024 + k] : p.in(3)[k]; s[i] = v / (1.f + expf(-v)); }
    __syncthreads();
    for (int item = bid_; item < 192; item += gridDim.x) {
        const int layer = item / 96, cgp = item % 96, col = cgp * 64 + lane;
        const gfloat* W = p.in(4) + (size_t)layer * 1024 * 6144 + col;
        float acc[9];
#pragma unroll
        for (int j = 0; j < 9; ++j) acc[j] = 0.f;
        const int k0 = wave * 128;
#pragma unroll 8
        for (int k = k0; k < k0 + 128; ++k) { const float w = W[(size_t)k * 6144];
#pragma unroll
            for (int j = 0; j < 9; ++j) acc[j] += s[j * 1024 + k] * w; }
#pragma unroll
        for (int j = 0; j < 9; ++j) red[(wave * 9 + j) * 64 + lane] = acc[j];
        __syncthreads();
        for (int t = tid; t < 576; t += 512) { const int j = t >> 6, l = t & 63; float v = p.in(5)[layer * 6144 + cgp * 64 + l];
#pragma unroll
            for (int w = 0; w < 8; ++w) v += red[(w * 9 + j) * 64 + l];
            mods[(size_t)(layer * 9 + j) * 6144 + cgp * 64 + l] = v; }
        __syncthreads();
    }
}
DI void make_tables(const PP p, const int tid_, const int bid_) {
    gbf16* DL = (gbf16*)(p.ws() + WS_DFTL); gbf16* DC = (gbf16*)(p.ws() + WS_DFTC);
    const int gt = bid_ * 512 + tid_, NT = gridDim.x * 512;
    for (int i = gt; i < 4096 * 256; i += NT) { const int row = i >> 8, l0 = (i & 255) * 8, cs = row >> 11, lp = row & 2047;
        float v[8];
#pragma unroll
        for (int e = 0; e < 8; ++e) { const int ph = (lp * (l0 + e)) & 2047; const float x = (float)ph * (1.f / 1024.f); v[e] = (cs ? sinpif(x) : cospif(x)) * 0.022097086912079608f; }
        u32x4 w; w.x = pk2(v[0], v[1]); w.y = pk2(v[2], v[3]); w.z = pk2(v[4], v[5]); w.w = pk2(v[6], v[7]);
        *(GAS u32x4*)(DL + (size_t)row * 2048 + l0) = w; }
    for (int i = gt; i < 512 * 32; i += NT) { const int row = i >> 5, l0 = (i & 31) * 8, cs = row >> 8, lp = row & 255;
        float v[8];
#pragma unroll
        for (int e = 0; e < 8; ++e) { const int ph = (lp * (l0 + e)) & 255; const float x = (float)ph * (1.f / 128.f); v[e] = (cs ? sinpif(x) : cospif(x)) * 0.0625f; }
        u32x4 w; w.x = pk2(v[0], v[1]); w.y = pk2(v[2], v[3]); w.z = pk2(v[4], v[5]); w.w = pk2(v[6], v[7]);
        *(GAS u32x4*)(DC + (size_t)row * 256 + l0) = w; }
}
DI void transpose_item(const gfloat* W, int K, int N, gbf16* WT, LAS float* scr, int item, int lane) {
    const int nblk = N / 32, kb = item / nblk, nb = item % nblk, k0 = 64 * kb, n0 = 32 * nb;
#pragma unroll 8
    for (int i = 0; i < 32; ++i) { const int kk = 2 * i + (lane >> 5); scr[kk * 33 + (lane & 31)] = W[(size_t)(k0 + kk) * N + n0 + (lane & 31)]; }
    LDS_WAIT(); asm volatile("" ::: "memory");
    const int c = lane & 7;
#pragma unroll
    for (int j = 0; j < 4; ++j) { const int n = (lane >> 3) + 8 * j; const LAS float* sp = scr + (8 * c) * 33 + n;
        u32x4 o; o.x = pk2(sp[0 * 33], sp[1 * 33]); o.y = pk2(sp[2 * 33], sp[3 * 33]); o.z = pk2(sp[4 * 33], sp[5 * 33]); o.w = pk2(sp[6 * 33], sp[7 * 33]);
        *(GAS u32x4*)(WT + (size_t)(n0 + n) * K + k0 + 8 * c) = o; }
    LDS_WAIT(); asm volatile("" ::: "memory");
}
DI void conv_weights(const PP p, int layer, LAS unsigned char* lds, const int tid_, const int bid_) {
    const int lane = tid_ & 63, wave = tid_ >> 6;
    LAS float* scr = (LAS float*)(lds + 57344 + wave * 8448);
    const int gw = bid_ * 8 + wave, NGW = gridDim.x * 8;
    const gfloat* Win = p.in(8) + (size_t)layer * D * DIN; const gfloat* Wout = p.in(17) + (size_t)layer * D * D;
    const gfloat* W1 = p.in(18) + (size_t)layer * D * DFF; const gfloat* W2 = p.in(19) + (size_t)layer * DFF * D; const gfloat* Wpw = p.in(14) + (size_t)layer * 256 * 256;
    gbf16* WinT = (gbf16*)(p.ws() + WS_WIN); gbf16* WoutT = (gbf16*)(p.ws() + WS_WOUT); gbf16* W1T = (gbf16*)(p.ws() + WS_W1); gbf16* W2T = (gbf16*)(p.ws() + WS_W2); gbf16* WpwT = (gbf16*)(p.ws() + WS_WPW);
    constexpr int I_IN = 16 * 72, I_OUT = 16 * 32, I_1 = 16 * 128, I_2 = 64 * 32, I_PW = 4 * 8, NIT = I_IN + I_OUT + I_1 + I_2 + I_PW;
    for (int it = gw; it < NIT; it += NGW) {
        int r = it;
        if (r < I_IN) { transpose_item(Win, D, DIN, WinT, scr, r, lane); continue; } r -= I_IN;
        if (r < I_OUT) { transpose_item(Wout, D, D, WoutT, scr, r, lane); continue; } r -= I_OUT;
        if (r < I_1) { transpose_item(W1, D, DFF, W1T, scr, r, lane); continue; } r -= I_1;
        if (r < I_2) { transpose_item(W2, DFF, D, W2T, scr, r, lane); continue; } r -= I_2;
        transpose_item(Wpw, 256, 256, WpwT, scr, r, lane);
    }
    const gfloat* Wf = p.in(9) + (size_t)layer * 256 * 256; gbf16* Wf2t = (gbf16*)(p.ws() + WS_WF2);
    for (int o = bid_ * 512 + tid_; o < 256 * 512; o += gridDim.x * 512) {
        const int n = o >> 9, k = o & 511, cs = k >> 8, g = (k >> 6) & 3, j = k & 63;
        float acc = 0.f;
        for (int jp = 0; jp < 64; ++jp) { const float x = (float)((j * jp) & 63) * (1.f / 32.f); const float t = cs ? sinpif(x) : cospif(x); acc += t * Wf[(size_t)(g * 64 + jp) * 256 + n]; }
        acc *= cs ? -0.125f : 0.125f;
        Wf2t[(size_t)n * 512 + k] = (bf16)(pk2(acc, 0.f) & 0xffffu);
    }
}
DI void phase_norm(const PP p, int layer, int which, int nrows, const int tid_, const int bid_) {
    const int lane = tid_ & 63, wave = tid_ >> 6;
    const int gw = bid_ * 8 + wave, NGW = gridDim.x * 8;
    const bool first = (layer == 0 && which == 0);
    const gfloat* hl = first ? p.in(0) : p.out(); const gfloat* hc = first ? p.in(2) : (const gfloat*)(p.ws() + WS_HCTX);
    const gfloat* g = p.in(which ? 7 : 6) + layer * D;
    const gfloat* mods = (const gfloat*)(p.ws() + WS_MODS) + (size_t)layer * 9 * 6144 + (which ? 3 : 0) * D;
    gbf16* hn = (gbf16*)(p.ws() + WS_HN);
    for (int row = gw; row < nrows; row += NGW) {
        const gfloat* src = row < TL ? hl + (size_t)row * D : hc + (size_t)(row - TL) * D;
        const int midx = row < TL ? (row >> 11) : 8;
        f32x4 v[4]; float ss = 0.f;
#pragma unroll
        for (int jj = 0; jj < 4; ++jj) v[jj] = *(const GAS f32x4*)(src + 4 * (lane + 64 * jj));
        if (!first && row >= TL) {
            const gfloat* sd = (const gfloat*)(p.ws() + WS_SIDE) + (size_t)(row - TL) * D; gfloat* hw = (gfloat*)(p.ws() + WS_HCTX) + (size_t)(row - TL) * D;
#pragma unroll
            for (int jj = 0; jj < 4; ++jj) { const int k = 4 * (lane + 64 * jj);
                v[jj] += (*(const GAS f32x4*)(sd + k) + *(const GAS f32x4*)(sd + 2 * 1024 * 1024 + k)) + *(const GAS f32x4*)(sd + 4 * 1024 * 1024 + k);
                *(GAS f32x4*)(hw + k) = v[jj]; } }
#pragma unroll
        for (int jj = 0; jj < 4; ++jj) ss += (v[jj].x * v[jj].x + v[jj].y * v[jj].y) + (v[jj].z * v[jj].z + v[jj].w * v[jj].w);
        const float rinv = 1.f / sqrtf(wave_sum(ss) * (1.f / D) + 1e-6f);
#pragma unroll
        for (int jj = 0; jj < 4; ++jj) { const int k = 4 * (lane + 64 * jj);
            const f32x4 gg = *(const GAS f32x4*)(g + k), sh = *(const GAS f32x4*)(mods + midx * 6144 + k), sc = *(const GAS f32x4*)(mods + midx * 6144 + D + k);
            const f32x4 y = (v[jj] * rinv * gg) * (sc + 1.f) + sh;
            u32x2 w; w.x = pk2(y.x, y.y); w.y = pk2(y.z, y.w);
            *(GAS u32x2*)(hn + (size_t)row * D + k) = w; }
    }
}
DI void phase_final(const PP p, const int tid_, const int bid_) {
    const int lane = tid_ & 63, wave = tid_ >> 6;
    const int gw = bid_ * 8 + wave, NGW = gridDim.x * 8;
    const gfloat* g = p.in(20);
    for (int row = gw; row < TL; row += NGW) {
        gfloat* src = p.out() + (size_t)row * D;
        f32x4 v[4]; float ss = 0.f;
#pragma unroll
        for (int jj = 0; jj < 4; ++jj) { v[jj] = *(const GAS f32x4*)(src + 4 * (lane + 64 * jj)); ss += (v[jj].x * v[jj].x + v[jj].y * v[jj].y) + (v[jj].z * v[jj].z + v[jj].w * v[jj].w); }
        const float rinv = 1.f / sqrtf(wave_sum(ss) * (1.f / D) + 1e-6f);
#pragma unroll
        for (int jj = 0; jj < 4; ++jj) { const int k = 4 * (lane + 64 * jj); const f32x4 gg = *(const GAS f32x4*)(g + k); *(GAS f32x4*)(src + k) = v[jj] * rinv * gg; }
    }
}
DI void conv_tile(const PP p, int layer, int seqbase, int L, int t0, LAS unsigned char* lds, const int tid_, const int bid_) {
    int tid = tid_; asm volatile("" : "+v"(tid));
    const int lane = tid & 63;
    LAS float* vt = (LAS float*)lds;
    LAS float* red1 = (LAS float*)(lds + 98304);
    LAS float* red2 = (LAS float*)(lds + 98304 + 1024);
    const gbf16* Urm = (const gbf16*)(p.ws() + WS_URM);
    gbf16* cva = (gbf16*)(p.ws() + WS_CVA);
    __syncthreads();
    for (int idx = tid; idx < 94 * 32; idx += 512) { const int tt = idx >> 5, c8 = (idx & 31) * 8, pos = t0 - 15 + tt;
        float v[8];
        if (pos >= 0 && pos < L) { const gbf16* rp = Urm + (size_t)(seqbase + pos) * URM + c8; const bf16x8 a8 = *(const GAS bf16x8*)rp, g8 = *(const GAS bf16x8*)(rp + 256);
#pragma unroll
            for (int e = 0; e < 8; ++e) { const float a = bf2f(a8[e]), gt = bf2f(g8[e]); v[e] = a / (1.f + __expf(-gt)); } }
        else {
#pragma unroll
            for (int e = 0; e < 8; ++e) v[e] = 0.f; }
        *(LAS f32x4*)(vt + tt * 256 + c8) = (f32x4){v[0], v[1], v[2], v[3]}; *(LAS f32x4*)(vt + tt * 256 + c8 + 4) = (f32x4){v[4], v[5], v[6], v[7]}; }
    __syncthreads();
    const int c = tid & 255, th = tid >> 8, wq = (tid >> 6) & 3;
    const gfloat* dw = p.in(10) + (size_t)layer * 31 * 256 + c;
    float w[31];
#pragma unroll
    for (int tap = 0; tap < 31; ++tap) w[tap] = dw[tap * 256];
    const float bias = p.in(11)[layer * 256 + c], lg = p.in(12)[layer * 256 + c], lb = p.in(13)[layer * 256 + c];
    for (int ch = 0; ch < 4; ++ch) {
        const int tb = th * 32 + ch * 8;
        float o[8];
#pragma unroll
        for (int e = 0; e < 8; ++e) { float acc = bias;
#pragma unroll
            for (int tap = 0; tap < 31; ++tap) acc += w[tap] * vt[(tb + e + tap) * 256 + c];
            o[e] = acc; }
#pragma unroll
        for (int e = 0; e < 8; ++e) { const float s1 = wave_sum(o[e]); if (lane == 0) red1[(tb + e) * 4 + wq] = s1; }
        __syncthreads();
#pragma unroll
        for (int e = 0; e < 8; ++e) { const LAS float* r = red1 + (tb + e) * 4; const float mean = ((r[0] + r[1]) + (r[2] + r[3])) * (1.f / 256.f); o[e] -= mean;
            const float s2 = wave_sum(o[e] * o[e]); if (lane == 0) red2[(tb + e) * 4 + wq] = s2; }
        __syncthreads();
#pragma unroll
        for (int e = 0; e < 8; ++e) { const LAS float* r = red2 + (tb + e) * 4; const float var = ((r[0] + r[1]) + (r[2] + r[3])) * (1.f / 256.f);
            const float y = o[e] / sqrtf(var + 1e-5f) * lg + lb; const float z = y / (1.f + __expf(-y));
            cva[(size_t)(seqbase + t0 + tb + e) * 256 + c] = (bf16)(pk2(z, 0.f) & 0xffffu); }
    }
}
#define MFMA32(a, b, c) __builtin_amdgcn_mfma_f32_32x32x16_bf16((a), (b), (c), 0, 0, 0)
DI void attn_load(const gchar* KtB, const gchar* VtB, int tile, int b, int h, int rs, int lane, bf16x8 (&kf)[4], bf16x8 (&vf)[2][2]) {
    const int tileg = tile >= 8 ? (b * 64 + rs * 2 + (tile - 8)) : (TL / 32 + b * 8 + tile);
    const unsigned off = (unsigned)((tileg * 8 + h) * 2048 + lane * 8) * 2u;
#pragma unroll
    for (int ks = 0; ks < 4; ++ks) kf[ks] = *(const GAS bf16x8*)(KtB + off + ks * 1024);
#pragma unroll
    for (int dt = 0; dt < 2; ++dt)
#pragma unroll
        for (int t = 0; t < 2; ++t) vf[dt][t] = *(const GAS bf16x8*)(VtB + off + (dt * 2 + t) * 1024);
}
template <int MODE, int KT> DI void attn_compute(const bf16x8 (&kf)[4], const bf16x8 (&vf)[2][2], const LAS bf16x8* ql_, f32x16 (&o)[2][2], float (&m)[2], float (&ls)[2],
                                                 const LAS float* bl, int kr, int ql, int half) {
    const float SCL = 0.125f * 1.4426950408889634f, NINF = -__builtin_inff();
#pragma unroll
    for (int qt = 0; qt < 2; ++qt) {
        constexpr int dummy = 0; (void)dummy;
        const int VLO = (MODE == 1 && qt != KT) ? (qt == 0 ? 0 : 12) : 0, VHI = (MODE == 1 && qt != KT) ? (qt == 0 ? 4 : 16) : 16;
        f32x16 sv;
#pragma unroll
        for (int v = 0; v < 16; ++v) sv[v] = 0.f;
#pragma unroll
        for (int ks = 0; ks < 4; ++ks) sv = MFMA32(kf[ks], ql_[(qt * 4 + ks) * 64], sv);
        float mx = NINF;
        if (MODE == 1) {
            const int qc = qt * 32 + ql, cs = min(max(qc - 8, 0), 48);
            const int kc0 = KT * 32 + 4 * half;
            const int d0 = kc0 - cs;
            const volatile LAS float* bp = (const volatile LAS float*)bl + (kr * 31 + kc0 - qc + 15 + 48);
            float bias[16];
#pragma unroll
            for (int v = 0; v < 16; ++v) if (v >= VLO && v < VHI) bias[v] = bp[(v & 3) + 8 * (v >> 2)];
#pragma unroll
            for (int v = 0; v < 16; ++v) if (v >= VLO && v < VHI) { const int dv = (v & 3) + 8 * (v >> 2); const bool valid = (unsigned)(d0 + dv) < 16u;
                const float x = valid ? sv[v] * SCL + bias[v] : NINF; sv[v] = x; mx = fmaxf(mx, x); }
        } else {
#pragma unroll
            for (int v = 0; v < 16; ++v) { const float x = sv[v] * SCL; sv[v] = x; mx = fmaxf(mx, x); }
        }
        mx = fmaxf(mx, __shfl_xor(mx, 32));
        const float mn = fmaxf(m[qt], mx), alpha = __builtin_amdgcn_exp2f(m[qt] - mn);
        const bool grew = mn > m[qt]; m[qt] = mn;
        float sum = 0.f;
#pragma unroll
        for (int v = 0; v < 16; ++v) if (v >= VLO && v < VHI) { const float pv = __builtin_amdgcn_exp2f(sv[v] - mn); sv[v] = pv; sum += pv; }
        ls[qt] = ls[qt] * alpha + sum;
        if (__builtin_amdgcn_ballot_w64(grew) != 0ull) {
#pragma unroll
            for (int dt = 0; dt < 2; ++dt)
#pragma unroll
                for (int v = 0; v < 16; ++v) o[dt][qt][v] *= alpha;
        }
#pragma unroll
        for (int t = 0; t < 2; ++t) {
            if (8 * t + 8 <= VLO || 8 * t >= VHI) continue;
            u32x4 pw;
            pw.x = (8 * t + 0 >= VLO && 8 * t + 0 < VHI) ? pk2(sv[8 * t + 0], sv[8 * t + 1]) : 0u; pw.y = (8 * t + 2 >= VLO && 8 * t + 2 < VHI) ? pk2(sv[8 * t + 2], sv[8 * t + 3]) : 0u;
            pw.z = (8 * t + 4 >= VLO && 8 * t + 4 < VHI) ? pk2(sv[8 * t + 4], sv[8 * t + 5]) : 0u; pw.w = (8 * t + 6 >= VLO && 8 * t + 6 < VHI) ? pk2(sv[8 * t + 6], sv[8 * t + 7]) : 0u;
            const bf16x8 pf = __builtin_bit_cast(bf16x8, pw);
#pragma unroll
            for (int dt = 0; dt < 2; ++dt) o[dt][qt] = MFMA32(vf[dt][t], pf, o[dt][qt]); }
    }
}
DI void attn_item(const PP p, int layer, int b, int qbase, int nloc, int r, LAS unsigned char* lds, const int tid_, const int bid_) {
    int tid = tid_; asm volatile("" : "+v"(tid));
    const int lane = tid & 63, h = __builtin_amdgcn_readfirstlane(tid >> 6), ql = lane & 31, half = lane >> 5;
    const gchar* UrmB = (const gchar*)(p.ws() + WS_URM); const gchar* KtB = (const gchar*)(p.ws() + WS_KT); const gchar* VtB = (const gchar*)(p.ws() + WS_VT);
    LAS float* bl = (LAS float*)(lds + h * 9728);
    LAS bf16x8* qlds = (LAS bf16x8*)(lds + h * 9728 + 1536) + lane;
    const int rs = min(max(r - 4, 0), 24);
    const float LOG2E = 1.4426950408889634f, NINF = -__builtin_inff();
    __syncthreads();
    if (nloc) { const gfloat* rp = p.in(16) + (size_t)(layer * 8 + h) * 465;
        for (int i = lane; i < 248; i += 64) { const int kr = i / 31, co = i - kr * 31; bl[48 + i] = rp[(rs - r + 7 + kr) * 31 + co] * LOG2E; } }
    __syncthreads();
#pragma unroll
    for (int qt = 0; qt < 2; ++qt) { const unsigned qoff = (unsigned)((qbase + qt * 32 + ql) * URM + 512 + h * 64 + 32 * half) * 2u;
#pragma unroll
        for (int ks = 0; ks < 4; ++ks) qlds[(qt * 4 + ks) * 64] = *(const GAS bf16x8*)(UrmB + qoff + 16 * ks); }
    f32x16 o[2][2];
#pragma unroll
    for (int a = 0; a < 2; ++a)
#pragma unroll
        for (int c = 0; c < 2; ++c)
#pragma unroll
            for (int v = 0; v < 16; ++v) o[a][c][v] = 0.f;
    float m[2] = {NINF, NINF}, ls[2] = {0.f, 0.f};
    const int ntiles = 8 + nloc;
    bf16x8 kf[4], vf[2][2], kn[4], vn[2][2];
#define ATT_ROT() do { _Pragma("unroll") for (int ks = 0; ks < 4; ++ks) kf[ks] = kn[ks]; _Pragma("unroll") for (int dt = 0; dt < 2; ++dt) _Pragma("unroll") for (int t = 0; t < 2; ++t) vf[dt][t] = vn[dt][t]; } while (0)
    attn_load(KtB, VtB, 0, b, h, rs, lane, kf, vf);
#pragma unroll 1
    for (int tile = 0; tile < 8; ++tile) {
        asm volatile("" ::: "memory");
        attn_load(KtB, VtB, tile + 1 < ntiles ? tile + 1 : tile, b, h, rs, lane, kn, vn);
        attn_compute<0, 0>(kf, vf, qlds, o, m, ls, bl, 0, ql, half);
        ATT_ROT();
    }
#pragma unroll 1
    for (int kr = 0; kr < (nloc >> 1); ++kr) {
        asm volatile("" ::: "memory");
        attn_load(KtB, VtB, 9 + 2 * kr, b, h, rs, lane, kn, vn);
        attn_compute<1, 0>(kf, vf, qlds, o, m, ls, bl, kr, ql, half);
        ATT_ROT();
        asm volatile("" ::: "memory");
        attn_load(KtB, VtB, 10 + 2 * kr < ntiles ? 10 + 2 * kr : 9 + 2 * kr, b, h, rs, lane, kn, vn);
        attn_compute<1, 1>(kf, vf, qlds, o, m, ls, bl, kr, ql, half);
        ATT_ROT();
    }
#undef ATT_ROT
    int tid2 = tid_; asm volatile("" : "+v"(tid2));
    const int ql2 = tid2 & 31, half2 = (tid2 >> 5) & 1; gbf16* mixo = (gbf16*)(p.ws() + WS_MIX);
#pragma unroll
    for (int qt = 0; qt < 2; ++qt) { const float lt_ = ls[qt] + __shfl_xor(ls[qt], 32); const float inv = 1.f / lt_; const int token = qbase + qt * 32 + ql2;
#pragma unroll
        for (int dt = 0; dt < 2; ++dt)
#pragma unroll
            for (int i = 0; i < 4; ++i) { const int d = dt * 32 + 8 * i + 4 * half2; u32x2 w; w.x = pk2(o[dt][qt][4 * i] * inv, o[dt][qt][4 * i + 1] * inv); w.y = pk2(o[dt][qt][4 * i + 2] * inv, o[dt][qt][4 * i + 3] * inv);
                *(GAS u32x2*)((gchar*)mixo + (unsigned)(token * D + 512 + h * 64 + d) * 2u) = w; } }
}
DI void run_phase(const PP p, int ph, LAS unsigned char* lds, const int tid, const int c, const int skip = 0) {
    const int G = gridDim.x;
    if (ph == 0) { phase_mods(p, lds, tid, c); make_tables(p, tid, c); conv_weights(p, 0, lds, tid, c); return; }
    if (ph == NPH - 1) { phase_final(p, tid, c); return; }
    const int layer = (ph - 1) >> 3, sub = (ph - 1) & 7;
    const int M = layer == 0 ? TA : TL;
    if (sub == 0) { if (layer == 1) conv_weights(p, 1, lds, tid, c); phase_norm(p, layer, 0, TA, tid, c); return; }
    if (sub == 5) { phase_norm(p, layer, 1, M, tid, c); return; }
    const int H = G / 2 > 0 ? G / 2 : 1;
#pragma unroll 1
    for (int j = 0; j < 2; ++j) {
        unsigned char* ws = p.ws();
        const gbf16* A = nullptr; const gbf16* Bt = nullptr; int K = 0, nM = 0, nN = 0, cc = c, pmadd = 0, mode = 0, pmbase = 0, ksplit = 1; bool valid = true;
        if (sub == 1) {
            if (j == 0) { A = (const gbf16*)(ws + WS_HN); Bt = (const gbf16*)(ws + WS_WIN) + (size_t)256 * D; K = D; nM = TA / 256; nN = 6; mode = M_URM; }
            else { A = (const gbf16*)(ws + WS_WIN); Bt = (const gbf16*)(ws + WS_HN); K = D; nM = 3; nN = TA / 256; cc = (c + (G - (432 % G))) % G; pmadd = 6; mode = M_SWAP; }
        } else if (sub == 2) {
            if (j == 0) { A = (const gbf16*)(ws + WS_DFTL); Bt = (const gbf16*)(ws + WS_UTL); K = SEQ; nM = 16; nN = 8; mode = M_DFTL; }
            else { A = (const gbf16*)(ws + WS_DFTC); Bt = (const gbf16*)(ws + WS_UTC); K = CTX; nM = 2; nN = 8; cc = (c + H) % G; mode = M_DFTC; valid = (layer == 0); }
        } else if (sub == 3) {
            if (j == 0) { A = (const gbf16*)(ws + WS_G12); Bt = (const gbf16*)(ws + WS_WF2); K = 512; nM = M / 256; nN = 1; mode = M_MIXF; }
            else { A = (const gbf16*)(ws + WS_CVA); Bt = (const gbf16*)(ws + WS_WPW); K = 256; nM = M / 256; nN = 1; cc = (c + G - ((M / 256) % G)) % G; mode = M_MIXC; }
        } else if (sub == 4) { A = (const gbf16*)(ws + WS_MIX); Bt = (const gbf16*)(ws + WS_WOUT); K = D; nN = 4;
            if (j == 0) { nM = TL / 256; mode = M_RES1; } else { nM = TC / 256; pmbase = TL / 256; ksplit = 4; mode = M_RES1K; valid = (layer == 0); }
        }
        else if (sub == 6) { A = (const gbf16*)(ws + WS_HN); Bt = (const gbf16*)(ws + WS_W1); K = D; nM = M / 256; nN = 16; mode = M_HID; valid = (j == 0); }
        else { A = (const gbf16*)(ws + WS_HID); Bt = (const gbf16*)(ws + WS_W2); K = DFF; nN = 4;
            if (j == 0) { nM = TL / 256; mode = M_RES2; } else { nM = TC / 256; pmbase = TL / 256; ksplit = 4; mode = M_RES2K; valid = (layer == 0); }
        }
        if (valid && !(skip & 1)) { Sched S; S.init(nM, nN, G, cc); S.pmadd = pmadd; S.pmbase = pmbase; S.ksplit = ksplit; S.kbytes = (K / ksplit) * 2; int tj = tid; asm volatile("" : "+v"(tj)); run_gemm(lds, A, Bt, K, ksplit > 1 ? K / ksplit : 0, S, mode, layer, p, tj); }
    }
    if (sub == 2) {
        const int natt = (skip & 4) ? 0 : (layer == 0 ? 288 : 256), nconv = (skip & 2) ? 0 : (layer == 0 ? 288 : 256);
        unsigned* ctr = (unsigned*)(p.ws() + WS_CTL) + 64 * layer + 16 * (skip != 0);
        LAS int* slot = (LAS int*)(lds + LDSP_OFF + 512);
#pragma unroll 1
        for (;;) {
            __syncthreads();
            if (tid == 0) *slot = (int)__hip_atomic_fetch_add(ctr, 1u, __ATOMIC_RELAXED, __HIP_MEMORY_SCOPE_AGENT);
            __syncthreads();
            const int it = __builtin_amdgcn_readfirstlane(*slot);
            if (it >= natt + nconv) break;
            if (it < natt) {
                if (it < 256) attn_item(p, layer, it >> 5, (it >> 5) * SEQ + (it & 31) * 64, 16, it & 31, lds, tid, c);
                else { const int i2 = it - 256; attn_item(p, layer, i2 >> 2, TL + (i2 >> 2) * CTX + (i2 & 3) * 64, 0, 0, lds, tid, c); }
            } else {
                const int ic = it - natt; const bool lat = ic < 256; const int i2 = ic - 256;
                conv_tile(p, layer, lat ? (ic >> 5) * SEQ : TL + (i2 >> 2) * CTX, lat ? SEQ : CTX, lat ? (ic & 31) * 64 : (i2 & 3) * 64, lds, tid, c);
            }
        }
    }
}

__global__ void __launch_bounds__(512, 2) fwd_kernel(Params prm) {
    extern __shared__ __attribute__((aligned(16))) unsigned char lds_raw[];
    LAS unsigned char* lds = (LAS unsigned char*)lds_raw;
    {
        const unsigned long long* ka = (const unsigned long long*)__builtin_amdgcn_kernarg_segment_ptr();
        if (threadIdx.x < 23) ((LAS unsigned long long*)(lds + LDSP_OFF))[threadIdx.x] = ka[threadIdx.x];
    }
    __syncthreads();
    PP p; p.P = (const LAS unsigned long long*)(lds + LDSP_OFF);
    if (threadIdx.x < 2) ((LAS unsigned*)(lds + LDSP_OFF + 1024))[threadIdx.x] = 0u;
    __syncthreads();
    const XcdBarrier xbar = xcd_barrier_post((unsigned*)(prm.ws + WS_CTL) + 4096, (volatile LAS unsigned*)(lds + LDSP_OFF + 1024));
    const int lo = prm.ph_lo, hi = prm.ph_hi;
    const int wave_s = __builtin_amdgcn_readfirstlane((int)threadIdx.x >> 6);
#pragma unroll 1
    for (int ph = lo; ph < hi; ++ph) {
        if (ph > lo) { if (ph == lo + 1) cg::this_grid().sync(); else xcd_barrier(xbar); }
        int lane_; asm volatile("v_mbcnt_lo_u32_b32 %0, -1, 0\n\tv_mbcnt_hi_u32_b32 %0, -1, %0" : "=v"(lane_));
        int tid = wave_s * 64 + lane_, bid = blockIdx.x;
        asm volatile("" : "+s"(bid));
        run_phase(p, ph, lds, tid, bid);
        __syncthreads();
#ifdef PROBE_REPEAT
        if ((PROBE_REPEAT >> ph) & 1) { xcd_barrier(xbar); run_phase(p, ph, lds, tid, bid, PROBE_SKIP); __syncthreads(); }
#endif
    }
}

extern "C" void kernel_launch(void* const* d_in, const int* in_sizes, int n_in, void* d_out, int out_size, void* d_ws, size_t ws_size, hipStream_t stream) {
    static int grid = 0;
    if (grid == 0) {
        if (n_in != 21 || ws_size < WS_SIDE + 24 * MiB) { fprintf(stderr, "kernel_launch: unexpected n_in %d / ws_size %zu\n", n_in, ws_size); grid = -1; return; }
        int dev = 0, cus = 0, per_cu = 0;
        (void)hipGetDevice(&dev); (void)hipDeviceGetAttribute(&cus, hipDeviceAttributeMultiprocessorCount, dev);
        (void)hipFuncSetAttribute((const void*)fwd_kernel, hipFuncAttributeMaxDynamicSharedMemorySize, LDS_BYTES);
        (void)hipOccupancyMaxActiveBlocksPerMultiprocessor(&per_cu, (const void*)fwd_kernel, 512, LDS_BYTES);
        if (per_cu < 1) { fprintf(stderr, "kernel_launch: occupancy query says %d blocks/CU\n", per_cu); per_cu = 1; }
        (void)hipGetLastError();
        grid = cus > 0 ? cus : 256;
    }
    if (grid < 0) return;
    (void)hipMemsetAsync((char*)d_ws + WS_CTL, 0, 65536, stream);
    Params p{};
    for (int i = 0; i < 21; ++i) p.in[i] = (const float*)d_in[i];
    p.out = (float*)d_out; p.ws = (unsigned char*)d_ws;
#if SINGLE_LAUNCH
    p.ph_lo = 0; p.ph_hi = NPH;
    void* args[] = {&p};
    hipError_t e = hipLaunchCooperativeKernel((const void*)fwd_kernel, dim3(grid), dim3(512), args, LDS_BYTES, stream);
    if (e != hipSuccess) fprintf(stderr, "cooperative launch failed: %s (grid %d)\n", hipGetErrorString(e), grid);
#else
    for (int ph = 0; ph < NPH; ++ph) { p.ph_lo = ph; p.ph_hi = ph + 1; hipLaunchKernelGGL(fwd_kernel, dim3(grid), dim3(512), LDS_BYTES, stream, p); }
#endif
}
```

```cpp
#include <hip/hip_runtime.h>
#include <hip/hip_cooperative_groups.h>
#include <cstdio>
#include <cstdint>
namespace cg = cooperative_groups;
namespace pg8 {
#define PG8_LAS __attribute__((address_space(3)))
typedef unsigned short bf16_t;
typedef short bf16x8 __attribute__((ext_vector_type(8)));
typedef float f32x4 __attribute__((ext_vector_type(4)));
typedef unsigned u32x4 __attribute__((ext_vector_type(4)));
constexpr int BM = 256, BK = 64, HALF = 128, HTB = HALF * BK * 2  , STAGE_BYTES = 8 * HTB, NXCD = 8, WGM = 8;

__host__ __device__ __forceinline__ int lds_byte(int r, int c) { const int st = (r >> 4) * 2 + (c >> 5), rr = r & 15, cc = c & 31, ob = rr * 64 + cc * 2; return st * 1024 + (ob ^ (((ob >> 9) & 1) << 5)); }
__host__ __device__ __forceinline__ void stage_rc(int b, int& R, int& C) { const int st = b / 1024, sb = b % 1024, swz = sb ^ (((sb >> 9) & 1) << 5); R = (st >> 1) * 16 + swz / 64; C = (st & 1) * 32 + (swz % 64) / 2; }
__host__ __device__ __forceinline__ int perm32(int rho) { const int n = rho >> 4, i = rho & 15; return 8 * (i >> 2) + 4 * n + (i & 3); }

struct Unit { int pm, pn, ko; };
struct Gemm { const bf16_t* A; const bf16_t* Bt; int M, N, K; };

struct StaticOrder {
    int nM, nN, nwg, G, c;
    __host__ __device__ void init(int M, int N, int G_, int c_) { nM = M / BM; nN = N / BM; nwg = nM * nN; G = G_; c = c_; }
    __host__ __device__ bool next(int i, Unit& u) const {
        const long L = (long)i * G + c; if (L >= nwg) return false;
        int wgid = (int)L; { const int q = nwg / NXCD, r = nwg % NXCD, xcd = wgid % NXCD, off = wgid / NXCD; wgid = (xcd < r ? xcd * (q + 1) : r * (q + 1) + (xcd - r) * q) + off; }
        const int nig = WGM * nN, gid = wgid / nig, fm = gid * WGM, gsz = (nM - fm) < WGM ? (nM - fm) : WGM;
        u.pm = fm + ((wgid % nig) % gsz); u.pn = (wgid % nig) / gsz; u.ko = 0; return true;
    }
    __device__ __forceinline__ void a_ready(const Unit&) const {}
    __device__ __forceinline__ void done(const Unit&) const {}
};

template <class Epi, class Sched, bool ALIGN_EPI = false, bool SP2 = false>
__device__ __forceinline__ void gemm_phase(PG8_LAS unsigned char* lds, const Gemm g, const Sched& S, const Epi& E, const int tid_in) {
    const int tid = tid_in, wid = __builtin_amdgcn_readfirstlane(tid >> 6), lane = tid & 63, wr = wid >> 2, wc = wid & 3, fr = lane & 15, fq = lane >> 4;
    const int K = g.K, nt = (g.M ? g.M : K) / BK;
    unsigned voffA[2], voffB[2];
#pragma unroll
    for (int i = 0; i < 2; ++i) { int R, C; stage_rc(tid * 16 + i * 8192, R, C); const int Rb = Epi::PERM ? ((R & ~31) + perm32(R & 31)) : R;
        voffA[i] = (unsigned)(R * K + C) * 2u; voffB[i] = (unsigned)(Rb * K + C) * 2u; }
    const size_t kstep = (size_t)(BK * 2);
    const size_t hstep = (size_t)HALF * K * 2;
    const size_t tstep = 2 * hstep;
    const unsigned ldsw = (unsigned)wid * 1024u;
    const int aoff = lds_byte(wr * 64 + fr, fq * 8), boff = lds_byte(wc * 32 + fr, fq * 8);
#define PG8_SA(b, h) (((b) * 2 + (h)) * HTB)
#define PG8_SB(b, h) ((4 + (b) * 2 + (h)) * HTB)
#define PG8_STAGE(bufoff, gbase, voff) do { _Pragma("unroll") for (int _i = 0; _i < 2; ++_i) \
        __builtin_amdgcn_global_load_lds((const unsigned*)((const char*)(gbase) + (voff)[_i]), (PG8_LAS unsigned*)(lds + (bufoff) + ldsw + _i * 8192), 16, 0, 0); } while (0)
#define PG8_LDA(dst, b, h) do { _Pragma("unroll") for (int m = 0; m < 4; ++m) _Pragma("unroll") for (int k = 0; k < 2; ++k) dst[m][k] = *(const PG8_LAS bf16x8*)(lds + PG8_SA(b, h) + aoff + m * 2048 + k * 1024); } while (0)
#define PG8_LDB(dst, b, h) do { _Pragma("unroll") for (int n = 0; n < 2; ++n) _Pragma("unroll") for (int k = 0; k < 2; ++k) dst[n][k] = *(const PG8_LAS bf16x8*)(lds + PG8_SB(b, h) + boff + n * 2048 + k * 1024); } while (0)
#define PG8_MMA(ai, bj, At, Bt) do { __builtin_amdgcn_s_setprio(1); _Pragma("unroll") for (int m = 0; m < 4; ++m) _Pragma("unroll") for (int n = 0; n < 2; ++n) _Pragma("unroll") for (int k = 0; k < 2; ++k) \
        acc[ai][bj][m][n] = __builtin_amdgcn_mfma_f32_16x16x32_bf16(Bt[n][k], At[m][k], acc[ai][bj][m][n], 0, 0, 0); __builtin_amdgcn_s_setprio(0); } while (0)
#define PG8_WAIT_V(n) asm volatile("s_waitcnt vmcnt(" #n ")" ::: "memory")
#define PG8_WAIT_L(n) asm volatile("s_waitcnt lgkmcnt(" #n ")" ::: "memory")
#define PG8_BAR __builtin_amdgcn_s_barrier()
#define PG8_SCHED __builtin_amdgcn_sched_barrier(0)
    Unit cur, nxt; int ui = 0;
    if (!S.next(0, cur)) return;
    f32x4 acc[2][2][4][2];
#pragma unroll
    for (int a = 0; a < 2; ++a)
#pragma unroll
        for (int b = 0; b < 2; ++b)
#pragma unroll
            for (int m = 0; m < 4; ++m)
#pragma unroll
                for (int n = 0; n < 2; ++n) acc[a][b][m][n] = (f32x4){0.f, 0.f, 0.f, 0.f};
    bf16x8 At[4][2], B0[2][2], B1[2][2];
    const char* cA = (const char*)g.A + (size_t)cur.pm * tstep + cur.ko; const char* cB = (const char*)g.Bt + (size_t)cur.pn * tstep + cur.ko;
    S.a_ready(cur);
    if constexpr (SP2) {
        PG8_STAGE(PG8_SB(0, 0), cB, voffB); PG8_STAGE(PG8_SB(0, 1), cB + hstep, voffB); PG8_STAGE(PG8_SA(0, 0), cA, voffA); PG8_STAGE(PG8_SA(0, 1), cA + hstep, voffA);
        if (wr == 1) PG8_BAR;
        PG8_WAIT_V(2); PG8_BAR;
        PG8_STAGE(PG8_SB(1, 0), cB + kstep, voffB); PG8_STAGE(PG8_SA(1, 0), cA + kstep, voffA); PG8_STAGE(PG8_SB(1, 1), cB + hstep + kstep, voffB);
        PG8_WAIT_V(6); PG8_BAR;
    } else {
        PG8_STAGE(PG8_SB(0, 0), cB, voffB); PG8_STAGE(PG8_SA(0, 0), cA, voffA); PG8_STAGE(PG8_SB(0, 1), cB + hstep, voffB); PG8_STAGE(PG8_SA(0, 1), cA + hstep, voffA);
        if (wr == 1) PG8_BAR;
        PG8_WAIT_V(4); PG8_BAR;
        PG8_STAGE(PG8_SB(1, 0), cB + kstep, voffB); PG8_STAGE(PG8_SA(1, 0), cA + kstep, voffA); PG8_STAGE(PG8_SB(1, 1), cB + hstep + kstep, voffB);
        PG8_WAIT_V(6); PG8_BAR;
    }
    for (;;) {
        const bool has_next = S.next(ui + 1, nxt);
        const char* nA = has_next ? (const char*)g.A + (size_t)nxt.pm * tstep + nxt.ko : cA; const char* nB = has_next ? (const char*)g.Bt + (size_t)nxt.pn * tstep + nxt.ko : cB;
        for (int t = 0; t < nt; t += 2) {
            const bool last = (t == nt - 2);
            const char* a1 = cA + (size_t)(t + 1) * kstep;
            const char* a2 = last ? nA : cA + (size_t)(t + 2) * kstep; const char* b2 = last ? nB : cB + (size_t)(t + 2) * kstep;
            const char* a3 = a2 + kstep; const char* b3 = b2 + kstep;
            if (last && has_next) S.a_ready(nxt);
            if constexpr (SP2) {
            PG8_LDB(B0, 0, 0); PG8_LDB(B1, 0, 1); PG8_SCHED; PG8_LDA(At, 0, 0); PG8_STAGE(PG8_SA(1, 1), a1 + hstep, voffA);
            PG8_WAIT_V(8); PG8_WAIT_L(0); PG8_BAR; PG8_MMA(0, 0, At, B0); PG8_MMA(0, 1, At, B1); PG8_BAR; PG8_SCHED;
            PG8_LDA(At, 0, 1); PG8_STAGE(PG8_SB(0, 0), b2, voffB); PG8_STAGE(PG8_SB(0, 1), b2 + hstep, voffB); PG8_STAGE(PG8_SA(0, 0), a2, voffA);
            PG8_WAIT_V(8); PG8_WAIT_L(0); PG8_BAR; PG8_MMA(1, 0, At, B0); PG8_MMA(1, 1, At, B1); PG8_BAR; PG8_SCHED;
            PG8_LDB(B0, 1, 0); PG8_LDB(B1, 1, 1); PG8_SCHED; PG8_LDA(At, 1, 0); PG8_STAGE(PG8_SA(0, 1), a2 + hstep, voffA);
            PG8_WAIT_V(8); PG8_WAIT_L(0); PG8_BAR; PG8_MMA(0, 0, At, B0); PG8_MMA(0, 1, At, B1); PG8_BAR; PG8_SCHED;
            PG8_LDA(At, 1, 1); PG8_STAGE(PG8_SB(1, 0), b3, voffB); PG8_STAGE(PG8_SB(1, 1), b3 + hstep, voffB); PG8_STAGE(PG8_SA(1, 0), a3, voffA);
            PG8_WAIT_V(8); PG8_WAIT_L(0); PG8_BAR; PG8_MMA(1, 0, At, B0); PG8_MMA(1, 1, At, B1); PG8_BAR; PG8_SCHED;
            } else {
            PG8_LDB(B0, 0, 0); PG8_SCHED; PG8_LDA(At, 0, 0); PG8_STAGE(PG8_SA(1, 1), a1 + hstep, voffA);
            PG8_WAIT_L(8); PG8_BAR; PG8_WAIT_L(0); PG8_MMA(0, 0, At, B0); PG8_BAR; PG8_SCHED;
            PG8_LDB(B1, 0, 1); PG8_STAGE(PG8_SB(0, 0), b2, voffB);
            PG8_BAR; PG8_WAIT_L(0); PG8_MMA(0, 1, At, B1); PG8_BAR;
            PG8_LDA(At, 0, 1); PG8_STAGE(PG8_SA(0, 0), a2, voffA);
            PG8_BAR; PG8_WAIT_L(0); PG8_MMA(1, 0, At, B0); PG8_BAR; PG8_SCHED;
            PG8_STAGE(PG8_SB(0, 1), b2 + hstep, voffB);
            PG8_WAIT_V(6); PG8_BAR; PG8_MMA(1, 1, At, B1); PG8_BAR;
            PG8_LDB(B0, 1, 0); PG8_SCHED; PG8_LDA(At, 1, 0); PG8_STAGE(PG8_SA(0, 1), a2 + hstep, voffA);
            PG8_WAIT_L(8); PG8_BAR; PG8_WAIT_L(0); PG8_MMA(0, 0, At, B0); PG8_BAR; PG8_SCHED;
            PG8_LDB(B1, 1, 1); PG8_STAGE(PG8_SB(1, 0), b3, voffB);
            PG8_BAR; PG8_WAIT_L(0); PG8_MMA(0, 1, At, B1); PG8_BAR;
            PG8_LDA(At, 1, 1); PG8_STAGE(PG8_SA(1, 0), a3, voffA);
            PG8_BAR; PG8_WAIT_L(0); PG8_MMA(1, 0, At, B0); PG8_BAR; PG8_SCHED;
            PG8_STAGE(PG8_SB(1, 1), b3 + hstep, voffB);
            PG8_WAIT_V(6); PG8_BAR; PG8_MMA(1, 1, At, B1); PG8_BAR;
            }
        }
        if constexpr (ALIGN_EPI) { if (wr == 0) PG8_BAR; }
        if constexpr (!Epi::AFTER_DRAIN) { E(acc, cur, wr, wc, fr, fq); S.done(cur); }
        if (!has_next) break;
#pragma unroll
        for (int a = 0; a < 2; ++a)
#pragma unroll
            for (int b = 0; b < 2; ++b)
#pragma unroll
                for (int m = 0; m < 4; ++m)
#pragma unroll
                    for (int n = 0; n < 2; ++n) acc[a][b][m][n] = (f32x4){0.f, 0.f, 0.f, 0.f};
        cur = nxt; cA = nA; cB = nB; ++ui;
        if constexpr (ALIGN_EPI) { if (wr == 1) PG8_BAR; }
    }
    PG8_WAIT_V(0);
    if constexpr (!ALIGN_EPI) { if (wr == 0) PG8_BAR; }
    PG8_BAR;
    if constexpr (Epi::AFTER_DRAIN) { E.fused(acc, cur, wr, wc, fr, fq, lds, wid, lane); S.done(cur); }
#undef PG8_SA
#undef PG8_SB
#undef PG8_STAGE
#undef PG8_LDA
#undef PG8_LDB
#undef PG8_MMA
#undef PG8_WAIT_V
#undef PG8_WAIT_L
#undef PG8_BAR
#undef PG8_SCHED
}
}

#define LAS __attribute__((address_space(3)))
#define DI __device__ __forceinline__
typedef unsigned short bf16;
typedef short bf16x8 __attribute__((ext_vector_type(8)));
typedef short s16x4 __attribute__((ext_vector_type(4)));
typedef float f32x4 __attribute__((ext_vector_type(4)));
typedef float f32x16 __attribute__((ext_vector_type(16)));
typedef unsigned u32x4 __attribute__((ext_vector_type(4)));
typedef unsigned u32x2 __attribute__((ext_vector_type(2)));
typedef __bf16 bf16x2_t __attribute__((ext_vector_type(2)));
typedef float f32x2_t __attribute__((ext_vector_type(2)));
#define GAS __attribute__((address_space(1)))
typedef GAS float gfloat; typedef GAS unsigned short gbf16; typedef GAS char gchar; typedef GAS unsigned char guchar;

#ifndef SINGLE_LAUNCH
#define SINGLE_LAUNCH 1
#endif

constexpr int D = 1024, NB = 8, SEQ = 2048, CTX = 256, TL = NB * SEQ, TC = NB * CTX, TA = TL + TC;
constexpr int DIN = 2304, DFF = 4096, URM = 1024;
constexpr int NPH = 18;
constexpr int LDS_BYTES = 147456;
constexpr size_t MiB = 1u << 20;
constexpr size_t WS_CTL = 0, WS_MODS = 1 * MiB;
constexpr size_t WS_WIN = 2 * MiB, WS_WOUT = WS_WIN + (size_t)DIN * D * 2, WS_W1 = WS_WOUT + 2 * MiB, WS_W2 = WS_W1 + 8 * MiB, WS_WPW = WS_W2 + 8 * MiB, WS_WF2 = WS_WPW + 128 * 1024;
constexpr size_t WS_DFTL = 25 * MiB, WS_DFTC = 41 * MiB, WS_HCTX = 42 * MiB, WS_HN = 50 * MiB, WS_OV = 86 * MiB;
constexpr size_t WS_URM = WS_OV, WS_UTL = WS_OV + 36 * MiB, WS_UTC = WS_UTL + 8 * MiB, WS_KT = WS_UTC + 1 * MiB, WS_VT = WS_KT + 18 * MiB,
                 WS_G12 = WS_VT + 18 * MiB, WS_CVA = WS_G12 + 18 * MiB, WS_MIX = WS_CVA + 9 * MiB, WS_HID = WS_OV, WS_END = WS_OV + 144 * MiB;
constexpr size_t WS_SIDE = WS_END;
static_assert(WS_SIDE + 24 * MiB <= 256 * MiB, "side buffers");
static_assert(WS_WF2 + 256 * 1024 <= WS_DFTL && WS_MIX + 36 * MiB == WS_END && WS_END <= 256 * MiB, "ws map");

struct Params { const float* in[21]; float* out; unsigned char* ws; int ph_lo, ph_hi; };
constexpr int LDSP_OFF = 131072;
struct PP {
    const __attribute__((address_space(3))) unsigned long long* P;
    __device__ __forceinline__ unsigned long long ld(int i) const { const unsigned long long v = P[i]; const unsigned lo = __builtin_amdgcn_readfirstlane((unsigned)v), hi = __builtin_amdgcn_readfirstlane((unsigned)(v >> 32)); return ((unsigned long long)hi << 32) | lo; }
    __device__ __forceinline__ const gfloat* in(int i) const { return (const gfloat*)ld(i); }
    __device__ __forceinline__ gfloat* out() const { return (gfloat*)ld(21); }
    __device__ __forceinline__ unsigned char* ws() const { return (unsigned char*)ld(22); }
};

DI unsigned pk2(float lo, float hi) { f32x2_t v = {lo, hi}; bf16x2_t b = __builtin_convertvector(v, bf16x2_t); return __builtin_bit_cast(unsigned, b); }
DI float bf2f(short x) { return __builtin_bit_cast(float, ((unsigned)(unsigned short)x) << 16); }
DI float wave_sum(float v) {
#pragma unroll
    for (int o = 1; o < 64; o <<= 1) v += __shfl_xor(v, o);
    return v;
}
#define LDS_WAIT() asm volatile("s_waitcnt lgkmcnt(0)" ::: "memory")

struct Sched {
    int nM, nN, nwg, G, c, pmadd, pmbase, ksplit, kbytes;
    DI void init(int nM_, int nN_, int G_, int c_) { nM = nM_; nN = nN_; nwg = nM_ * nN_; G = G_; c = c_; pmadd = 0; pmbase = 0; ksplit = 1; kbytes = 0; }
    DI bool next(int i, pg8::Unit& u) const {
        const long L = (long)i * G + c; if (L >= (long)nwg * ksplit) return false;
        int wgid = (int)L; u.ko = 0;
        if (ksplit > 1) { u.ko = (wgid % ksplit) * kbytes; wgid /= ksplit; }
        else { const int q = nwg / 8, r = nwg % 8, xcd = wgid % 8, off = wgid / 8; wgid = (xcd < r ? xcd * (q + 1) : r * (q + 1) + (xcd - r) * q) + off; }
        const int nig = 8 * nN, gid = wgid / nig, fm = gid * 8, gsz = (nM - fm) < 8 ? (nM - fm) : 8;
        u.pm = fm + ((wgid % nig) % gsz); u.pn = (wgid % nig) / gsz;
        if (u.pm > 0) u.pm += pmadd;
        u.pm += pmbase;
        return true;
    }
    DI void a_ready(const pg8::Unit&) const {}
    DI void done(const pg8::Unit&) const {}
};

template <int ACT> DI void store_tile_bf16(const pg8::f32x4 (&acc)[2][2][4][2], gbf16* base, int ld, const gfloat* bias, int wr, int wc, int fr, int fq) {
    const unsigned loff = (unsigned)((wr * 64 + fr) * ld + wc * 32 + 8 * fq) * 2u;
    f32x4 bv[2][2];
#pragma unroll
    for (int bj = 0; bj < 2; ++bj)
#pragma unroll
        for (int n = 0; n < 2; ++n) bv[bj][n] = bias ? *(const GAS f32x4*)(bias + wc * 32 + 8 * fq + bj * 128 + 4 * n) : (f32x4){0.f, 0.f, 0.f, 0.f};
#pragma unroll
    for (int ai = 0; ai < 2; ++ai)
#pragma unroll
        for (int m = 0; m < 4; ++m) { gchar* rowp = (gchar*)base + (size_t)((ai * 128 + m * 16) * ld) * 2u;
#pragma unroll
            for (int bj = 0; bj < 2; ++bj) { f32x4 a = acc[ai][bj][m][0] + bv[bj][0], b = acc[ai][bj][m][1] + bv[bj][1];
                if (ACT == 1) {
#pragma unroll
                    for (int e = 0; e < 4; ++e) { const float x = fmaxf(a[e], 0.f); a[e] = x * x; const float y = fmaxf(b[e], 0.f); b[e] = y * y; } }
                u32x4 w; w.x = pk2(a.x, a.y); w.y = pk2(a.z, a.w); w.z = pk2(b.x, b.y); w.w = pk2(b.z, b.w);
                *(GAS u32x4*)(rowp + bj * 256 + loff) = w; } }
}
DI void store_kfrag(const pg8::f32x4 (&acc)[2][2][4][2], gbf16* base, int wr, int wc, int fr, int fq) {
    const unsigned loff = (unsigned)(wr * 2 * 16384 + (wc >> 1) * 2048 + fq * 512 + (wc & 1) * 256 + fr * 8) * 2u;
#pragma unroll
    for (int ai = 0; ai < 2; ++ai)
#pragma unroll
        for (int m = 0; m < 4; ++m)
#pragma unroll
            for (int bj = 0; bj < 2; ++bj) { const f32x4 a = acc[ai][bj][m][0], b = acc[ai][bj][m][1];
                u32x4 w; w.x = pk2(a.x, a.y); w.y = pk2(a.z, a.w); w.z = pk2(b.x, b.y); w.w = pk2(b.z, b.w);
                *(GAS u32x4*)((gchar*)base + (size_t)((ai * 4 + (m >> 1)) * 16384 + bj * 2 * 2048 + (m & 1) * 128) * 2u + loff) = w; }
}
DI void store_vfrag(const pg8::f32x4 (&acc)[2][2][4][2], gbf16* base, int wr, int wc, int fr, int fq) {
    const unsigned loff = (unsigned)(wc * 8 * 2048 + wr * 2048 + (fq >> 1) * 512 + fr * 8 + (fq & 1) * 4) * 2u;
#pragma unroll
    for (int ai = 0; ai < 2; ++ai)
#pragma unroll
        for (int m = 0; m < 4; ++m)
#pragma unroll
            for (int bj = 0; bj < 2; ++bj) { const f32x4 a = acc[ai][bj][m][0], b = acc[ai][bj][m][1];
                gchar* q = (gchar*)base + (size_t)(bj * 32 * 2048 + ai * 2 * 2048 + (m >> 1) * 1024 + (m & 1) * 128) * 2u + loff;
                u32x2 w0; w0.x = pk2(a.x, a.y); w0.y = pk2(a.z, a.w); u32x2 w1; w1.x = pk2(b.x, b.y); w1.y = pk2(b.z, b.w);
                *(GAS u32x2*)q = w0; *(GAS u32x2*)(q + 512) = w1; }
}
enum { M_URM = 0, M_SWAP, M_DFTL, M_DFTC, M_MIXF, M_MIXC, M_RES1, M_RES2, M_HID, M_RES1K, M_RES2K };
struct UEpi {
    static constexpr bool PERM = true, AFTER_DRAIN = false;
    int mode, layer; PP p;
    DI void operator()(const pg8::f32x4 (&acc)[2][2][4][2], const pg8::Unit& u, int wr, int wc, int fr, int fq) const {
        unsigned char* ws = p.ws();
        if (mode == M_RES1K || mode == M_RES2K) {
            const int kc = u.ko / (mode == M_RES1K ? (D / 4) * 2 : (DFF / 4) * 2);
            const int r2 = u.pm * 256 - TL;
            const gfloat* srcb = (mode == M_RES1K && layer == 0) ? p.in(2) : (const gfloat*)(ws + WS_HCTX);
            const gchar* sp = (const gchar*)(srcb + (size_t)r2 * D + u.pn * 256);
            gchar* d = (gchar*)((gfloat*)(ws + (kc == 0 ? WS_HCTX : WS_SIDE + (size_t)(kc - 1) * 8 * MiB)) + (size_t)r2 * D + u.pn * 256);
            const gfloat* gp = (const gfloat*)(ws + WS_MODS) + (size_t)layer * 9 * 6144 + (mode == M_RES1K ? 2 : 5) * D + 8 * 6144 + u.pn * 256 + wc * 32 + 8 * fq;
            const unsigned loff = (unsigned)((wr * 64 + fr) * D + wc * 32 + 8 * fq) * 4u;
            f32x4 gv[2][2];
#pragma unroll
            for (int bj = 0; bj < 2; ++bj)
#pragma unroll
                for (int n = 0; n < 2; ++n) gv[bj][n] = *(const GAS f32x4*)(gp + bj * 128 + 4 * n);
#pragma unroll
            for (int ai = 0; ai < 2; ++ai)
#pragma unroll
                for (int m = 0; m < 4; ++m) { const size_t ro = (size_t)((ai * 128 + m * 16) * D) * 4u;
#pragma unroll
                    for (int bj = 0; bj < 2; ++bj) {
                        f32x4 x0 = (f32x4){0.f, 0.f, 0.f, 0.f}, x1 = x0;
                        if (kc == 0) { x0 = *(const GAS f32x4*)(sp + ro + bj * 512 + loff); x1 = *(const GAS f32x4*)(sp + ro + bj * 512 + 16 + loff); }
                        *(GAS f32x4*)(d + ro + bj * 512 + loff) = x0 + gv[bj][0] * acc[ai][bj][m][0];
                        *(GAS f32x4*)(d + ro + bj * 512 + 16 + loff) = x1 + gv[bj][1] * acc[ai][bj][m][1]; } }
            return;
        }
        if (mode == M_RES1 || mode == M_RES2) {
            const bool first = (mode == M_RES1 && layer == 0);
            const int row0 = u.pm * 256; const bool lat = row0 < TL; const int r2 = lat ? row0 : row0 - TL, midx = lat ? (row0 >> 11) : 8;
            const gfloat* srcb = lat ? (first ? p.in(0) : (const gfloat*)p.out()) : (first ? p.in(2) : (const gfloat*)(ws + WS_HCTX));
            gfloat* dstb = lat ? p.out() : (gfloat*)(ws + WS_HCTX);
            const gchar* s = (const gchar*)(srcb + (size_t)r2 * D + u.pn * 256);
            gchar* d = (gchar*)(dstb + (size_t)r2 * D + u.pn * 256);
            const gfloat* gp = (const gfloat*)(ws + WS_MODS) + (size_t)layer * 9 * 6144 + (mode == M_RES1 ? 2 : 5) * D + midx * 6144 + u.pn * 256 + wc * 32 + 8 * fq;
            const unsigned loff = (unsigned)((wr * 64 + fr) * D + wc * 32 + 8 * fq) * 4u;
            f32x4 gv[2][2];
#pragma unroll
            for (int bj = 0; bj < 2; ++bj)
#pragma unroll
                for (int n = 0; n < 2; ++n) gv[bj][n] = *(const GAS f32x4*)(gp + bj * 128 + 4 * n);
#pragma unroll
            for (int ai = 0; ai < 2; ++ai)
#pragma unroll
                for (int m = 0; m < 4; ++m) { const size_t ro = (size_t)((ai * 128 + m * 16) * D) * 4u;
#pragma unroll
                    for (int bj = 0; bj < 2; ++bj) {
                        const f32x4 x0 = *(const GAS f32x4*)(s + ro + bj * 512 + loff), x1 = *(const GAS f32x4*)(s + ro + bj * 512 + 16 + loff);
                        *(GAS f32x4*)(d + ro + bj * 512 + loff) = x0 + gv[bj][0] * acc[ai][bj][m][0];
                        *(GAS f32x4*)(d + ro + bj * 512 + 16 + loff) = x1 + gv[bj][1] * acc[ai][bj][m][1]; } }
            return;
        }
        gbf16* base; int ld; const gfloat* bias = nullptr;
        if (mode == M_URM) {
            if (u.pn >= 4) { store_kfrag(acc, (gbf16*)(ws + WS_KT) + (size_t)(u.pm * 64 + (u.pn - 4) * 4) * 2048, wr, wc, fr, fq); return; }
            ld = URM; base = (gbf16*)(ws + WS_URM) + (size_t)(u.pm * 256) * URM + u.pn * 256; }
        else if (mode == M_HID) { ld = DFF; base = (gbf16*)(ws + WS_HID) + (size_t)(u.pm * 256) * DFF + u.pn * 256; }
        else if (mode == M_SWAP) {
            if (u.pm != 0) { store_vfrag(acc, (gbf16*)(ws + WS_VT) + (size_t)(u.pn * 64 + (u.pm - 7) * 4) * 2048, wr, wc, fr, fq); return; }
            const int tok0 = u.pn * 256; const bool lat = tok0 < TL;
            const int bb = lat ? (tok0 >> 11) : ((tok0 - TL) >> 8), l0 = lat ? (tok0 & (SEQ - 1)) : 0; ld = lat ? SEQ : CTX;
            base = (gbf16*)(ws + (lat ? WS_UTL : WS_UTC)) + (size_t)(bb * 256) * ld + l0;
        } else if (mode == M_DFTL || mode == M_DFTC) {
            const int L = mode == M_DFTL ? SEQ : CTX, lshift = mode == M_DFTL ? 11 : 8, rowbase = mode == M_DFTL ? 0 : TL;
            const int row0 = u.pm * 256, cs = row0 >> lshift, lp0 = row0 & (L - 1);
            ld = 512; base = (gbf16*)(ws + WS_G12) + (size_t)(rowbase + u.pn * L + lp0) * 512 + cs * 256;
        } else {
            ld = D; base = (gbf16*)(ws + WS_MIX) + (size_t)(u.pm * 256) * D + (mode == M_MIXC ? 256 : 0);
            if (mode == M_MIXC) bias = p.in(15) + layer * 256;
        }
        if (mode == M_HID) store_tile_bf16<1>(acc, base, ld, nullptr, wr, wc, fr, fq);
        else store_tile_bf16<0>(acc, base, ld, bias, wr, wc, fr, fq);
    }
};
DI void run_gemm(LAS unsigned char* lds, const gbf16* A, const gbf16* Bt, int K, int Kext, const Sched& S, int mode, int layer, PP p, const int tid) {
    pg8::Gemm g{(const bf16*)A, (const bf16*)Bt, Kext, 0, K}; UEpi e{mode, layer, p};
    pg8::gemm_phase<UEpi, Sched, true, true>(lds, g, S, e, tid);
}
#define XB_TMO      128
#define XB_XCNT(j)  (256  + 64 * (j))
#define XB_XSUB(j)  (1280 + 64 * (j))
#define XB_XGEN(j)  (2304 + 64 * (j))
#define XB_TOP      3328
#define XB_TOPGEN   3392
#define XCD_BAR_WORDS 3456
#define XB_SPIN_CAP (1u << 18)

__device__ __forceinline__ unsigned xb_ld(unsigned* p)              { return __hip_atomic_load(p, __ATOMIC_RELAXED, __HIP_MEMORY_SCOPE_AGENT); }
__device__ __forceinline__ unsigned xb_add(unsigned* p, unsigned v) { return __hip_atomic_fetch_add(p, v, __ATOMIC_RELAXED, __HIP_MEMORY_SCOPE_AGENT); }
__device__ __forceinline__ unsigned xb_xcc_id() { return (unsigned)__builtin_amdgcn_s_getreg((3 << 11) | 20) & 0xFu; }
#define XB_SPIN(cond, bar) do { unsigned _sp = 0; while (cond) { __builtin_amdgcn_s_sleep(1); \
    if ((++_sp & 255u) == 0u) { if (xb_ld(&(bar)[XB_TMO])) break; if (_sp > XB_SPIN_CAP) { atomicAdd(&(bar)[XB_TMO], 1u); break; } } } } while (0)

struct XcdBarrier {
    unsigned* bar; unsigned x;
    volatile LAS unsigned* st;
};

__device__ __forceinline__ XcdBarrier xcd_barrier_post(unsigned* bar, volatile LAS unsigned* st) {
    XcdBarrier b; b.bar = bar; b.x = xb_xcc_id(); b.st = st;
    if (threadIdx.x == 0) (void)xb_add(&bar[XB_XCNT(b.x)], 1u);
    return b;
}
__device__ __forceinline__ void xcd_barrier_complete(unsigned* bar, unsigned x, unsigned& nloc, unsigned& nx) {
    const unsigned G = gridDim.x * gridDim.y * gridDim.z;
    unsigned sum, cnt, mine, sp = 0u;
    for (;;) {
        sum = 0u; cnt = 0u; mine = 0u;
#pragma unroll
        for (unsigned j = 0; j < 16; ++j) { const unsigned c = xb_ld(&bar[XB_XCNT(j)]); sum += c; cnt += (c > 0u) ? 1u : 0u; mine = (j == x) ? c : mine; }
        if (sum == G) break;
        __builtin_amdgcn_s_sleep(1);
        if ((++sp & 255u) == 0u) { if (xb_ld(&bar[XB_TMO])) break; if (sp > XB_SPIN_CAP) { atomicAdd(&bar[XB_TMO], 1u); break; } }
    }
    nloc = mine > 0u ? mine : 1u; nx = cnt > 0u ? cnt : 1u;
}

__device__ __forceinline__ void xcd_barrier(const XcdBarrier& b) {
    asm volatile("s_waitcnt vmcnt(0)" ::: "memory");
    __syncthreads();
    if (threadIdx.x == 0) {
        unsigned* bar = b.bar;
        __builtin_amdgcn_s_waitcnt(0);
        unsigned nloc = b.st[0], nx = b.st[1];
        if (nloc == 0u) { xcd_barrier_complete(bar, b.x, nloc, nx); b.st[0] = nloc; b.st[1] = nx; }
        const unsigned old = xb_add(&bar[XB_XSUB(b.x)], 1u);
        const unsigned gen = old / nloc;
        if (old + 1u == (gen + 1u) * nloc) {
            __builtin_amdgcn_fence(__ATOMIC_RELEASE, "agent");
            asm volatile("s_waitcnt vmcnt(0)" ::: "memory");
            const unsigned og = xb_add(&bar[XB_TOP], 1u);
            const unsigned tg = og / nx;
            if (og + 1u == (tg + 1u) * nx) xb_add(&bar[XB_TOPGEN], 1u);
            else XB_SPIN(xb_ld(&bar[XB_TOPGEN]) == tg, bar);
            __builtin_amdgcn_fence(__ATOMIC_ACQUIRE, "agent");
            xb_add(&bar[XB_XGEN(b.x)], 1u);
            asm volatile("s_waitcnt vmcnt(0)" ::: "memory");
        } else {
            XB_SPIN(xb_ld(&bar[XB_XGEN(b.x)]) == gen, bar);
            __builtin_amdgcn_fence(__ATOMIC_ACQUIRE, "agent");
            asm volatile("s_waitcnt vmcnt(0)" ::: "memory");
        }
    }
    __syncthreads();
}

DI void phase_mods(const PP p, LAS unsigned char* lds, const int tid_, const int bid_) {
    const int tid = tid_, lane = tid & 63, wave = tid >> 6;
    LAS float* s = (LAS float*)lds;
    LAS float* red = (LAS float*)(lds + 36864);
    gfloat* mods = (gfloat*)(p.ws() + WS_MODS);
    for (int i = tid; i < 9 * 1024; i += 512) { const int j = i >> 10, k = i & 1023; const float v = j < 8 ? p.in(1)[j * 1024 + k] : p.in(3)[k]; s[i] = v / (1.f + expf(-v)); }
    __syncthreads();
    for (int item = bid_; item < 192; item += gridDim.x) {
        const int layer = item / 96, cgp = item % 96, col = cgp * 64 + lane;
        const gfloat* W = p.in(4) + (size_t)layer * 1024 * 6144 + col;
        float acc[9];
#pragma unroll
        for (int j = 0; j < 9; ++j) acc[j] = 0.f;
        const int k0 = wave * 128;
#pragma unroll 32
        for (int k = k0; k < k0 + 128; ++k) { const float w = W[(size_t)k * 6144];
#pragma unroll
            for (int j = 0; j < 9; ++j) acc[j] += s[j * 1024 + k] * w; }
#pragma unroll
        for (int j = 0; j < 9; ++j) red[(wave * 9 + j) * 64 + lane] = acc[j];
        __syncthreads();
        for (int t = tid; t < 576; t += 512) { const int j = t >> 6, l = t & 63; float v = p.in(5)[layer * 6144 + cgp * 64 + l];
#pragma unroll
            for (int w = 0; w < 8; ++w) v += red[(w * 9 + j) * 64 + l];
            mods[(size_t)(layer * 9 + j) * 6144 + cgp * 64 + l] = v; }
        __syncthreads();
    }
}
DI void make_tables(const PP p, const int tid_, const int bid_) {
    gbf16* DL = (gbf16*)(p.ws() + WS_DFTL); gbf16* DC = (gbf16*)(p.ws() + WS_DFTC);
    const int gt = bid_ * 512 + tid_, NT = gridDim.x * 512;
    for (int i = gt; i < 4096 * 256; i += NT) { const int row = i >> 8, l0 = (i & 255) * 8, cs = row >> 11, lp = row & 2047;
        float v[8];
#pragma unroll
        for (int e = 0; e < 8; ++e) { const int ph = (lp * (l0 + e)) & 2047; const float x = (float)ph * (1.f / 1024.f); v[e] = (cs ? sinpif(x) : cospif(x)) * 0.022097086912079608f; }
        u32x4 w; w.x = pk2(v[0], v[1]); w.y = pk2(v[2], v[3]); w.z = pk2(v[4], v[5]); w.w = pk2(v[6], v[7]);
        *(GAS u32x4*)(DL + (size_t)row * 2048 + l0) = w; }
    for (int i = gt; i < 512 * 32; i += NT) { const int row = i >> 5, l0 = (i & 31) * 8, cs = row >> 8, lp = row & 255;
        float v[8];
#pragma unroll
        for (int e = 0; e < 8; ++e) { const int ph = (lp * (l0 + e)) & 255; const float x = (float)ph * (1.f / 128.f); v[e] = (cs ? sinpif(x) : cospif(x)) * 0.0625f; }
        u32x4 w; w.x = pk2(v[0], v[1]); w.y = pk2(v[2], v[3]); w.z = pk2(v[4], v[5]); w.w = pk2(v[6], v[7]);
        *(GAS u32x4*)(DC + (size_t)row * 256 + l0) = w; }
}
DI void transpose_item(const gfloat* W, int K, int N, gbf16* WT, LAS float* scr, int item, int lane) {
    const int nblk = N / 32, kb = item / nblk, nb = item % nblk, k0 = 64 * kb, n0 = 32 * nb;
#pragma unroll 8
    for (int i = 0; i < 32; ++i) { const int kk = 2 * i + (lane >> 5); scr[kk * 33 + (lane & 31)] = W[(size_t)(k0 + kk) * N + n0 + (lane & 31)]; }
    LDS_WAIT(); asm volatile("" ::: "memory");
    const int c = lane & 7;
#pragma unroll
    for (int j = 0; j < 4; ++j) { const int n = (lane >> 3) + 8 * j; const LAS float* sp = scr + (8 * c) * 33 + n;
        u32x4 o; o.x = pk2(sp[0 * 33], sp[1 * 33]); o.y = pk2(sp[2 * 33], sp[3 * 33]); o.z = pk2(sp[4 * 33], sp[5 * 33]); o.w = pk2(sp[6 * 33], sp[7 * 33]);
        *(GAS u32x4*)(WT + (size_t)(n0 + n) * K + k0 + 8 * c) = o; }
    LDS_WAIT(); asm volatile("" ::: "memory");
}
DI void conv_weights(const PP p, int layer, LAS unsigned char* lds, const int tid_, const int bid_) {
    const int lane = tid_ & 63, wave = tid_ >> 6;
    LAS float* scr = (LAS float*)(lds + 57344 + wave * 8448);
    const int gw = bid_ * 8 + wave, NGW = gridDim.x * 8;
    const gfloat* Win = p.in(8) + (size_t)layer * D * DIN; const gfloat* Wout = p.in(17) + (size_t)layer * D * D;
    const gfloat* W1 = p.in(18) + (size_t)layer * D * DFF; const gfloat* W2 = p.in(19) + (size_t)layer * DFF * D; const gfloat* Wpw = p.in(14) + (size_t)layer * 256 * 256;
    gbf16* WinT = (gbf16*)(p.ws() + WS_WIN); gbf16* WoutT = (gbf16*)(p.ws() + WS_WOUT); gbf16* W1T = (gbf16*)(p.ws() + WS_W1); gbf16* W2T = (gbf16*)(p.ws() + WS_W2); gbf16* WpwT = (gbf16*)(p.ws() + WS_WPW);
    constexpr int I_IN = 16 * 72, I_OUT = 16 * 32, I_1 = 16 * 128, I_2 = 64 * 32, I_PW = 4 * 8, NIT = I_IN + I_OUT + I_1 + I_2 + I_PW;
    for (int it = gw; it < NIT; it += NGW) {
        int r = it;
        if (r < I_IN) { transpose_item(Win, D, DIN, WinT, scr, r, lane); continue; } r -= I_IN;
        if (r < I_OUT) { transpose_item(Wout, D, D, WoutT, scr, r, lane); continue; } r -= I_OUT;
        if (r < I_1) { transpose_item(W1, D, DFF, W1T, scr, r, lane); continue; } r -= I_1;
        if (r < I_2) { transpose_item(W2, DFF, D, W2T, scr, r, lane); continue; } r -= I_2;
        transpose_item(Wpw, 256, 256, WpwT, scr, r, lane);
    }
    const gfloat* Wf = p.in(9) + (size_t)layer * 256 * 256; gbf16* Wf2t = (gbf16*)(p.ws() + WS_WF2);
    for (int o = bid_ * 512 + tid_; o < 256 * 512; o += gridDim.x * 512) {
        const int n = o >> 9, k = o & 511, cs = k >> 8, g = (k >> 6) & 3, j = k & 63;
        float acc = 0.f;
        for (int jp = 0; jp < 64; ++jp) { const float x = (float)((j * jp) & 63) * (1.f / 32.f); const float t = cs ? sinpif(x) : cospif(x); acc += t * Wf[(size_t)(g * 64 + jp) * 256 + n]; }
        acc *= cs ? -0.125f : 0.125f;
        Wf2t[(size_t)n * 512 + k] = (bf16)(pk2(acc, 0.f) & 0xffffu);
    }
}
DI void phase_norm(const PP p, int layer, int which, int nrows, const int tid_, const int bid_) {
    const int lane = tid_ & 63, wave = tid_ >> 6;
    const int gw = bid_ * 8 + wave, NGW = gridDim.x * 8;
    const bool first = (layer == 0 && which == 0);
    const gfloat* hl = first ? p.in(0) : p.out(); const gfloat* hc = first ? p.in(2) : (const gfloat*)(p.ws() + WS_HCTX);
    const gfloat* g = p.in(which ? 7 : 6) + layer * D;
    const gfloat* mods = (const gfloat*)(p.ws() + WS_MODS) + (size_t)layer * 9 * 6144 + (which ? 3 : 0) * D;
    gbf16* hn = (gbf16*)(p.ws() + WS_HN);
    for (int row = gw; row < nrows; row += NGW) {
        const gfloat* src = row < TL ? hl + (size_t)row * D : hc + (size_t)(row - TL) * D;
        const int midx = row < TL ? (row >> 11) : 8;
        f32x4 v[4]; float ss = 0.f;
#pragma unroll
        for (int jj = 0; jj < 4; ++jj) v[jj] = *(const GAS f32x4*)(src + 4 * (lane + 64 * jj));
        if (!first && row >= TL) {
            const gfloat* sd = (const gfloat*)(p.ws() + WS_SIDE) + (size_t)(row - TL) * D; gfloat* hw = (gfloat*)(p.ws() + WS_HCTX) + (size_t)(row - TL) * D;
#pragma unroll
            for (int jj = 0; jj < 4; ++jj) { const int k = 4 * (lane + 64 * jj);
                v[jj] += (*(const GAS f32x4*)(sd + k) + *(const GAS f32x4*)(sd + 2 * 1024 * 1024 + k)) + *(const GAS f32x4*)(sd + 4 * 1024 * 1024 + k);
                *(GAS f32x4*)(hw + k) = v[jj]; } }
#pragma unroll
        for (int jj = 0; jj < 4; ++jj) ss += (v[jj].x * v[jj].x + v[jj].y * v[jj].y) + (v[jj].z * v[jj].z + v[jj].w * v[jj].w);
        const float rinv = 1.f / sqrtf(wave_sum(ss) * (1.f / D) + 1e-6f);
#pragma unroll
        for (int jj = 0; jj < 4; ++jj) { const int k = 4 * (lane + 64 * jj);
            const f32x4 gg = *(const GAS f32x4*)(g + k), sh = *(const GAS f32x4*)(mods + midx * 6144 + k), sc = *(const GAS f32x4*)(mods + midx * 6144 + D + k);
            const f32x4 y = (v[jj] * rinv * gg) * (sc + 1.f) + sh;
            u32x2 w; w.x = pk2(y.x, y.y); w.y = pk2(y.z, y.w);
            *(GAS u32x2*)(hn + (size_t)row * D + k) = w; }
    }
}
DI void phase_final(const PP p, const int tid_, const int bid_) {
    const int lane = tid_ & 63, wave = tid_ >> 6;
    const int gw = bid_ * 8 + wave, NGW = gridDim.x * 8;
    const gfloat* g = p.in(20);
    for (int row = gw; row < TL; row += NGW) {
        gfloat* src = p.out() + (size_t)row * D;
        f32x4 v[4]; float ss = 0.f;
#pragma unroll
        for (int jj = 0; jj < 4; ++jj) { v[jj] = *(const GAS f32x4*)(src + 4 * (lane + 64 * jj)); ss += (v[jj].x * v[jj].x + v[jj].y * v[jj].y) + (v[jj].z * v[jj].z + v[jj].w * v[jj].w); }
        const float rinv = 1.f / sqrtf(wave_sum(ss) * (1.f / D) + 1e-6f);
#pragma unroll
        for (int jj = 0; jj < 4; ++jj) { const int k = 4 * (lane + 64 * jj); const f32x4 gg = *(const GAS f32x4*)(g + k); *(GAS f32x4*)(src + k) = v[jj] * rinv * gg; }
    }
}
DI void conv_tile(const PP p, int layer, int seqbase, int L, int t0, LAS unsigned char* lds, const int tid_, const int bid_) {
    int tid = tid_; asm volatile("" : "+v"(tid));
    const int lane = tid & 63;
    LAS float* vt = (LAS float*)lds;
    LAS float* red1 = (LAS float*)(lds + 98304);
    LAS float* red2 = (LAS float*)(lds + 98304 + 1024);
    const gbf16* Urm = (const gbf16*)(p.ws() + WS_URM);
    gbf16* cva = (gbf16*)(p.ws() + WS_CVA);
    __syncthreads();
    for (int idx = tid; idx < 94 * 32; idx += 512) { const int tt = idx >> 5, c8 = (idx & 31) * 8, pos = t0 - 15 + tt;
        float v[8];
        if (pos >= 0 && pos < L) { const gbf16* rp = Urm + (size_t)(seqbase + pos) * URM + c8; const bf16x8 a8 = *(const GAS bf16x8*)rp, g8 = *(const GAS bf16x8*)(rp + 256);
#pragma unroll
            for (int e = 0; e < 8; ++e) { const float a = bf2f(a8[e]), gt = bf2f(g8[e]); v[e] = a / (1.f + __expf(-gt)); } }
        else {
#pragma unroll
            for (int e = 0; e < 8; ++e) v[e] = 0.f; }
        *(LAS f32x4*)(vt + tt * 256 + c8) = (f32x4){v[0], v[1], v[2], v[3]}; *(LAS f32x4*)(vt + tt * 256 + c8 + 4) = (f32x4){v[4], v[5], v[6], v[7]}; }
    __syncthreads();
    const int c = tid & 255, th = tid >> 8, wq = (tid >> 6) & 3;
    const gfloat* dw = p.in(10) + (size_t)layer * 31 * 256 + c;
    float w[31];
#pragma unroll
    for (int tap = 0; tap < 31; ++tap) w[tap] = dw[tap * 256];
    const float bias = p.in(11)[layer * 256 + c], lg = p.in(12)[layer * 256 + c], lb = p.in(13)[layer * 256 + c];
    for (int ch = 0; ch < 4; ++ch) {
        const int tb = th * 32 + ch * 8;
        float o[8];
#pragma unroll
        for (int e = 0; e < 8; ++e) { float acc = bias;
#pragma unroll
            for (int tap = 0; tap < 31; ++tap) acc += w[tap] * vt[(tb + e + tap) * 256 + c];
            o[e] = acc; }
#pragma unroll
        for (int e = 0; e < 8; ++e) { const float s1 = wave_sum(o[e]); if (lane == 0) red1[(tb + e) * 4 + wq] = s1; }
        __syncthreads();
#pragma unroll
        for (int e = 0; e < 8; ++e) { const LAS float* r = red1 + (tb + e) * 4; const float mean = ((r[0] + r[1]) + (r[2] + r[3])) * (1.f / 256.f); o[e] -= mean;
            const float s2 = wave_sum(o[e] * o[e]); if (lane == 0) red2[(tb + e) * 4 + wq] = s2; }
        __syncthreads();
#pragma unroll
        for (int e = 0; e < 8; ++e) { const LAS float* r = red2 + (tb + e) * 4; const float var = ((r[0] + r[1]) + (r[2] + r[3])) * (1.f / 256.f);
            const float y = o[e] / sqrtf(var + 1e-5f) * lg + lb; const float z = y / (1.f + __expf(-y));
            cva[(size_t)(seqbase + t0 + tb + e) * 256 + c] = (bf16)(pk2(z, 0.f) & 0xffffu); }
    }
}
#define MFMA32(a, b, c) __builtin_amdgcn_mfma_f32_32x32x16_bf16((a), (b), (c), 0, 0, 0)
DI void attn_load(const gchar* KtB, const gchar* VtB, int tile, int b, int h, int rs, int lane, bf16x8 (&kf)[4], bf16x8 (&vf)[2][2]) {
    const int tileg = tile >= 8 ? (b * 64 + rs * 2 + (tile - 8)) : (TL / 32 + b * 8 + tile);
    const unsigned off = (unsigned)((tileg * 8 + h) * 2048 + lane * 8) * 2u;
#pragma unroll
    for (int ks = 0; ks < 4; ++ks) kf[ks] = *(const GAS bf16x8*)(KtB + off + ks * 1024);
#pragma unroll
    for (int dt = 0; dt < 2; ++dt)
#pragma unroll
        for (int t = 0; t < 2; ++t) vf[dt][t] = *(const GAS bf16x8*)(VtB + off + (dt * 2 + t) * 1024);
}
template <int MODE, int KT> DI void attn_compute(const bf16x8 (&kf)[4], const bf16x8 (&vf)[2][2], const LAS bf16x8* ql_, f32x16 (&o)[2][2], float (&m)[2], float (&ls)[2],
                                                 const LAS float* bl, int kr, int ql, int half) {
    const float SCL = 0.125f * 1.4426950408889634f, NINF = -__builtin_inff();
#pragma unroll
    for (int qt = 0; qt < 2; ++qt) {
        constexpr int dummy = 0; (void)dummy;
        const int VLO = (MODE == 1 && qt != KT) ? (qt == 0 ? 0 : 12) : 0, VHI = (MODE == 1 && qt != KT) ? (qt == 0 ? 4 : 16) : 16;
        f32x16 sv;
#pragma unroll
        for (int v = 0; v < 16; ++v) sv[v] = 0.f;
#pragma unroll
        for (int ks = 0; ks < 4; ++ks) sv = MFMA32(kf[ks], ql_[(qt * 4 + ks) * 64], sv);
        float mx = NINF;
        if (MODE == 1) {
            const int qc = qt * 32 + ql, cs = min(max(qc - 8, 0), 48);
            const int kc0 = KT * 32 + 4 * half;
            const int d0 = kc0 - cs;
            const volatile LAS float* bp = (const volatile LAS float*)bl + (kr * 31 + kc0 - qc + 15 + 48);
            float bias[16];
#pragma unroll
            for (int v = 0; v < 16; ++v) if (v >= VLO && v < VHI) bias[v] = bp[(v & 3) + 8 * (v >> 2)];
#pragma unroll
            for (int v = 0; v < 16; ++v) if (v >= VLO && v < VHI) { const int dv = (v & 3) + 8 * (v >> 2); const bool valid = (unsigned)(d0 + dv) < 16u;
                const float x = valid ? sv[v] * SCL + bias[v] : NINF; sv[v] = x; mx = fmaxf(mx, x); }
        } else {
#pragma unroll
            for (int v = 0; v < 16; ++v) { const float x = sv[v] * SCL; sv[v] = x; mx = fmaxf(mx, x); }
        }
        mx = fmaxf(mx, __shfl_xor(mx, 32));
        const float mn = fmaxf(m[qt], mx), alpha = __builtin_amdgcn_exp2f(m[qt] - mn);
        const bool grew = mn > m[qt]; m[qt] = mn;
        float sum = 0.f;
#pragma unroll
        for (int v = 0; v < 16; ++v) if (v >= VLO && v < VHI) { const float pv = __builtin_amdgcn_exp2f(sv[v] - mn); sv[v] = pv; sum += pv; }
        ls[qt] = ls[qt] * alpha + sum;
        if (__builtin_amdgcn_ballot_w64(grew) != 0ull) {
#pragma unroll
            for (int dt = 0; dt < 2; ++dt)
#pragma unroll
                for (int v = 0; v < 16; ++v) o[dt][qt][v] *= alpha;
        }
#pragma unroll
        for (int t = 0; t < 2; ++t) {
            if (8 * t + 8 <= VLO || 8 * t >= VHI) continue;
            u32x4 pw;
            pw.x = (8 * t + 0 >= VLO && 8 * t + 0 < VHI) ? pk2(sv[8 * t + 0], sv[8 * t + 1]) : 0u; pw.y = (8 * t + 2 >= VLO && 8 * t + 2 < VHI) ? pk2(sv[8 * t + 2], sv[8 * t + 3]) : 0u;
            pw.z = (8 * t + 4 >= VLO && 8 * t + 4 < VHI) ? pk2(sv[8 * t + 4], sv[8 * t + 5]) : 0u; pw.w = (8 * t + 6 >= VLO && 8 * t + 6 < VHI) ? pk2(sv[8 * t + 6], sv[8 * t + 7]) : 0u;
            const bf16x8 pf = __builtin_bit_cast(bf16x8, pw);
#pragma unroll
            for (int dt = 0; dt < 2; ++dt) o[dt][qt] = MFMA32(vf[dt][t], pf, o[dt][qt]); }
    }
}
DI void attn_item(const PP p, int layer, int b, int qbase, int nloc, int r, LAS unsigned char* lds, const int tid_, const int bid_) {
    int tid = tid_; asm volatile("" : "+v"(tid));
    const int lane = tid & 63, h = __builtin_amdgcn_readfirstlane(tid >> 6), ql = lane & 31, half = lane >> 5;
    const gchar* UrmB = (const gchar*)(p.ws() + WS_URM); const gchar* KtB = (const gchar*)(p.ws() + WS_KT); const gchar* VtB = (const gchar*)(p.ws() + WS_VT);
    LAS float* bl = (LAS float*)(lds + h * 9728);
    LAS bf16x8* qlds = (LAS bf16x8*)(lds + h * 9728 + 1536) + lane;
    const int rs = min(max(r - 4, 0), 24);
    const float LOG2E = 1.4426950408889634f, NINF = -__builtin_inff();
    __syncthreads();
    if (nloc) { const gfloat* rp = p.in(16) + (size_t)(layer * 8 + h) * 465;
        for (int i = lane; i < 248; i += 64) { const int kr = i / 31, co = i - kr * 31; bl[48 + i] = rp[(rs - r + 7 + kr) * 31 + co] * LOG2E; } }
    __syncthreads();
#pragma unroll
    for (int qt = 0; qt < 2; ++qt) { const unsigned qoff = (unsigned)((qbase + qt * 32 + ql) * URM + 512 + h * 64 + 32 * half) * 2u;
#pragma unroll
        for (int ks = 0; ks < 4; ++ks) qlds[(qt * 4 + ks) * 64] = *(const GAS bf16x8*)(UrmB + qoff + 16 * ks); }
    f32x16 o[2][2];
#pragma unroll
    for (int a = 0; a < 2; ++a)
#pragma unroll
        for (int c = 0; c < 2; ++c)
#pragma unroll
            for (int v = 0; v < 16; ++v) o[a][c][v] = 0.f;
    float m[2] = {NINF, NINF}, ls[2] = {0.f, 0.f};
    const int ntiles = 8 + nloc;
    bf16x8 kf[4], vf[2][2], kn[4], vn[2][2];
#define ATT_ROT() do { _Pragma("unroll") for (int ks = 0; ks < 4; ++ks) kf[ks] = kn[ks]; _Pragma("unroll") for (int dt = 0; dt < 2; ++dt) _Pragma("unroll") for (int t = 0; t < 2; ++t) vf[dt][t] = vn[dt][t]; } while (0)
    attn_load(KtB, VtB, 0, b, h, rs, lane, kf, vf);
#pragma unroll 1
    for (int tile = 0; tile < 8; ++tile) {
        asm volatile("" ::: "memory");
        attn_load(KtB, VtB, tile + 1 < ntiles ? tile + 1 : tile, b, h, rs, lane, kn, vn);
        attn_compute<0, 0>(kf, vf, qlds, o, m, ls, bl, 0, ql, half);
        ATT_ROT();
    }
#pragma unroll 1
    for (int kr = 0; kr < (nloc >> 1); ++kr) {
        asm volatile("" ::: "memory");
        attn_load(KtB, VtB, 9 + 2 * kr, b, h, rs, lane, kn, vn);
        attn_compute<1, 0>(kf, vf, qlds, o, m, ls, bl, kr, ql, half);
        ATT_ROT();
        asm volatile("" ::: "memory");
        attn_load(KtB, VtB, 10 + 2 * kr < ntiles ? 10 + 2 * kr : 9 + 2 * kr, b, h, rs, lane, kn, vn);
        attn_compute<1, 1>(kf, vf, qlds, o, m, ls, bl, kr, ql, half);
        ATT_ROT();
    }
#undef ATT_ROT
    int tid2 = tid_; asm volatile("" : "+v"(tid2));
    const int ql2 = tid2 & 31, half2 = (tid2 >> 5) & 1; gbf16* mixo = (gbf16*)(p.ws() + WS_MIX);
#pragma unroll
    for (int qt = 0; qt < 2; ++qt) { const float lt_ = ls[qt] + __shfl_xor(ls[qt], 32); const float inv = 1.f / lt_; const int token = qbase + qt * 32 + ql2;
#pragma unroll
        for (int dt = 0; dt < 2; ++dt)
#pragma unroll
            for (int i = 0; i < 4; ++i) { const int d = dt * 32 + 8 * i + 4 * half2; u32x2 w; w.x = pk2(o[dt][qt][4 * i] * inv, o[dt][qt][4 * i + 1] * inv); w.y = pk2(o[dt][qt][4 * i + 2] * inv, o[dt][qt][4 * i + 3] * inv);
                *(GAS u32x2*)((gchar*)mixo + (unsigned)(token * D + 512 + h * 64 + d) * 2u) = w; } }
}
DI void run_phase(const PP p, int ph, LAS unsigned char* lds, const int tid, const int c, const int skip = 0) {
    const int G = gridDim.x;
    if (ph == 0) { phase_mods(p, lds, tid, c); make_tables(p, tid, c); conv_weights(p, 0, lds, tid, c); return; }
    if (ph == NPH - 1) { phase_final(p, tid, c); return; }
    const int layer = (ph - 1) >> 3, sub = (ph - 1) & 7;
    const int M = layer == 0 ? TA : TL;
    if (sub == 0) { if (layer == 1) conv_weights(p, 1, lds, tid, c); phase_norm(p, layer, 0, TA, tid, c); return; }
    if (sub == 5) { phase_norm(p, layer, 1, M, tid, c); return; }
    const int H = G / 2 > 0 ? G / 2 : 1;
#pragma unroll 1
    for (int j = 0; j < 2; ++j) {
        unsigned char* ws = p.ws();
        const gbf16* A = nullptr; const gbf16* Bt = nullptr; int K = 0, nM = 0, nN = 0, cc = c, pmadd = 0, mode = 0, pmbase = 0, ksplit = 1; bool valid = true;
        if (sub == 1) {
            if (j == 0) { A = (const gbf16*)(ws + WS_HN); Bt = (const gbf16*)(ws + WS_WIN) + (size_t)256 * D; K = D; nM = TA / 256; nN = 6; mode = M_URM; }
            else { A = (const gbf16*)(ws + WS_WIN); Bt = (const gbf16*)(ws + WS_HN); K = D; nM = 3; nN = TA / 256; cc = (c + (G - (432 % G))) % G; pmadd = 6; mode = M_SWAP; }
        } else if (sub == 2) {
            if (j == 0) { A = (const gbf16*)(ws + WS_DFTL); Bt = (const gbf16*)(ws + WS_UTL); K = SEQ; nM = 16; nN = 8; mode = M_DFTL; }
            else { A = (const gbf16*)(ws + WS_DFTC); Bt = (const gbf16*)(ws + WS_UTC); K = CTX; nM = 2; nN = 8; cc = (c + H) % G; mode = M_DFTC; valid = (layer == 0); }
        } else if (sub == 3) {
            if (j == 0) { A = (const gbf16*)(ws + WS_G12); Bt = (const gbf16*)(ws + WS_WF2); K = 512; nM = M / 256; nN = 1; mode = M_MIXF; }
            else { A = (const gbf16*)(ws + WS_CVA); Bt = (const gbf16*)(ws + WS_WPW); K = 256; nM = M / 256; nN = 1; cc = (c + G - ((M / 256) % G)) % G; mode = M_MIXC; }
        } else if (sub == 4) { A = (const gbf16*)(ws + WS_MIX); Bt = (const gbf16*)(ws + WS_WOUT); K = D; nN = 4;
            if (j == 0) { nM = TL / 256; mode = M_RES1; } else { nM = TC / 256; pmbase = TL / 256; ksplit = 4; mode = M_RES1K; valid = (layer == 0); }
        }
        else if (sub == 6) { A = (const gbf16*)(ws + WS_HN); Bt = (const gbf16*)(ws + WS_W1); K = D; nM = M / 256; nN = 16; mode = M_HID; valid = (j == 0); }
        else { A = (const gbf16*)(ws + WS_HID); Bt = (const gbf16*)(ws + WS_W2); K = DFF; nN = 4;
            if (j == 0) { nM = TL / 256; mode = M_RES2; } else { nM = TC / 256; pmbase = TL / 256; ksplit = 4; mode = M_RES2K; valid = (layer == 0); }
        }
        if (valid && !(skip & 1)) { Sched S; S.init(nM, nN, G, cc); S.pmadd = pmadd; S.pmbase = pmbase; S.ksplit = ksplit; S.kbytes = (K / ksplit) * 2; int tj = tid; asm volatile("" : "+v"(tj)); run_gemm(lds, A, Bt, K, ksplit > 1 ? K / ksplit : 0, S, mode, layer, p, tj); }
    }
    if (sub == 2) {
        const int natt = (skip & 4) ? 0 : (layer == 0 ? 288 : 256), nconv = (skip & 2) ? 0 : (layer == 0 ? 288 : 256);
        unsigned* ctr = (unsigned*)(p.ws() + WS_CTL) + 64 * layer + 16 * (skip != 0);
        LAS int* slot = (LAS int*)(lds + LDSP_OFF + 512);
#pragma unroll 1
        for (;;) {
            __syncthreads();
            if (tid == 0) *slot = (int)__hip_atomic_fetch_add(ctr, 1u, __ATOMIC_RELAXED, __HIP_MEMORY_SCOPE_AGENT);
            __syncthreads();
            const int it = __builtin_amdgcn_readfirstlane(*slot);
            if (it >= natt + nconv) break;
            if (it < natt) {
                if (it < 256) attn_item(p, layer, it >> 5, (it >> 5) * SEQ + (it & 31) * 64, 16, it & 31, lds, tid, c);
                else { const int i2 = it - 256; attn_item(p, layer, i2 >> 2, TL + (i2 >> 2) * CTX + (i2 & 3) * 64, 0, 0, lds, tid, c); }
            } else {
                const int ic = it - natt; const bool lat = ic < 256; const int i2 = ic - 256;
                conv_tile(p, layer, lat ? (ic >> 5) * SEQ : TL + (i2 >> 2) * CTX, lat ? SEQ : CTX, lat ? (ic & 31) * 64 : (i2 & 3) * 64, lds, tid, c);
            }
        }
    }
}

__global__ void __launch_bounds__(512, 2) fwd_kernel(Params prm) {
    extern __shared__ __attribute__((aligned(16))) unsigned char lds_raw[];
    LAS unsigned char* lds = (LAS unsigned char*)lds_raw;
    {
        const unsigned long long* ka = (const unsigned long long*)__builtin_amdgcn_kernarg_segment_ptr();
        if (threadIdx.x < 23) ((LAS unsigned long long*)(lds + LDSP_OFF))[threadIdx.x] = ka[threadIdx.x];
    }
    __syncthreads();
    PP p; p.P = (const LAS unsigned long long*)(lds + LDSP_OFF);
    if (threadIdx.x < 2) ((LAS unsigned*)(lds + LDSP_OFF + 1024))[threadIdx.x] = 0u;
    __syncthreads();
    const XcdBarrier xbar = xcd_barrier_post((unsigned*)(prm.ws + WS_CTL) + 4096, (volatile LAS unsigned*)(lds + LDSP_OFF + 1024));
    const int lo = prm.ph_lo, hi = prm.ph_hi;
    const int wave_s = __builtin_amdgcn_readfirstlane((int)threadIdx.x >> 6);
#pragma unroll 1
    for (int ph = lo; ph < hi; ++ph) {
        if (ph > lo) { if (hi < 0) cg::this_grid().sync(); else xcd_barrier(xbar); }
        int lane_; asm volatile("v_mbcnt_lo_u32_b32 %0, -1, 0\n\tv_mbcnt_hi_u32_b32 %0, -1, %0" : "=v"(lane_));
        int tid = wave_s * 64 + lane_, bid = blockIdx.x;
        asm volatile("" : "+s"(bid));
        run_phase(p, ph, lds, tid, bid);
        __syncthreads();
#ifdef PROBE_REPEAT
        if ((PROBE_REPEAT >> ph) & 1) { xcd_barrier(xbar); run_phase(p, ph, lds, tid, bid, PROBE_SKIP); __syncthreads(); }
#endif
    }
}

extern "C" void kernel_launch(void* const* d_in, const int* in_sizes, int n_in, void* d_out, int out_size, void* d_ws, size_t ws_size, hipStream_t stream) {
    static int grid = 0;
    if (grid == 0) {
        if (n_in != 21 || ws_size < WS_SIDE + 24 * MiB) { fprintf(stderr, "kernel_launch: unexpected n_in %d / ws_size %zu\n", n_in, ws_size); grid = -1; return; }
        int dev = 0, cus = 0, per_cu = 0;
        (void)hipGetDevice(&dev); (void)hipDeviceGetAttribute(&cus, hipDeviceAttributeMultiprocessorCount, dev);
        (void)hipFuncSetAttribute((const void*)fwd_kernel, hipFuncAttributeMaxDynamicSharedMemorySize, LDS_BYTES);
        (void)hipOccupancyMaxActiveBlocksPerMultiprocessor(&per_cu, (const void*)fwd_kernel, 512, LDS_BYTES);
        if (per_cu < 1) { fprintf(stderr, "kernel_launch: occupancy query says %d blocks/CU\n", per_cu); per_cu = 1; }
        (void)hipGetLastError();
        grid = cus > 0 ? cus : 256;
    }
    if (grid < 0) return;
    (void)hipMemsetAsync((char*)d_ws + WS_CTL, 0, 65536, stream);
    Params p{};
    for (int i = 0; i < 21; ++i) p.in[i] = (const float*)d_in[i];
    p.out = (float*)d_out; p.ws = (unsigned char*)d_ws;
#if SINGLE_LAUNCH
    p.ph_lo = 0; p.ph_hi = NPH;
    void* args[] = {&p};
    hipError_t e = hipLaunchCooperativeKernel((const void*)fwd_kernel, dim3(grid), dim3(512), args, LDS_BYTES, stream);
    if (e != hipSuccess) fprintf(stderr, "cooperative launch failed: %s (grid %d)\n", hipGetErrorString(e), grid);
#else
    for (int ph = 0; ph < NPH; ++ph) { p.ph_lo = ph; p.ph_hi = ph + 1; hipLaunchKernelGGL(fwd_kernel, dim3(grid), dim3(512), LDS_BYTES, stream, p); }
#endif
}
```

```cpp
#include <hip/hip_runtime.h>
#include <hip/hip_cooperative_groups.h>
#include <cstdio>
#include <cstdint>
namespace cg = cooperative_groups;
namespace pg8 {
#define PG8_LAS __attribute__((address_space(3)))
typedef unsigned short bf16_t;
typedef short bf16x8 __attribute__((ext_vector_type(8)));
typedef float f32x4 __attribute__((ext_vector_type(4)));
typedef unsigned u32x4 __attribute__((ext_vector_type(4)));
constexpr int BM = 256, BK = 64, HALF = 128, HTB = HALF * BK * 2  , STAGE_BYTES = 8 * HTB, NXCD = 8, WGM = 8;

__host__ __device__ __forceinline__ int lds_byte(int r, int c) { const int st = (r >> 4) * 2 + (c >> 5), rr = r & 15, cc = c & 31, ob = rr * 64 + cc * 2; return st * 1024 + (ob ^ (((ob >> 9) & 1) << 5)); }
__host__ __device__ __forceinline__ void stage_rc(int b, int& R, int& C) { const int st = b / 1024, sb = b % 1024, swz = sb ^ (((sb >> 9) & 1) << 5); R = (st >> 1) * 16 + swz / 64; C = (st & 1) * 32 + (swz % 64) / 2; }
__host__ __device__ __forceinline__ int perm32(int rho) { const int n = rho >> 4, i = rho & 15; return 8 * (i >> 2) + 4 * n + (i & 3); }

struct Unit { int pm, pn, ko; };
struct Gemm { const bf16_t* A; const bf16_t* Bt; int M, N, K; };

struct StaticOrder {
    int nM, nN, nwg, G, c;
    __host__ __device__ void init(int M, int N, int G_, int c_) { nM = M / BM; nN = N / BM; nwg = nM * nN; G = G_; c = c_; }
    __host__ __device__ bool next(int i, Unit& u) const {
        const long L = (long)i * G + c; if (L >= nwg) return false;
        int wgid = (int)L; { const int q = nwg / NXCD, r = nwg % NXCD, xcd = wgid % NXCD, off = wgid / NXCD; wgid = (xcd < r ? xcd * (q + 1) : r * (q + 1) + (xcd - r) * q) + off; }
        const int nig = WGM * nN, gid = wgid / nig, fm = gid * WGM, gsz = (nM - fm) < WGM ? (nM - fm) : WGM;
        u.pm = fm + ((wgid % nig) % gsz); u.pn = (wgid % nig) / gsz; u.ko = 0; return true;
    }
    __device__ __forceinline__ void a_ready(const Unit&) const {}
    __device__ __forceinline__ void done(const Unit&) const {}
};

template <class Epi, class Sched, bool ALIGN_EPI = false, bool SP2 = false>
__device__ __forceinline__ void gemm_phase(PG8_LAS unsigned char* lds, const Gemm g, const Sched& S, const Epi& E, const int tid_in) {
    const int tid = tid_in, wid = __builtin_amdgcn_readfirstlane(tid >> 6), lane = tid & 63, wr = wid >> 2, wc = wid & 3, fr = lane & 15, fq = lane >> 4;
    const int K = g.K, nt = (g.M ? g.M : K) / BK;
    unsigned voffA[2], voffB[2];
#pragma unroll
    for (int i = 0; i < 2; ++i) { int R, C; stage_rc(tid * 16 + i * 8192, R, C); const int Rb = Epi::PERM ? ((R & ~31) + perm32(R & 31)) : R;
        voffA[i] = (unsigned)(R * K + C) * 2u; voffB[i] = (unsigned)(Rb * K + C) * 2u; }
    const size_t kstep = (size_t)(BK * 2);
    const size_t hstep = (size_t)HALF * K * 2;
    const size_t tstep = 2 * hstep;
    const unsigned ldsw = (unsigned)wid * 1024u;
    const int aoff = lds_byte(wr * 64 + fr, fq * 8), boff = lds_byte(wc * 32 + fr, fq * 8);
#define PG8_SA(b, h) (((b) * 2 + (h)) * HTB)
#define PG8_SB(b, h) ((4 + (b) * 2 + (h)) * HTB)
#define PG8_STAGE(bufoff, gbase, voff) do { _Pragma("unroll") for (int _i = 0; _i < 2; ++_i) \
        __builtin_amdgcn_global_load_lds((const unsigned*)((const char*)(gbase) + (voff)[_i]), (PG8_LAS unsigned*)(lds + (bufoff) + ldsw + _i * 8192), 16, 0, 0); } while (0)
#define PG8_LDA(dst, b, h) do { _Pragma("unroll") for (int m = 0; m < 4; ++m) _Pragma("unroll") for (int k = 0; k < 2; ++k) dst[m][k] = *(const PG8_LAS bf16x8*)(lds + PG8_SA(b, h) + aoff + m * 2048 + k * 1024); } while (0)
#define PG8_LDB(dst, b, h) do { _Pragma("unroll") for (int n = 0; n < 2; ++n) _Pragma("unroll") for (int k = 0; k < 2; ++k) dst[n][k] = *(const PG8_LAS bf16x8*)(lds + PG8_SB(b, h) + boff + n * 2048 + k * 1024); } while (0)
#define PG8_MMA(ai, bj, At, Bt) do { __builtin_amdgcn_s_setprio(1); _Pragma("unroll") for (int m = 0; m < 4; ++m) _Pragma("unroll") for (int n = 0; n < 2; ++n) _Pragma("unroll") for (int k = 0; k < 2; ++k) \
        acc[ai][bj][m][n] = __builtin_amdgcn_mfma_f32_16x16x32_bf16(Bt[n][k], At[m][k], acc[ai][bj][m][n], 0, 0, 0); __builtin_amdgcn_s_setprio(0); } while (0)
#define PG8_WAIT_V(n) asm volatile("s_waitcnt vmcnt(" #n ")" ::: "memory")
#define PG8_WAIT_L(n) asm volatile("s_waitcnt lgkmcnt(" #n ")" ::: "memory")
#define PG8_BAR __builtin_amdgcn_s_barrier()
#define PG8_SCHED __builtin_amdgcn_sched_barrier(0)
    Unit cur, nxt; int ui = 0;
    if (!S.next(0, cur)) return;
    f32x4 acc[2][2][4][2];
#pragma unroll
    for (int a = 0; a < 2; ++a)
#pragma unroll
        for (int b = 0; b < 2; ++b)
#pragma unroll
            for (int m = 0; m < 4; ++m)
#pragma unroll
                for (int n = 0; n < 2; ++n) acc[a][b][m][n] = (f32x4){0.f, 0.f, 0.f, 0.f};
    bf16x8 At[4][2], B0[2][2], B1[2][2];
    const char* cA = (const char*)g.A + (size_t)cur.pm * tstep + cur.ko; const char* cB = (const char*)g.Bt + (size_t)cur.pn * tstep + cur.ko;
    S.a_ready(cur);
    if constexpr (SP2) {
        PG8_STAGE(PG8_SB(0, 0), cB, voffB); PG8_STAGE(PG8_SB(0, 1), cB + hstep, voffB); PG8_STAGE(PG8_SA(0, 0), cA, voffA); PG8_STAGE(PG8_SA(0, 1), cA + hstep, voffA);
        if (wr == 1) PG8_BAR;
        PG8_WAIT_V(2); PG8_BAR;
        PG8_STAGE(PG8_SB(1, 0), cB + kstep, voffB); PG8_STAGE(PG8_SA(1, 0), cA + kstep, voffA); PG8_STAGE(PG8_SB(1, 1), cB + hstep + kstep, voffB);
        PG8_WAIT_V(6); PG8_BAR;
    } else {
        PG8_STAGE(PG8_SB(0, 0), cB, voffB); PG8_STAGE(PG8_SA(0, 0), cA, voffA); PG8_STAGE(PG8_SB(0, 1), cB + hstep, voffB); PG8_STAGE(PG8_SA(0, 1), cA + hstep, voffA);
        if (wr == 1) PG8_BAR;
        PG8_WAIT_V(4); PG8_BAR;
        PG8_STAGE(PG8_SB(1, 0), cB + kstep, voffB); PG8_STAGE(PG8_SA(1, 0), cA + kstep, voffA); PG8_STAGE(PG8_SB(1, 1), cB + hstep + kstep, voffB);
        PG8_WAIT_V(6); PG8_BAR;
    }
    for (;;) {
        const bool has_next = S.next(ui + 1, nxt);
        const char* nA = has_next ? (const char*)g.A + (size_t)nxt.pm * tstep + nxt.ko : cA; const char* nB = has_next ? (const char*)g.Bt + (size_t)nxt.pn * tstep + nxt.ko : cB;
        for (int t = 0; t < nt; t += 2) {
            const bool last = (t == nt - 2);
            const char* a1 = cA + (size_t)(t + 1) * kstep;
            const char* a2 = last ? nA : cA + (size_t)(t + 2) * kstep; const char* b2 = last ? nB : cB + (size_t)(t + 2) * kstep;
            const char* a3 = a2 + kstep; const char* b3 = b2 + kstep;
            if (last && has_next) S.a_ready(nxt);
            if constexpr (SP2) {
            PG8_LDB(B0, 0, 0); PG8_LDB(B1, 0, 1); PG8_SCHED; PG8_LDA(At, 0, 0); PG8_STAGE(PG8_SA(1, 1), a1 + hstep, voffA);
            PG8_WAIT_V(8); PG8_WAIT_L(0); PG8_BAR; PG8_MMA(0, 0, At, B0); PG8_MMA(0, 1, At, B1); PG8_BAR; PG8_SCHED;
            PG8_LDA(At, 0, 1); PG8_STAGE(PG8_SB(0, 0), b2, voffB); PG8_STAGE(PG8_SB(0, 1), b2 + hstep, voffB); PG8_STAGE(PG8_SA(0, 0), a2, voffA);
            PG8_WAIT_V(8); PG8_WAIT_L(0); PG8_BAR; PG8_MMA(1, 0, At, B0); PG8_MMA(1, 1, At, B1); PG8_BAR; PG8_SCHED;
            PG8_LDB(B0, 1, 0); PG8_LDB(B1, 1, 1); PG8_SCHED; PG8_LDA(At, 1, 0); PG8_STAGE(PG8_SA(0, 1), a2 + hstep, voffA);
            PG8_WAIT_V(8); PG8_WAIT_L(0); PG8_BAR; PG8_MMA(0, 0, At, B0); PG8_MMA(0, 1, At, B1); PG8_BAR; PG8_SCHED;
            PG8_LDA(At, 1, 1); PG8_STAGE(PG8_SB(1, 0), b3, voffB); PG8_STAGE(PG8_SB(1, 1), b3 + hstep, voffB); PG8_STAGE(PG8_SA(1, 0), a3, voffA);
            PG8_WAIT_V(8); PG8_WAIT_L(0); PG8_BAR; PG8_MMA(1, 0, At, B0); PG8_MMA(1, 1, At, B1); PG8_BAR; PG8_SCHED;
            } else {
            PG8_LDB(B0, 0, 0); PG8_SCHED; PG8_LDA(At, 0, 0); PG8_STAGE(PG8_SA(1, 1), a1 + hstep, voffA);
            PG8_WAIT_L(8); PG8_BAR; PG8_WAIT_L(0); PG8_MMA(0, 0, At, B0); PG8_BAR; PG8_SCHED;
            PG8_LDB(B1, 0, 1); PG8_STAGE(PG8_SB(0, 0), b2, voffB);
            PG8_BAR; PG8_WAIT_L(0); PG8_MMA(0, 1, At, B1); PG8_BAR;
            PG8_LDA(At, 0, 1); PG8_STAGE(PG8_SA(0, 0), a2, voffA);
            PG8_BAR; PG8_WAIT_L(0); PG8_MMA(1, 0, At, B0); PG8_BAR; PG8_SCHED;
            PG8_STAGE(PG8_SB(0, 1), b2 + hstep, voffB);
            PG8_WAIT_V(6); PG8_BAR; PG8_MMA(1, 1, At, B1); PG8_BAR;
            PG8_LDB(B0, 1, 0); PG8_SCHED; PG8_LDA(At, 1, 0); PG8_STAGE(PG8_SA(0, 1), a2 + hstep, voffA);
            PG8_WAIT_L(8); PG8_BAR; PG8_WAIT_L(0); PG8_MMA(0, 0, At, B0); PG8_BAR; PG8_SCHED;
            PG8_LDB(B1, 1, 1); PG8_STAGE(PG8_SB(1, 0), b3, voffB);
            PG8_BAR; PG8_WAIT_L(0); PG8_MMA(0, 1, At, B1); PG8_BAR;
            PG8_LDA(At, 1, 1); PG8_STAGE(PG8_SA(1, 0), a3, voffA);
            PG8_BAR; PG8_WAIT_L(0); PG8_MMA(1, 0, At, B0); PG8_BAR; PG8_SCHED;
            PG8_STAGE(PG8_SB(1, 1), b3 + hstep, voffB);
            PG8_WAIT_V(6); PG8_BAR; PG8_MMA(1, 1, At, B1); PG8_BAR;
            }
        }
        if constexpr (ALIGN_EPI) { if (wr == 0) PG8_BAR; }
        if constexpr (!Epi::AFTER_DRAIN) { E(acc, cur, wr, wc, fr, fq); S.done(cur); }
        if (!has_next) break;
#pragma unroll
        for (int a = 0; a < 2; ++a)
#pragma unroll
            for (int b = 0; b < 2; ++b)
#pragma unroll
                for (int m = 0; m < 4; ++m)
#pragma unroll
                    for (int n = 0; n < 2; ++n) acc[a][b][m][n] = (f32x4){0.f, 0.f, 0.f, 0.f};
        cur = nxt; cA = nA; cB = nB; ++ui;
        if constexpr (ALIGN_EPI) { if (wr == 1) PG8_BAR; }
    }
    PG8_WAIT_V(0);
    if constexpr (!ALIGN_EPI) { if (wr == 0) PG8_BAR; }
    PG8_BAR;
    if constexpr (Epi::AFTER_DRAIN) { E.fused(acc, cur, wr, wc, fr, fq, lds, wid, lane); S.done(cur); }
#undef PG8_SA
#undef PG8_SB
#undef PG8_STAGE
#undef PG8_LDA
#undef PG8_LDB
#undef PG8_MMA
#undef PG8_WAIT_V
#undef PG8_WAIT_L
#undef PG8_BAR
#undef PG8_SCHED
}
}

#define LAS __attribute__((address_space(3)))
#define DI __device__ __forceinline__
typedef unsigned short bf16;
typedef short bf16x8 __attribute__((ext_vector_type(8)));
typedef short s16x4 __attribute__((ext_vector_type(4)));
typedef float f32x4 __attribute__((ext_vector_type(4)));
typedef float f32x16 __attribute__((ext_vector_type(16)));
typedef unsigned u32x4 __attribute__((ext_vector_type(4)));
typedef unsigned u32x2 __attribute__((ext_vector_type(2)));
typedef __bf16 bf16x2_t __attribute__((ext_vector_type(2)));
typedef float f32x2_t __attribute__((ext_vector_type(2)));
#define GAS __attribute__((address_space(1)))
typedef GAS float gfloat; typedef GAS unsigned short gbf16; typedef GAS char gchar; typedef GAS unsigned char guchar;

#ifndef SINGLE_LAUNCH
#define SINGLE_LAUNCH 1
#endif

constexpr int D = 1024, NB = 8, SEQ = 2048, CTX = 256, TL = NB * SEQ, TC = NB * CTX, TA = TL + TC;
constexpr int DIN = 2304, DFF = 4096, URM = 1024;
constexpr int NPH = 18;
constexpr int LDS_BYTES = 147456;
constexpr size_t MiB = 1u << 20;
constexpr size_t WS_CTL = 0, WS_MODS = 1 * MiB;
constexpr size_t WS_WIN = 2 * MiB, WS_WOUT = WS_WIN + (size_t)DIN * D * 2, WS_W1 = WS_WOUT + 2 * MiB, WS_W2 = WS_W1 + 8 * MiB, WS_WPW = WS_W2 + 8 * MiB, WS_WF2 = WS_WPW + 128 * 1024;
constexpr size_t WS_DFTL = 25 * MiB, WS_DFTC = 41 * MiB, WS_HCTX = 42 * MiB, WS_HN = 50 * MiB, WS_OV = 86 * MiB;
constexpr size_t WS_URM = WS_OV, WS_UTL = WS_OV + 36 * MiB, WS_UTC = WS_UTL + 8 * MiB, WS_KT = WS_UTC + 1 * MiB, WS_VT = WS_KT + 18 * MiB,
                 WS_G12 = WS_VT + 18 * MiB, WS_CVA = WS_G12 + 18 * MiB, WS_MIX = WS_CVA + 9 * MiB, WS_HID = WS_OV, WS_END = WS_OV + 144 * MiB;
constexpr size_t WS_SIDE = WS_END;
static_assert(WS_SIDE + 24 * MiB <= 256 * MiB, "side buffers");
static_assert(WS_WF2 + 256 * 1024 <= WS_DFTL && WS_MIX + 36 * MiB == WS_END && WS_END <= 256 * MiB, "ws map");

struct Params { const float* in[21]; float* out; unsigned char* ws; int ph_lo, ph_hi; };
constexpr int LDSP_OFF = 131072;
struct PP {
    const __attribute__((address_space(3))) unsigned long long* P;
    __device__ __forceinline__ unsigned long long ld(int i) const { const unsigned long long v = P[i]; const unsigned lo = __builtin_amdgcn_readfirstlane((unsigned)v), hi = __builtin_amdgcn_readfirstlane((unsigned)(v >> 32)); return ((unsigned long long)hi << 32) | lo; }
    __device__ __forceinline__ const gfloat* in(int i) const { return (const gfloat*)ld(i); }
    __device__ __forceinline__ gfloat* out() const { return (gfloat*)ld(21); }
    __device__ __forceinline__ unsigned char* ws() const { return (unsigned char*)ld(22); }
};

DI unsigned pk2(float lo, float hi) { f32x2_t v = {lo, hi}; bf16x2_t b = __builtin_convertvector(v, bf16x2_t); return __builtin_bit_cast(unsigned, b); }
DI float bf2f(short x) { return __builtin_bit_cast(float, ((unsigned)(unsigned short)x) << 16); }
DI float wave_sum(float v) {
#pragma unroll
    for (int o = 1; o < 64; o <<= 1) v += __shfl_xor(v, o);
    return v;
}
#define LDS_WAIT() asm volatile("s_waitcnt lgkmcnt(0)" ::: "memory")

struct Sched {
    int nM, nN, nwg, G, c, pmadd, pmbase, ksplit, kbytes;
    DI void init(int nM_, int nN_, int G_, int c_) { nM = nM_; nN = nN_; nwg = nM_ * nN_; G = G_; c = c_; pmadd = 0; pmbase = 0; ksplit = 1; kbytes = 0; }
    DI bool next(int i, pg8::Unit& u) const {
        const long L = (long)i * G + c; if (L >= (long)nwg * ksplit) return false;
        int wgid = (int)L; u.ko = 0;
        if (ksplit > 1) { u.ko = (wgid % ksplit) * kbytes; wgid /= ksplit; }
        else { const int q = nwg / 8, r = nwg % 8, xcd = wgid % 8, off = wgid / 8; wgid = (xcd < r ? xcd * (q + 1) : r * (q + 1) + (xcd - r) * q) + off; }
        const int nig = 8 * nN, gid = wgid / nig, fm = gid * 8, gsz = (nM - fm) < 8 ? (nM - fm) : 8;
        u.pm = fm + ((wgid % nig) % gsz); u.pn = (wgid % nig) / gsz;
        if (u.pm > 0) u.pm += pmadd;
        u.pm += pmbase;
        return true;
    }
    DI void a_ready(const pg8::Unit&) const {}
    DI void done(const pg8::Unit&) const {}
};

template <int ACT> DI void store_tile_bf16(const pg8::f32x4 (&acc)[2][2][4][2], gbf16* base, int ld, const gfloat* bias, int wr, int wc, int fr, int fq) {
    const unsigned loff = (unsigned)((wr * 64 + fr) * ld + wc * 32 + 8 * fq) * 2u;
    f32x4 bv[2][2];
#pragma unroll
    for (int bj = 0; bj < 2; ++bj)
#pragma unroll
        for (int n = 0; n < 2; ++n) bv[bj][n] = bias ? *(const GAS f32x4*)(bias + wc * 32 + 8 * fq + bj * 128 + 4 * n) : (f32x4){0.f, 0.f, 0.f, 0.f};
#pragma unroll
    for (int ai = 0; ai < 2; ++ai)
#pragma unroll
        for (int m = 0; m < 4; ++m) { gchar* rowp = (gchar*)base + (size_t)((ai * 128 + m * 16) * ld) * 2u;
#pragma unroll
            for (int bj = 0; bj < 2; ++bj) { f32x4 a = acc[ai][bj][m][0] + bv[bj][0], b = acc[ai][bj][m][1] + bv[bj][1];
                if (ACT == 1) {
#pragma unroll
                    for (int e = 0; e < 4; ++e) { const float x = fmaxf(a[e], 0.f); a[e] = x * x; const float y = fmaxf(b[e], 0.f); b[e] = y * y; } }
                u32x4 w; w.x = pk2(a.x, a.y); w.y = pk2(a.z, a.w); w.z = pk2(b.x, b.y); w.w = pk2(b.z, b.w);
                *(GAS u32x4*)(rowp + bj * 256 + loff) = w; } }
}
DI void store_kfrag(const pg8::f32x4 (&acc)[2][2][4][2], gbf16* base, int wr, int wc, int fr, int fq) {
    const unsigned loff = (unsigned)(wr * 2 * 16384 + (wc >> 1) * 2048 + fq * 512 + (wc & 1) * 256 + fr * 8) * 2u;
#pragma unroll
    for (int ai = 0; ai < 2; ++ai)
#pragma unroll
        for (int m = 0; m < 4; ++m)
#pragma unroll
            for (int bj = 0; bj < 2; ++bj) { const f32x4 a = acc[ai][bj][m][0], b = acc[ai][bj][m][1];
                u32x4 w; w.x = pk2(a.x, a.y); w.y = pk2(a.z, a.w); w.z = pk2(b.x, b.y); w.w = pk2(b.z, b.w);
                *(GAS u32x4*)((gchar*)base + (size_t)((ai * 4 + (m >> 1)) * 16384 + bj * 2 * 2048 + (m & 1) * 128) * 2u + loff) = w; }
}
DI void store_vfrag(const pg8::f32x4 (&acc)[2][2][4][2], gbf16* base, int wr, int wc, int fr, int fq) {
    const unsigned loff = (unsigned)(wc * 8 * 2048 + wr * 2048 + (fq >> 1) * 512 + fr * 8 + (fq & 1) * 4) * 2u;
#pragma unroll
    for (int ai = 0; ai < 2; ++ai)
#pragma unroll
        for (int m = 0; m < 4; ++m)
#pragma unroll
            for (int bj = 0; bj < 2; ++bj) { const f32x4 a = acc[ai][bj][m][0], b = acc[ai][bj][m][1];
                gchar* q = (gchar*)base + (size_t)(bj * 32 * 2048 + ai * 2 * 2048 + (m >> 1) * 1024 + (m & 1) * 128) * 2u + loff;
                u32x2 w0; w0.x = pk2(a.x, a.y); w0.y = pk2(a.z, a.w); u32x2 w1; w1.x = pk2(b.x, b.y); w1.y = pk2(b.z, b.w);
                *(GAS u32x2*)q = w0; *(GAS u32x2*)(q + 512) = w1; }
}
enum { M_URM = 0, M_SWAP, M_DFTL, M_DFTC, M_MIXF, M_MIXC, M_RES1, M_RES2, M_HID, M_RES1K, M_RES2K };
struct UEpi {
    static constexpr bool PERM = true, AFTER_DRAIN = false;
    int mode, layer; PP p;
    DI void operator()(const pg8::f32x4 (&acc)[2][2][4][2], const pg8::Unit& u, int wr, int wc, int fr, int fq) const {
        unsigned char* ws = p.ws();
        if (mode == M_RES1K || mode == M_RES2K) {
            const int kc = u.ko / (mode == M_RES1K ? (D / 4) * 2 : (DFF / 4) * 2);
            const int r2 = u.pm * 256 - TL;
            const gfloat* srcb = (mode == M_RES1K && layer == 0) ? p.in(2) : (const gfloat*)(ws + WS_HCTX);
            const gchar* sp = (const gchar*)(srcb + (size_t)r2 * D + u.pn * 256);
            gchar* d = (gchar*)((gfloat*)(ws + (kc == 0 ? WS_HCTX : WS_SIDE + (size_t)(kc - 1) * 8 * MiB)) + (size_t)r2 * D + u.pn * 256);
            const gfloat* gp = (const gfloat*)(ws + WS_MODS) + (size_t)layer * 9 * 6144 + (mode == M_RES1K ? 2 : 5) * D + 8 * 6144 + u.pn * 256 + wc * 32 + 8 * fq;
            const unsigned loff = (unsigned)((wr * 64 + fr) * D + wc * 32 + 8 * fq) * 4u;
            f32x4 gv[2][2];
#pragma unroll
            for (int bj = 0; bj < 2; ++bj)
#pragma unroll
                for (int n = 0; n < 2; ++n) gv[bj][n] = *(const GAS f32x4*)(gp + bj * 128 + 4 * n);
#pragma unroll
            for (int ai = 0; ai < 2; ++ai)
#pragma unroll
                for (int m = 0; m < 4; ++m) { const size_t ro = (size_t)((ai * 128 + m * 16) * D) * 4u;
#pragma unroll
                    for (int bj = 0; bj < 2; ++bj) {
                        f32x4 x0 = (f32x4){0.f, 0.f, 0.f, 0.f}, x1 = x0;
                        if (kc == 0) { x0 = *(const GAS f32x4*)(sp + ro + bj * 512 + loff); x1 = *(const GAS f32x4*)(sp + ro + bj * 512 + 16 + loff); }
                        *(GAS f32x4*)(d + ro + bj * 512 + loff) = x0 + gv[bj][0] * acc[ai][bj][m][0];
                        *(GAS f32x4*)(d + ro + bj * 512 + 16 + loff) = x1 + gv[bj][1] * acc[ai][bj][m][1]; } }
            return;
        }
        if (mode == M_RES1 || mode == M_RES2) {
            const bool first = (mode == M_RES1 && layer == 0);
            const int row0 = u.pm * 256; const bool lat = row0 < TL; const int r2 = lat ? row0 : row0 - TL, midx = lat ? (row0 >> 11) : 8;
            const gfloat* srcb = lat ? (first ? p.in(0) : (const gfloat*)p.out()) : (first ? p.in(2) : (const gfloat*)(ws + WS_HCTX));
            gfloat* dstb = lat ? p.out() : (gfloat*)(ws + WS_HCTX);
            const gchar* s = (const gchar*)(srcb + (size_t)r2 * D + u.pn * 256);
            gchar* d = (gchar*)(dstb + (size_t)r2 * D + u.pn * 256);
            const gfloat* gp = (const gfloat*)(ws + WS_MODS) + (size_t)layer * 9 * 6144 + (mode == M_RES1 ? 2 : 5) * D + midx * 6144 + u.pn * 256 + wc * 32 + 8 * fq;
            const unsigned loff = (unsigned)((wr * 64 + fr) * D + wc * 32 + 8 * fq) * 4u;
            f32x4 gv[2][2];
#pragma unroll
            for (int bj = 0; bj < 2; ++bj)
#pragma unroll
                for (int n = 0; n < 2; ++n) gv[bj][n] = *(const GAS f32x4*)(gp + bj * 128 + 4 * n);
#pragma unroll
            for (int ai = 0; ai < 2; ++ai)
#pragma unroll
                for (int m = 0; m < 4; ++m) { const size_t ro = (size_t)((ai * 128 + m * 16) * D) * 4u;
#pragma unroll
                    for (int bj = 0; bj < 2; ++bj) {
                        const f32x4 x0 = *(const GAS f32x4*)(s + ro + bj * 512 + loff), x1 = *(const GAS f32x4*)(s + ro + bj * 512 + 16 + loff);
                        *(GAS f32x4*)(d + ro + bj * 512 + loff) = x0 + gv[bj][0] * acc[ai][bj][m][0];
                        *(GAS f32x4*)(d + ro + bj * 512 + 16 + loff) = x1 + gv[bj][1] * acc[ai][bj][m][1]; } }
            return;
        }
        gbf16* base; int ld; const gfloat* bias = nullptr;
        if (mode == M_URM) {
            if (u.pn >= 4) { store_kfrag(acc, (gbf16*)(ws + WS_KT) + (size_t)(u.pm * 64 + (u.pn - 4) * 4) * 2048, wr, wc, fr, fq); return; }
            ld = URM; base = (gbf16*)(ws + WS_URM) + (size_t)(u.pm * 256) * URM + u.pn * 256; }
        else if (mode == M_HID) { ld = DFF; base = (gbf16*)(ws + WS_HID) + (size_t)(u.pm * 256) * DFF + u.pn * 256; }
        else if (mode == M_SWAP) {
            if (u.pm != 0) { store_vfrag(acc, (gbf16*)(ws + WS_VT) + (size_t)(u.pn * 64 + (u.pm - 7) * 4) * 2048, wr, wc, fr, fq); return; }
            const int tok0 = u.pn * 256; const bool lat = tok0 < TL;
            const int bb = lat ? (tok0 >> 11) : ((tok0 - TL) >> 8), l0 = lat ? (tok0 & (SEQ - 1)) : 0; ld = lat ? SEQ : CTX;
            base = (gbf16*)(ws + (lat ? WS_UTL : WS_UTC)) + (size_t)(bb * 256) * ld + l0;
        } else if (mode == M_DFTL || mode == M_DFTC) {
            const int L = mode == M_DFTL ? SEQ : CTX, lshift = mode == M_DFTL ? 11 : 8, rowbase = mode == M_DFTL ? 0 : TL;
            const int row0 = u.pm * 256, cs = row0 >> lshift, lp0 = row0 & (L - 1);
            ld = 512; base = (gbf16*)(ws + WS_G12) + (size_t)(rowbase + u.pn * L + lp0) * 512 + cs * 256;
        } else {
            ld = D; base = (gbf16*)(ws + WS_MIX) + (size_t)(u.pm * 256) * D + (mode == M_MIXC ? 256 : 0);
            if (mode == M_MIXC) bias = p.in(15) + layer * 256;
        }
        if (mode == M_HID) store_tile_bf16<1>(acc, base, ld, nullptr, wr, wc, fr, fq);
        else store_tile_bf16<0>(acc, base, ld, bias, wr, wc, fr, fq);
    }
};
DI void run_gemm(LAS unsigned char* lds, const gbf16* A, const gbf16* Bt, int K, int Kext, const Sched& S, int mode, int layer, PP p, const int tid) {
    pg8::Gemm g{(const bf16*)A, (const bf16*)Bt, Kext, 0, K}; UEpi e{mode, layer, p};
    pg8::gemm_phase<UEpi, Sched, true, true>(lds, g, S, e, tid);
}
#define XB_TMO      128
#define XB_XCNT(j)  (256  + 64 * (j))
#define XB_XSUB(j)  (1280 + 64 * (j))
#define XB_XGEN(j)  (2304 + 64 * (j))
#define XB_TOP      3328
#define XB_TOPGEN   3392
#define XCD_BAR_WORDS 3456
#define XB_SPIN_CAP (1u << 18)

__device__ __forceinline__ unsigned xb_ld(unsigned* p)              { return __hip_atomic_load(p, __ATOMIC_RELAXED, __HIP_MEMORY_SCOPE_AGENT); }
__device__ __forceinline__ unsigned xb_add(unsigned* p, unsigned v) { return __hip_atomic_fetch_add(p, v, __ATOMIC_RELAXED, __HIP_MEMORY_SCOPE_AGENT); }
__device__ __forceinline__ unsigned xb_xcc_id() { return (unsigned)__builtin_amdgcn_s_getreg((3 << 11) | 20) & 0xFu; }
#define XB_SPIN(cond, bar) do { unsigned _sp = 0; while (cond) { __builtin_amdgcn_s_sleep(1); \
    if ((++_sp & 255u) == 0u) { if (xb_ld(&(bar)[XB_TMO])) break; if (_sp > XB_SPIN_CAP) { atomicAdd(&(bar)[XB_TMO], 1u); break; } } } } while (0)

struct XcdBarrier {
    unsigned* bar; unsigned x;
    volatile LAS unsigned* st;
};

__device__ __forceinline__ XcdBarrier xcd_barrier_post(unsigned* bar, volatile LAS unsigned* st) {
    XcdBarrier b; b.bar = bar; b.x = xb_xcc_id(); b.st = st;
    if (threadIdx.x == 0) (void)xb_add(&bar[XB_XCNT(b.x)], 1u);
    return b;
}
__device__ __forceinline__ void xcd_barrier_complete(unsigned* bar, unsigned x, unsigned& nloc, unsigned& nx) {
    const unsigned G = gridDim.x * gridDim.y * gridDim.z;
    unsigned sum, cnt, mine, sp = 0u;
    for (;;) {
        sum = 0u; cnt = 0u; mine = 0u;
#pragma unroll
        for (unsigned j = 0; j < 16; ++j) { const unsigned c = xb_ld(&bar[XB_XCNT(j)]); sum += c; cnt += (c > 0u) ? 1u : 0u; mine = (j == x) ? c : mine; }
        if (sum == G) break;
        __builtin_amdgcn_s_sleep(1);
        if ((++sp & 255u) == 0u) { if (xb_ld(&bar[XB_TMO])) break; if (sp > XB_SPIN_CAP) { atomicAdd(&bar[XB_TMO], 1u); break; } }
    }
    nloc = mine > 0u ? mine : 1u; nx = cnt > 0u ? cnt : 1u;
}

__device__ __forceinline__ void xcd_barrier(const XcdBarrier& b) {
    asm volatile("s_waitcnt vmcnt(0)" ::: "memory");
    __syncthreads();
    if (threadIdx.x == 0) {
        unsigned* bar = b.bar;
        __builtin_amdgcn_s_waitcnt(0);
        unsigned nloc = b.st[0], nx = b.st[1];
        if (nloc == 0u) { xcd_barrier_complete(bar, b.x, nloc, nx); b.st[0] = nloc; b.st[1] = nx; }
        const unsigned old = xb_add(&bar[XB_XSUB(b.x)], 1u);
        const unsigned gen = old / nloc;
        if (old + 1u == (gen + 1u) * nloc) {
            __builtin_amdgcn_fence(__ATOMIC_RELEASE, "agent");
            asm volatile("s_waitcnt vmcnt(0)" ::: "memory");
            const unsigned og = xb_add(&bar[XB_TOP], 1u);
            const unsigned tg = og / nx;
            if (og + 1u == (tg + 1u) * nx) xb_add(&bar[XB_TOPGEN], 1u);
            else XB_SPIN(xb_ld(&bar[XB_TOPGEN]) == tg, bar);
            __builtin_amdgcn_fence(__ATOMIC_ACQUIRE, "agent");
            xb_add(&bar[XB_XGEN(b.x)], 1u);
            asm volatile("s_waitcnt vmcnt(0)" ::: "memory");
        } else {
            XB_SPIN(xb_ld(&bar[XB_XGEN(b.x)]) == gen, bar);
            __builtin_amdgcn_fence(__ATOMIC_ACQUIRE, "agent");
            asm volatile("s_waitcnt vmcnt(0)" ::: "memory");
        }
    }
    __syncthreads();
}

DI void phase_mods(const PP p, LAS unsigned char* lds, const int tid_, const int bid_) {
    const int tid = tid_, lane = tid & 63, wave = tid >> 6;
    LAS float* s = (LAS float*)lds;
    LAS float* red = (LAS float*)(lds + 36864);
    gfloat* mods = (gfloat*)(p.ws() + WS_MODS);
    for (int i = tid; i < 9 * 1024; i += 512) { const int j = i >> 10, k = i & 1023; const float v = j < 8 ? p.in(1)[j * 1024 + k] : p.in(3)[k]; s[i] = v / (1.f + expf(-v)); }
    __syncthreads();
    for (int item = bid_; item < 192; item += gridDim.x) {
        const int layer = item / 96, cgp = item % 96, col = cgp * 64 + lane;
        const gfloat* W = p.in(4) + (size_t)layer * 1024 * 6144 + col;
        float acc[9];
#pragma unroll
        for (int j = 0; j < 9; ++j) acc[j] = 0.f;
        const int k0 = wave * 128;
#pragma unroll 32
        for (int k = k0; k < k0 + 128; ++k) { const float w = W[(size_t)k * 6144];
#pragma unroll
            for (int j = 0; j < 9; ++j) acc[j] += s[j * 1024 + k] * w; }
#pragma unroll
        for (int j = 0; j < 9; ++j) red[(wave * 9 + j) * 64 + lane] = acc[j];
        __syncthreads();
        for (int t = tid; t < 576; t += 512) { const int j = t >> 6, l = t & 63; float v = p.in(5)[layer * 6144 + cgp * 64 + l];
#pragma unroll
            for (int w = 0; w < 8; ++w) v += red[(w * 9 + j) * 64 + l];
            mods[(size_t)(layer * 9 + j) * 6144 + cgp * 64 + l] = v; }
        __syncthreads();
    }
}
DI void make_tables(const PP p, const int tid_, const int bid_) {
    gbf16* DL = (gbf16*)(p.ws() + WS_DFTL); gbf16* DC = (gbf16*)(p.ws() + WS_DFTC);
    const int gt = bid_ * 512 + tid_, NT = gridDim.x * 512;
    for (int i = gt; i < 4096 * 256; i += NT) { const int row = i >> 8, l0 = (i & 255) * 8, cs = row >> 11, lp = row & 2047;
        float v[8]; float sn, cn, st, ct;
        sincospif((float)((lp * l0) & 2047) * (1.f / 1024.f), &sn, &cn); sincospif((float)lp * (1.f / 1024.f), &st, &ct);
#pragma unroll
        for (int e = 0; e < 8; ++e) { v[e] = (cs ? sn : cn) * 0.022097086912079608f; const float c2 = cn * ct - sn * st, s2 = sn * ct + cn * st; cn = c2; sn = s2; }
        u32x4 w; w.x = pk2(v[0], v[1]); w.y = pk2(v[2], v[3]); w.z = pk2(v[4], v[5]); w.w = pk2(v[6], v[7]);
        *(GAS u32x4*)(DL + (size_t)row * 2048 + l0) = w; }
    for (int i = gt; i < 512 * 32; i += NT) { const int row = i >> 5, l0 = (i & 31) * 8, cs = row >> 8, lp = row & 255;
        float v[8]; float sn, cn, st, ct;
        sincospif((float)((lp * l0) & 255) * (1.f / 128.f), &sn, &cn); sincospif((float)lp * (1.f / 128.f), &st, &ct);
#pragma unroll
        for (int e = 0; e < 8; ++e) { v[e] = (cs ? sn : cn) * 0.0625f; const float c2 = cn * ct - sn * st, s2 = sn * ct + cn * st; cn = c2; sn = s2; }
        u32x4 w; w.x = pk2(v[0], v[1]); w.y = pk2(v[2], v[3]); w.z = pk2(v[4], v[5]); w.w = pk2(v[6], v[7]);
        *(GAS u32x4*)(DC + (size_t)row * 256 + l0) = w; }
}
DI void transpose_item(const gfloat* W, int K, int N, gbf16* WT, LAS float* scr, int item, int lane) {
    const int nblk = N / 32, kb = item / nblk, nb = item % nblk, k0 = 64 * kb, n0 = 32 * nb;
    f32x4 wv[8];
#pragma unroll
    for (int i = 0; i < 8; ++i) wv[i] = *(const GAS f32x4*)(W + (size_t)(k0 + 8 * i + (lane >> 3)) * N + n0 + (lane & 7) * 4);
#pragma unroll
    for (int i = 0; i < 8; ++i) { LAS float* d = scr + (8 * i + (lane >> 3)) * 33 + (lane & 7) * 4; d[0] = wv[i].x; d[1] = wv[i].y; d[2] = wv[i].z; d[3] = wv[i].w; }
    LDS_WAIT(); asm volatile("" ::: "memory");
    const int c = lane & 7;
#pragma unroll
    for (int j = 0; j < 4; ++j) { const int n = (lane >> 3) + 8 * j; const LAS float* sp = scr + (8 * c) * 33 + n;
        u32x4 o; o.x = pk2(sp[0 * 33], sp[1 * 33]); o.y = pk2(sp[2 * 33], sp[3 * 33]); o.z = pk2(sp[4 * 33], sp[5 * 33]); o.w = pk2(sp[6 * 33], sp[7 * 33]);
        *(GAS u32x4*)(WT + (size_t)(n0 + n) * K + k0 + 8 * c) = o; }
    LDS_WAIT(); asm volatile("" ::: "memory");
}
DI void conv_weights(const PP p, int layer, LAS unsigned char* lds, const int tid_, const int bid_) {
    const int lane = tid_ & 63, wave = tid_ >> 6;
    LAS float* scr = (LAS float*)(lds + 57344 + wave * 8448);
    const int gw = bid_ * 8 + wave, NGW = gridDim.x * 8;
    const gfloat* Win = p.in(8) + (size_t)layer * D * DIN; const gfloat* Wout = p.in(17) + (size_t)layer * D * D;
    const gfloat* W1 = p.in(18) + (size_t)layer * D * DFF; const gfloat* W2 = p.in(19) + (size_t)layer * DFF * D; const gfloat* Wpw = p.in(14) + (size_t)layer * 256 * 256;
    gbf16* WinT = (gbf16*)(p.ws() + WS_WIN); gbf16* WoutT = (gbf16*)(p.ws() + WS_WOUT); gbf16* W1T = (gbf16*)(p.ws() + WS_W1); gbf16* W2T = (gbf16*)(p.ws() + WS_W2); gbf16* WpwT = (gbf16*)(p.ws() + WS_WPW);
    constexpr int I_IN = 16 * 72, I_OUT = 16 * 32, I_1 = 16 * 128, I_2 = 64 * 32, I_PW = 4 * 8, NIT = I_IN + I_OUT + I_1 + I_2 + I_PW;
    for (int it = gw; it < NIT; it += NGW) {
        int r = it;
        if (r < I_IN) { transpose_item(Win, D, DIN, WinT, scr, r, lane); continue; } r -= I_IN;
        if (r < I_OUT) { transpose_item(Wout, D, D, WoutT, scr, r, lane); continue; } r -= I_OUT;
        if (r < I_1) { transpose_item(W1, D, DFF, W1T, scr, r, lane); continue; } r -= I_1;
        if (r < I_2) { transpose_item(W2, DFF, D, W2T, scr, r, lane); continue; } r -= I_2;
        transpose_item(Wpw, 256, 256, WpwT, scr, r, lane);
    }
    const gfloat* Wf = p.in(9) + (size_t)layer * 256 * 256; gbf16* Wf2t = (gbf16*)(p.ws() + WS_WF2);
    for (int o = bid_ * 512 + tid_; o < 256 * 512; o += gridDim.x * 512) {
        const int n = o >> 9, k = o & 511, cs = k >> 8, g = (k >> 6) & 3, j = k & 63;
        float acc = 0.f, st, ct, sn = 0.f, cn = 1.f;
        sincospif((float)j * (1.f / 32.f), &st, &ct);
#pragma unroll 16
        for (int jp = 0; jp < 64; ++jp) { acc += (cs ? sn : cn) * Wf[(size_t)(g * 64 + jp) * 256 + n]; const float c2 = cn * ct - sn * st, s2 = sn * ct + cn * st; cn = c2; sn = s2; }
        acc *= cs ? -0.125f : 0.125f;
        Wf2t[(size_t)n * 512 + k] = (bf16)(pk2(acc, 0.f) & 0xffffu);
    }
}
DI void phase_norm(const PP p, int layer, int which, int nrows, const int tid_, const int bid_) {
    const int lane = tid_ & 63, wave = tid_ >> 6;
    const int gw = bid_ * 8 + wave, NGW = gridDim.x * 8;
    const bool first = (layer == 0 && which == 0);
    const gfloat* hl = first ? p.in(0) : p.out(); const gfloat* hc = first ? p.in(2) : (const gfloat*)(p.ws() + WS_HCTX);
    const gfloat* g = p.in(which ? 7 : 6) + layer * D;
    const gfloat* mods = (const gfloat*)(p.ws() + WS_MODS) + (size_t)layer * 9 * 6144 + (which ? 3 : 0) * D;
    gbf16* hn = (gbf16*)(p.ws() + WS_HN);
    for (int row = gw; row < nrows; row += NGW) {
        const gfloat* src = row < TL ? hl + (size_t)row * D : hc + (size_t)(row - TL) * D;
        const int midx = row < TL ? (row >> 11) : 8;
        f32x4 v[4]; float ss = 0.f;
#pragma unroll
        for (int jj = 0; jj < 4; ++jj) v[jj] = *(const GAS f32x4*)(src + 4 * (lane + 64 * jj));
        if (!first && row >= TL) {
            const gfloat* sd = (const gfloat*)(p.ws() + WS_SIDE) + (size_t)(row - TL) * D; gfloat* hw = (gfloat*)(p.ws() + WS_HCTX) + (size_t)(row - TL) * D;
#pragma unroll
            for (int jj = 0; jj < 4; ++jj) { const int k = 4 * (lane + 64 * jj);
                v[jj] += (*(const GAS f32x4*)(sd + k) + *(const GAS f32x4*)(sd + 2 * 1024 * 1024 + k)) + *(const GAS f32x4*)(sd + 4 * 1024 * 1024 + k);
                *(GAS f32x4*)(hw + k) = v[jj]; } }
#pragma unroll
        for (int jj = 0; jj < 4; ++jj) ss += (v[jj].x * v[jj].x + v[jj].y * v[jj].y) + (v[jj].z * v[jj].z + v[jj].w * v[jj].w);
        const float rinv = 1.f / sqrtf(wave_sum(ss) * (1.f / D) + 1e-6f);
#pragma unroll
        for (int jj = 0; jj < 4; ++jj) { const int k = 4 * (lane + 64 * jj);
            const f32x4 gg = *(const GAS f32x4*)(g + k), sh = *(const GAS f32x4*)(mods + midx * 6144 + k), sc = *(const GAS f32x4*)(mods + midx * 6144 + D + k);
            const f32x4 y = (v[jj] * rinv * gg) * (sc + 1.f) + sh;
            u32x2 w; w.x = pk2(y.x, y.y); w.y = pk2(y.z, y.w);
            *(GAS u32x2*)(hn + (size_t)row * D + k) = w; }
    }
}
DI void phase_final(const PP p, const int tid_, const int bid_) {
    const int lane = tid_ & 63, wave = tid_ >> 6;
    const int gw = bid_ * 8 + wave, NGW = gridDim.x * 8;
    const gfloat* g = p.in(20);
    for (int row = gw; row < TL; row += NGW) {
        gfloat* src = p.out() + (size_t)row * D;
        f32x4 v[4]; float ss = 0.f;
#pragma unroll
        for (int jj = 0; jj < 4; ++jj) { v[jj] = *(const GAS f32x4*)(src + 4 * (lane + 64 * jj)); ss += (v[jj].x * v[jj].x + v[jj].y * v[jj].y) + (v[jj].z * v[jj].z + v[jj].w * v[jj].w); }
        const float rinv = 1.f / sqrtf(wave_sum(ss) * (1.f / D) + 1e-6f);
#pragma unroll
        for (int jj = 0; jj < 4; ++jj) { const int k = 4 * (lane + 64 * jj); const f32x4 gg = *(const GAS f32x4*)(g + k); *(GAS f32x4*)(src + k) = v[jj] * rinv * gg; }
    }
}
DI void conv_tile(const PP p, int layer, int seqbase, int L, int t0, LAS unsigned char* lds, const int tid_, const int bid_) {
    int tid = tid_; asm volatile("" : "+v"(tid));
    const int lane = tid & 63;
    LAS float* vt = (LAS float*)lds;
    LAS float* red1 = (LAS float*)(lds + 98304);
    LAS float* red2 = (LAS float*)(lds + 98304 + 1024);
    const gbf16* Urm = (const gbf16*)(p.ws() + WS_URM);
    gbf16* cva = (gbf16*)(p.ws() + WS_CVA);
    __syncthreads();
    for (int idx = tid; idx < 94 * 32; idx += 512) { const int tt = idx >> 5, c8 = (idx & 31) * 8, pos = t0 - 15 + tt;
        float v[8];
        if (pos >= 0 && pos < L) { const gbf16* rp = Urm + (size_t)(seqbase + pos) * URM + c8; const bf16x8 a8 = *(const GAS bf16x8*)rp, g8 = *(const GAS bf16x8*)(rp + 256);
#pragma unroll
            for (int e = 0; e < 8; ++e) { const float a = bf2f(a8[e]), gt = bf2f(g8[e]); v[e] = a / (1.f + __expf(-gt)); } }
        else {
#pragma unroll
            for (int e = 0; e < 8; ++e) v[e] = 0.f; }
        *(LAS f32x4*)(vt + tt * 256 + c8) = (f32x4){v[0], v[1], v[2], v[3]}; *(LAS f32x4*)(vt + tt * 256 + c8 + 4) = (f32x4){v[4], v[5], v[6], v[7]}; }
    __syncthreads();
    const int c = tid & 255, th = tid >> 8, wq = (tid >> 6) & 3;
    const gfloat* dw = p.in(10) + (size_t)layer * 31 * 256 + c;
    float w[31];
#pragma unroll
    for (int tap = 0; tap < 31; ++tap) w[tap] = dw[tap * 256];
    const float bias = p.in(11)[layer * 256 + c], lg = p.in(12)[layer * 256 + c], lb = p.in(13)[layer * 256 + c];
    for (int ch = 0; ch < 4; ++ch) {
        const int tb = th * 32 + ch * 8;
        float o[8];
#pragma unroll
        for (int e = 0; e < 8; ++e) { float acc = bias;
#pragma unroll
            for (int tap = 0; tap < 31; ++tap) acc += w[tap] * vt[(tb + e + tap) * 256 + c];
            o[e] = acc; }
#pragma unroll
        for (int e = 0; e < 8; ++e) { const float s1 = wave_sum(o[e]); if (lane == 0) red1[(tb + e) * 4 + wq] = s1; }
        __syncthreads();
#pragma unroll
        for (int e = 0; e < 8; ++e) { const LAS float* r = red1 + (tb + e) * 4; const float mean = ((r[0] + r[1]) + (r[2] + r[3])) * (1.f / 256.f); o[e] -= mean;
            const float s2 = wave_sum(o[e] * o[e]); if (lane == 0) red2[(tb + e) * 4 + wq] = s2; }
        __syncthreads();
#pragma unroll
        for (int e = 0; e < 8; ++e) { const LAS float* r = red2 + (tb + e) * 4; const float var = ((r[0] + r[1]) + (r[2] + r[3])) * (1.f / 256.f);
            const float y = o[e] / sqrtf(var + 1e-5f) * lg + lb; const float z = y / (1.f + __expf(-y));
            cva[(size_t)(seqbase + t0 + tb + e) * 256 + c] = (bf16)(pk2(z, 0.f) & 0xffffu); }
    }
}
#define MFMA32(a, b, c) __builtin_amdgcn_mfma_f32_32x32x16_bf16((a), (b), (c), 0, 0, 0)
DI unsigned attn_off(int tile, int b, int h, int rs, int lane) {
    const int tileg = tile >= 8 ? (b * 64 + rs * 2 + (tile - 8)) : (TL / 32 + b * 8 + tile);
    return (unsigned)((tileg * 8 + h) * 2048 + lane * 8) * 2u;
}
DI void attn_load_k(const gchar* KtB, unsigned off, bf16x8 (&kf)[4]) {
#pragma unroll
    for (int ks = 0; ks < 4; ++ks) kf[ks] = *(const GAS bf16x8*)(KtB + off + ks * 1024);
}
DI void attn_load_v(const gchar* VtB, unsigned off, bf16x8 (&vf)[2][2]) {
#pragma unroll
    for (int dt = 0; dt < 2; ++dt)
#pragma unroll
        for (int t = 0; t < 2; ++t) vf[dt][t] = *(const GAS bf16x8*)(VtB + off + (dt * 2 + t) * 1024);
}
template <int MODE, int KT> DI void attn_compute(const bf16x8 (&kf)[4], const bf16x8 (&vf)[2][2], const bf16x8 (&qf)[2][4], f32x16 (&o)[2][2], float (&m)[2], float (&ls)[2],
                                                 const LAS float* bl, int kr, int ql, int half) {
    const float SCL = 0.125f * 1.4426950408889634f, NINF = -__builtin_inff();
#pragma unroll
    for (int qt = 0; qt < 2; ++qt) {
        constexpr int dummy = 0; (void)dummy;
        const int VLO = (MODE == 1 && qt != KT) ? (qt == 0 ? 0 : 12) : 0, VHI = (MODE == 1 && qt != KT) ? (qt == 0 ? 4 : 16) : 16;
        f32x16 sv;
#pragma unroll
        for (int v = 0; v < 16; ++v) sv[v] = 0.f;
#pragma unroll
        for (int ks = 0; ks < 4; ++ks) sv = MFMA32(kf[ks], qf[qt][ks], sv);
        float mx = NINF;
        if (MODE == 1) {
            const int qc = qt * 32 + ql, cs = min(max(qc - 8, 0), 48);
            const int kc0 = KT * 32 + 4 * half;
            const int d0 = kc0 - cs;
            const volatile LAS float* bp = (const volatile LAS float*)bl + (kr * 31 + kc0 - qc + 15 + 48);
            float bias[16];
#pragma unroll
            for (int v = 0; v < 16; ++v) if (v >= VLO && v < VHI) bias[v] = bp[(v & 3) + 8 * (v >> 2)];
#pragma unroll
            for (int v = 0; v < 16; ++v) if (v >= VLO && v < VHI) { const int dv = (v & 3) + 8 * (v >> 2); const bool valid = (unsigned)(d0 + dv) < 16u;
                const float x = valid ? sv[v] * SCL + bias[v] : NINF; sv[v] = x; mx = fmaxf(mx, x); }
        } else {
#pragma unroll
            for (int v = 0; v < 16; ++v) { const float x = sv[v] * SCL; sv[v] = x; mx = fmaxf(mx, x); }
        }
        mx = fmaxf(mx, __shfl_xor(mx, 32));
        const float mn = fmaxf(m[qt], mx), alpha = __builtin_amdgcn_exp2f(m[qt] - mn);
        const bool grew = mn > m[qt]; m[qt] = mn;
        float sum = 0.f;
#pragma unroll
        for (int v = 0; v < 16; ++v) if (v >= VLO && v < VHI) { const float pv = __builtin_amdgcn_exp2f(sv[v] - mn); sv[v] = pv; sum += pv; }
        ls[qt] = ls[qt] * alpha + sum;
        if (__builtin_amdgcn_ballot_w64(grew) != 0ull) {
#pragma unroll
            for (int dt = 0; dt < 2; ++dt)
#pragma unroll
                for (int v = 0; v < 16; ++v) o[dt][qt][v] *= alpha;
        }
#pragma unroll
        for (int t = 0; t < 2; ++t) {
            if (8 * t + 8 <= VLO || 8 * t >= VHI) continue;
            u32x4 pw;
            pw.x = (8 * t + 0 >= VLO && 8 * t + 0 < VHI) ? pk2(sv[8 * t + 0], sv[8 * t + 1]) : 0u; pw.y = (8 * t + 2 >= VLO && 8 * t + 2 < VHI) ? pk2(sv[8 * t + 2], sv[8 * t + 3]) : 0u;
            pw.z = (8 * t + 4 >= VLO && 8 * t + 4 < VHI) ? pk2(sv[8 * t + 4], sv[8 * t + 5]) : 0u; pw.w = (8 * t + 6 >= VLO && 8 * t + 6 < VHI) ? pk2(sv[8 * t + 6], sv[8 * t + 7]) : 0u;
            const bf16x8 pf = __builtin_bit_cast(bf16x8, pw);
#pragma unroll
            for (int dt = 0; dt < 2; ++dt) o[dt][qt] = MFMA32(vf[dt][t], pf, o[dt][qt]); }
    }
}
DI void attn_item(const PP p, int layer, int b, int qbase, int nloc, int r, LAS unsigned char* lds, const int tid_, const int bid_) {
    int tid = tid_; asm volatile("" : "+v"(tid));
    const int lane = tid & 63, h = __builtin_amdgcn_readfirstlane(tid >> 6), ql = lane & 31, half = lane >> 5;
    const gchar* UrmB = (const gchar*)(p.ws() + WS_URM); const gchar* KtB = (const gchar*)(p.ws() + WS_KT); const gchar* VtB = (const gchar*)(p.ws() + WS_VT);
    LAS float* bl = (LAS float*)(lds + h * 9728);
    LAS bf16x8* qlds = (LAS bf16x8*)(lds + h * 9728 + 1536) + lane;
    const int rs = min(max(r - 4, 0), 24);
    const float LOG2E = 1.4426950408889634f, NINF = -__builtin_inff();
    __syncthreads();
    if (nloc) { const gfloat* rp = p.in(16) + (size_t)(layer * 8 + h) * 465;
        for (int i = lane; i < 248; i += 64) { const int kr = i / 31, co = i - kr * 31; bl[48 + i] = rp[(rs - r + 7 + kr) * 31 + co] * LOG2E; } }
    __syncthreads();
    bf16x8 qf[2][4];
#pragma unroll
    for (int qt = 0; qt < 2; ++qt) { const unsigned qoff = (unsigned)((qbase + qt * 32 + ql) * URM + 512 + h * 64 + 32 * half) * 2u;
#pragma unroll
        for (int ks = 0; ks < 4; ++ks) qf[qt][ks] = *(const GAS bf16x8*)(UrmB + qoff + 16 * ks); }
    f32x16 o[2][2];
#pragma unroll
    for (int a = 0; a < 2; ++a)
#pragma unroll
        for (int c = 0; c < 2; ++c)
#pragma unroll
            for (int v = 0; v < 16; ++v) o[a][c][v] = 0.f;
    float m[2] = {NINF, NINF}, ls[2] = {0.f, 0.f};
    const int ntiles = 8 + nloc;
    bf16x8 kf[4], vf[2][2], kn[4];
#define ATT_ROT() do { _Pragma("unroll") for (int ks = 0; ks < 4; ++ks) kf[ks] = kn[ks]; } while (0)
    attn_load_k(KtB, attn_off(0, b, h, rs, lane), kf);
#pragma unroll 1
    for (int tile = 0; tile < 8; ++tile) {
        asm volatile("" ::: "memory");
        attn_load_v(VtB, attn_off(tile, b, h, rs, lane), vf);
        attn_load_k(KtB, attn_off(tile + 1 < ntiles ? tile + 1 : tile, b, h, rs, lane), kn);
        attn_compute<0, 0>(kf, vf, qf, o, m, ls, bl, 0, ql, half);
        ATT_ROT();
    }
#pragma unroll 1
    for (int kr = 0; kr < (nloc >> 1); ++kr) {
        asm volatile("" ::: "memory");
        attn_load_v(VtB, attn_off(8 + 2 * kr, b, h, rs, lane), vf);
        attn_load_k(KtB, attn_off(9 + 2 * kr, b, h, rs, lane), kn);
        attn_compute<1, 0>(kf, vf, qf, o, m, ls, bl, kr, ql, half);
        ATT_ROT();
        asm volatile("" ::: "memory");
        attn_load_v(VtB, attn_off(9 + 2 * kr, b, h, rs, lane), vf);
        attn_load_k(KtB, attn_off(10 + 2 * kr < ntiles ? 10 + 2 * kr : 9 + 2 * kr, b, h, rs, lane), kn);
        attn_compute<1, 1>(kf, vf, qf, o, m, ls, bl, kr, ql, half);
        ATT_ROT();
    }
#undef ATT_ROT
    int tid2 = tid_; asm volatile("" : "+v"(tid2));
    const int ql2 = tid2 & 31, half2 = (tid2 >> 5) & 1; gbf16* mixo = (gbf16*)(p.ws() + WS_MIX);
#pragma unroll
    for (int qt = 0; qt < 2; ++qt) { const float lt_ = ls[qt] + __shfl_xor(ls[qt], 32); const float inv = 1.f / lt_; const int token = qbase + qt * 32 + ql2;
#pragma unroll
        for (int dt = 0; dt < 2; ++dt)
#pragma unroll
            for (int i = 0; i < 4; ++i) { const int d = dt * 32 + 8 * i + 4 * half2; u32x2 w; w.x = pk2(o[dt][qt][4 * i] * inv, o[dt][qt][4 * i + 1] * inv); w.y = pk2(o[dt][qt][4 * i + 2] * inv, o[dt][qt][4 * i + 3] * inv);
                *(GAS u32x2*)((gchar*)mixo + (unsigned)(token * D + 512 + h * 64 + d) * 2u) = w; } }
}
DI void run_phase(const PP p, int ph, LAS unsigned char* lds, const int tid, const int c, const int skip = 0) {
    const int G = gridDim.x;
    if (ph == 0) { phase_mods(p, lds, tid, c); make_tables(p, tid, c); conv_weights(p, 0, lds, tid, c); return; }
    if (ph == NPH - 1) { phase_final(p, tid, c); return; }
    const int layer = (ph - 1) >> 3, sub = (ph - 1) & 7;
    const int M = layer == 0 ? TA : TL;
    if (sub == 0) { if (layer == 1) conv_weights(p, 1, lds, tid, c); phase_norm(p, layer, 0, TA, tid, c); return; }
    if (sub == 5) { phase_norm(p, layer, 1, M, tid, c); return; }
    const int H = G / 2 > 0 ? G / 2 : 1;
#pragma unroll 1
    for (int j = 0; j < 2; ++j) {
        unsigned char* ws = p.ws();
        const gbf16* A = nullptr; const gbf16* Bt = nullptr; int K = 0, nM = 0, nN = 0, cc = c, pmadd = 0, mode = 0, pmbase = 0, ksplit = 1; bool valid = true;
        if (sub == 1) {
            if (j == 0) { A = (const gbf16*)(ws + WS_HN); Bt = (const gbf16*)(ws + WS_WIN) + (size_t)256 * D; K = D; nM = TA / 256; nN = 6; mode = M_URM; }
            else { A = (const gbf16*)(ws + WS_WIN); Bt = (const gbf16*)(ws + WS_HN); K = D; nM = 3; nN = TA / 256; cc = (c + (G - (432 % G))) % G; pmadd = 6; mode = M_SWAP; }
        } else if (sub == 2) {
            if (j == 0) { A = (const gbf16*)(ws + WS_DFTL); Bt = (const gbf16*)(ws + WS_UTL); K = SEQ; nM = 16; nN = 8; mode = M_DFTL; }
            else { A = (const gbf16*)(ws + WS_DFTC); Bt = (const gbf16*)(ws + WS_UTC); K = CTX; nM = 2; nN = 8; cc = (c + H) % G; mode = M_DFTC; valid = (layer == 0); }
        } else if (sub == 3) {
            if (j == 0) { A = (const gbf16*)(ws + WS_G12); Bt = (const gbf16*)(ws + WS_WF2); K = 512; nM = M / 256; nN = 1; mode = M_MIXF; }
            else { A = (const gbf16*)(ws + WS_CVA); Bt = (const gbf16*)(ws + WS_WPW); K = 256; nM = M / 256; nN = 1; cc = (c + G - ((M / 256) % G)) % G; mode = M_MIXC; }
        } else if (sub == 4) { A = (const gbf16*)(ws + WS_MIX); Bt = (const gbf16*)(ws + WS_WOUT); K = D; nN = 4;
            if (j == 0) { nM = TL / 256; mode = M_RES1; } else { nM = TC / 256; pmbase = TL / 256; ksplit = 4; mode = M_RES1K; valid = (layer == 0); }
        }
        else if (sub == 6) { A = (const gbf16*)(ws + WS_HN); Bt = (const gbf16*)(ws + WS_W1); K = D; nM = M / 256; nN = 16; mode = M_HID; valid = (j == 0); }
        else { A = (const gbf16*)(ws + WS_HID); Bt = (const gbf16*)(ws + WS_W2); K = DFF; nN = 4;
            if (j == 0) { nM = TL / 256; mode = M_RES2; } else { nM = TC / 256; pmbase = TL / 256; ksplit = 4; mode = M_RES2K; valid = (layer == 0); }
        }
        if (valid && !(skip & 1)) { Sched S; S.init(nM, nN, G, cc); S.pmadd = pmadd; S.pmbase = pmbase; S.ksplit = ksplit; S.kbytes = (K / ksplit) * 2; int tj = tid; asm volatile("" : "+v"(tj)); run_gemm(lds, A, Bt, K, ksplit > 1 ? K / ksplit : 0, S, mode, layer, p, tj); }
    }
    if (sub == 2) {
        const int natt = (skip & 4) ? 0 : (layer == 0 ? 288 : 256), nconv = (skip & 2) ? 0 : (layer == 0 ? 288 : 256);
        unsigned* ctr = (unsigned*)(p.ws() + WS_CTL) + 64 * layer + 16 * (skip != 0);
        LAS int* slot = (LAS int*)(lds + LDSP_OFF + 512);
#pragma unroll 1
        for (;;) {
            __syncthreads();
            if (tid == 0) *slot = (int)__hip_atomic_fetch_add(ctr, 1u, __ATOMIC_RELAXED, __HIP_MEMORY_SCOPE_AGENT);
            __syncthreads();
            const int it = __builtin_amdgcn_readfirstlane(*slot);
            if (it >= natt + nconv) break;
            if (it < natt) {
                if (it < 256) attn_item(p, layer, it >> 5, (it >> 5) * SEQ + (it & 31) * 64, 16, it & 31, lds, tid, c);
                else { const int i2 = it - 256; attn_item(p, layer, i2 >> 2, TL + (i2 >> 2) * CTX + (i2 & 3) * 64, 0, 0, lds, tid, c); }
            } else {
                const int ic = it - natt; const bool lat = ic < 256; const int i2 = ic - 256;
                conv_tile(p, layer, lat ? (ic >> 5) * SEQ : TL + (i2 >> 2) * CTX, lat ? SEQ : CTX, lat ? (ic & 31) * 64 : (i2 & 3) * 64, lds, tid, c);
            }
        }
    }
}

__global__ void __launch_bounds__(512, 2) fwd_kernel(Params prm) {
    extern __shared__ __attribute__((aligned(16))) unsigned char lds_raw[];
    LAS unsigned char* lds = (LAS unsigned char*)lds_raw;
    {
        const unsigned long long* ka = (const unsigned long long*)__builtin_amdgcn_kernarg_segment_ptr();
        if (threadIdx.x < 23) ((LAS unsigned long long*)(lds + LDSP_OFF))[threadIdx.x] = ka[threadIdx.x];
    }
    __syncthreads();
    PP p; p.P = (const LAS unsigned long long*)(lds + LDSP_OFF);
    if (threadIdx.x < 2) ((LAS unsigned*)(lds + LDSP_OFF + 1024))[threadIdx.x] = 0u;
    __syncthreads();
    const XcdBarrier xbar = xcd_barrier_post((unsigned*)(prm.ws + WS_CTL) + 4096, (volatile LAS unsigned*)(lds + LDSP_OFF + 1024));
    const int lo = prm.ph_lo, hi = prm.ph_hi;
    const int wave_s = __builtin_amdgcn_readfirstlane((int)threadIdx.x >> 6);
#pragma unroll 1
    for (int ph = lo; ph < hi; ++ph) {
        if (ph > lo) { if (hi < 0) cg::this_grid().sync(); else xcd_barrier(xbar); }
        int lane_; asm volatile("v_mbcnt_lo_u32_b32 %0, -1, 0\n\tv_mbcnt_hi_u32_b32 %0, -1, %0" : "=v"(lane_));
        int tid = wave_s * 64 + lane_, bid = blockIdx.x;
        asm volatile("" : "+s"(bid));
        run_phase(p, ph, lds, tid, bid);
        __syncthreads();
#ifdef PROBE_REPEAT
        if ((PROBE_REPEAT >> ph) & 1) { xcd_barrier(xbar); run_phase(p, ph, lds, tid, bid, PROBE_SKIP); __syncthreads(); }
#endif
    }
}

extern "C" void kernel_launch(void* const* d_in, const int* in_sizes, int n_in, void* d_out, int out_size, void* d_ws, size_t ws_size, hipStream_t stream) {
    static int grid = 0;
    if (grid == 0) {
        if (n_in != 21 || ws_size < WS_SIDE + 24 * MiB) { fprintf(stderr, "kernel_launch: unexpected n_in %d / ws_size %zu\n", n_in, ws_size); grid = -1; return; }
        int dev = 0, cus = 0, per_cu = 0;
        (void)hipGetDevice(&dev); (void)hipDeviceGetAttribute(&cus, hipDeviceAttributeMultiprocessorCount, dev);
        (void)hipFuncSetAttribute((const void*)fwd_kernel, hipFuncAttributeMaxDynamicSharedMemorySize, LDS_BYTES);
        (void)hipOccupancyMaxActiveBlocksPerMultiprocessor(&per_cu, (const void*)fwd_kernel, 512, LDS_BYTES);
        if (per_cu < 1) { fprintf(stderr, "kernel_launch: occupancy query says %d blocks/CU\n", per_cu); per_cu = 1; }
        (void)hipGetLastError();
        grid = cus > 0 ? cus : 256;
    }
    if (grid < 0) return;
    (void)hipMemsetAsync((char*)d_ws + WS_CTL, 0, 65536, stream);
    Params p{};
    for (int i = 0; i < 21; ++i) p.in[i] = (const float*)d_in[i];
    p.out = (float*)d_out; p.ws = (unsigned char*)d_ws;
#if SINGLE_LAUNCH
    p.ph_lo = 0; p.ph_hi = NPH;
    void* args[] = {&p};
    hipError_t e = hipLaunchCooperativeKernel((const void*)fwd_kernel, dim3(grid), dim3(512), args, LDS_BYTES, stream);
    if (e != hipSuccess) fprintf(stderr, "cooperative launch failed: %s (grid %d)\n", hipGetErrorString(e), grid);
#else
    for (int ph = 0; ph < NPH; ++ph) { p.ph_lo = ph; p.ph_hi = ph + 1; hipLaunchKernelGGL(fwd_kernel, dim3(grid), dim3(512), LDS_BYTES, stream, p); }
#endif
}
```
